# Optimizing an MI355X kernel written in HIP

```python
import jax, jax.numpy as jnp
from jax import lax
import numpy as np

D_MODEL = 1024
BATCH = 4
SEQ = 4096
DEPTH = 2

CONV_WIDTH = 3
D_CONV = D_MODEL
CONV_GROUPS = 16
RET_HEADS = 4
RET_QK_DIM = D_MODEL // RET_HEADS
RET_V_DIM = 2 * D_MODEL // RET_HEADS
D_RET_QK = RET_HEADS * RET_QK_DIM
D_RET_V = RET_HEADS * RET_V_DIM
CHUNK = 128
ROPE_BASE = 10000.0
EPS = 1e-6
SPLITS = (D_CONV, D_CONV, D_CONV, D_CONV, D_RET_QK, D_RET_QK, D_RET_V, D_RET_V, D_MODEL, D_MODEL)
D_IN = sum(SPLITS)

kernel_name = "hybrid_shortconv_retention_gated_merge"


def rmsnorm(x, g):
    xf = x.astype(jnp.float32)
    y = xf * lax.rsqrt(jnp.mean(xf * xf, axis=-1, keepdims=True) + EPS)
    return (y * g.astype(jnp.float32)).astype(x.dtype)


def short_conv_branch(b_gate, c_gate, xv, z, conv_w, conv_b, w_out):
    u = c_gate * xv
    u = lax.conv_general_dilated(
        u, conv_w[:, None, :],
        window_strides=(1,), padding=[(CONV_WIDTH - 1, 0)],
        dimension_numbers=('NWC', 'WIO', 'NWC'),
        feature_group_count=D_CONV) + conv_b
    y = b_gate * u * jax.nn.silu(z)
    return y @ w_out


def rotary(t, cos, sin):
    t1, t2 = jnp.split(t, 2, axis=-1)
    c = cos[None, :, None, :]
    s = sin[None, :, None, :]
    return jnp.concatenate([t1 * c - t2 * s, t1 * s + t2 * c], axis=-1)


def retention_branch(q, k, v, z, w_out):
    bsz, seq, _ = q.shape
    n_chunks = seq // CHUNK
    f32 = jnp.float32
    q = q.reshape(bsz, seq, RET_HEADS, RET_QK_DIM).astype(f32)
    k = k.reshape(bsz, seq, RET_HEADS, RET_QK_DIM).astype(f32)
    v = v.reshape(bsz, seq, RET_HEADS, RET_V_DIM).astype(f32)

    pos = jnp.arange(seq, dtype=f32)
    inv_freq = ROPE_BASE ** (-jnp.arange(0, RET_QK_DIM, 2, dtype=f32) / RET_QK_DIM)
    ang = pos[:, None] * inv_freq[None, :]
    cos, sin = jnp.cos(ang), jnp.sin(ang)
    q = rotary(q, cos, sin)
    k = rotary(k, cos, sin) * (RET_QK_DIM ** -0.5)

    log_gamma = jnp.log(1.0 - jnp.exp2(-5.0 - jnp.arange(RET_HEADS, dtype=f32)))
    idx = jnp.arange(CHUNK, dtype=f32)
    rel = idx[:, None] - idx[None, :]
    decay_in = jnp.where(rel[None] >= 0,
                         jnp.exp(jnp.maximum(rel, 0.0)[None] * log_gamma[:, None, None]),
                         0.0)
    xi = jnp.exp((idx + 1.0)[:, None] * log_gamma[None, :])
    zeta = jnp.exp((CHUNK - 1.0 - idx)[:, None] * log_gamma[None, :])
    chunk_decay = jnp.exp(CHUNK * log_gamma)

    qc = q.reshape(bsz, n_chunks, CHUNK, RET_HEADS, RET_QK_DIM)
    kc = k.reshape(bsz, n_chunks, CHUNK, RET_HEADS, RET_QK_DIM)
    vc = v.reshape(bsz, n_chunks, CHUNK, RET_HEADS, RET_V_DIM)

    s = jnp.einsum('bnihd,bnjhd->bnhij', qc, kc) * decay_in[None, None]
    o_in = jnp.einsum('bnhij,bnjhe->bnihe', s, vc)

    def step(state, inp):
        qn, kn, vn = inp
        cross = jnp.einsum('bihd,bhde->bihe', qn, state) * xi[None, :, :, None]
        state = state * chunk_decay[None, :, None, None] + jnp.einsum(
            'bjhd,bjhe->bhde', kn * zeta[None, :, :, None], vn)
        return state, cross

    s0 = jnp.zeros((bsz, RET_HEADS, RET_QK_DIM, RET_V_DIM), f32)
    _, o_cross = lax.scan(step, s0, (jnp.moveaxis(qc, 1, 0), jnp.moveaxis(kc, 1, 0),
                                     jnp.moveaxis(vc, 1, 0)))
    o = (o_in + jnp.moveaxis(o_cross, 0, 1)).reshape(bsz, seq, RET_HEADS, RET_V_DIM)

    o = o * lax.rsqrt(jnp.mean(o * o, axis=-1, keepdims=True) + EPS)
    o = o.reshape(bsz, seq, D_RET_V).astype(z.dtype) * jax.nn.silu(z)
    return o @ w_out


def setup_inputs(seed: int = 0) -> dict:
    key = jax.random.key(seed)
    ks = jax.random.split(key, 10)
    f32 = jnp.float32
    x = jax.random.normal(ks[0], (BATCH, SEQ, D_MODEL), f32)
    norm_g = 1.0 + 0.01 * jax.random.normal(ks[1], (DEPTH, D_MODEL), f32)
    w_in = jax.random.normal(ks[2], (DEPTH, D_MODEL, D_IN), f32) * D_MODEL ** -0.5
    conv_w = jax.random.normal(ks[3], (DEPTH, CONV_WIDTH, D_CONV), f32) * CONV_WIDTH ** -0.5
    conv_b = 0.01 * jax.random.normal(ks[4], (DEPTH, D_CONV), f32)
    w_a_out = jax.random.normal(ks[5], (DEPTH, D_CONV, D_MODEL), f32) * D_CONV ** -0.5
    w_b_out = jax.random.normal(ks[6], (DEPTH, D_RET_V, D_MODEL), f32) * D_RET_V ** -0.5
    w_o = jax.random.normal(ks[7], (DEPTH, D_MODEL, D_MODEL), f32) * D_MODEL ** -0.5
    final_g = 1.0 + 0.01 * jax.random.normal(ks[8], (D_MODEL,), f32)
    return {"x": x, "norm_g": norm_g, "w_in": w_in, "conv_w": conv_w, "conv_b": conv_b,
            "w_a_out": w_a_out, "w_b_out": w_b_out, "w_o": w_o, "final_g": final_g}


def reference(x, norm_g, w_in, conv_w, conv_b, w_a_out, w_b_out, w_o, final_g):
    split_points = list(np.cumsum(SPLITS)[:-1])
    for layer in range(DEPTH):
        h = rmsnorm(x, norm_g[layer])
        proj = h @ w_in[layer]
        b_a, c_a, x_a, z_a, q, k, v, z_b, g_a, g_b = jnp.split(proj, split_points, axis=-1)
        y_a = short_conv_branch(b_a, c_a, x_a, z_a, conv_w[layer], conv_b[layer], w_a_out[layer])
        y_b = retention_branch(q, k, v, z_b, w_b_out[layer])
        merged = jax.nn.sigmoid(g_a) * y_a + jax.nn.sigmoid(g_b) * y_b
        x = x + merged @ w_o[layer]
    return rmsnorm(x, final_g)
```

```cpp
#include <hip/hip_runtime.h>
#include <cstdio>
#include <cstdint>
#ifndef N_LAUNCHES_DEFINED
#endif
namespace pg8 {
#define PG8_LAS __attribute__((address_space(3)))
typedef unsigned short bf16_t;
typedef short bf16x8 __attribute__((ext_vector_type(8)));
typedef float f32x4 __attribute__((ext_vector_type(4)));
typedef unsigned u32x4 __attribute__((ext_vector_type(4)));
constexpr int BM = 256, BK = 64, HALF = 128, HTB = HALF * BK * 2  , STAGE_BYTES = 8 * HTB, NXCD = 8, WGM = 8;

__host__ __device__ __forceinline__ int lds_byte(int r, int c) { const int st = (r >> 4) * 2 + (c >> 5), rr = r & 15, cc = c & 31, ob = rr * 64 + cc * 2; return st * 1024 + (ob ^ (((ob >> 9) & 1) << 5)); }
__host__ __device__ __forceinline__ void stage_rc(int b, int& R, int& C) { const int st = b / 1024, sb = b % 1024, swz = sb ^ (((sb >> 9) & 1) << 5); R = (st >> 1) * 16 + swz / 64; C = (st & 1) * 32 + (swz % 64) / 2; }
__host__ __device__ __forceinline__ int perm32(int rho) { const int n = rho >> 4, i = rho & 15; return 8 * (i >> 2) + 4 * n + (i & 3); }

struct Unit { int pm, pn; };
struct Gemm { const bf16_t* A; const bf16_t* Bt; int M, N, K; };

struct StaticOrder {
    int nM, nN, nwg, G, c;
    __host__ __device__ void init(int M, int N, int G_, int c_) { nM = M / BM; nN = N / BM; nwg = nM * nN; G = G_; c = c_; }
    __host__ __device__ bool next(int i, Unit& u) const {
        const long L = (long)i * G + c; if (L >= nwg) return false;
        int wgid = (int)L; { const int q = nwg / NXCD, r = nwg % NXCD, xcd = wgid % NXCD, off = wgid / NXCD; wgid = (xcd < r ? xcd * (q + 1) : r * (q + 1) + (xcd - r) * q) + off; }
        const int nig = WGM * nN, gid = wgid / nig, fm = gid * WGM, gsz = (nM - fm) < WGM ? (nM - fm) : WGM;
        u.pm = fm + ((wgid % nig) % gsz); u.pn = (wgid % nig) / gsz; return true;
    }
    __device__ __forceinline__ void a_ready(const Unit&) const {}
    __device__ __forceinline__ void done(const Unit&) const {}
};
__device__ __forceinline__ unsigned cvt_pk_bf16(float lo, float hi) { unsigned r; asm volatile("v_cvt_pk_bf16_f32 %0, %1, %2" : "=v"(r) : "v"(lo), "v"(hi)); return r; }
template <class Epi, class Sched, bool ALIGN_EPI = false, bool SP2 = false>
__device__ __forceinline__ void gemm_phase(PG8_LAS unsigned char* lds, const Gemm g, const Sched& S, const Epi& E) {
    int tid_ = threadIdx.x; asm volatile("" : "+v"(tid_));
    const int tid = tid_, wid = __builtin_amdgcn_readfirstlane(tid >> 6), lane = tid & 63, wr = wid >> 2, wc = wid & 3, fr = lane & 15, fq = lane >> 4;
    const int K = g.K, nt = K / BK;
    unsigned voffA[2], voffB[2];
#pragma unroll
    for (int i = 0; i < 2; ++i) { int R, C; stage_rc(tid * 16 + i * 8192, R, C); const int Rb = Epi::PERM ? ((R & ~31) + perm32(R & 31)) : R;
        voffA[i] = (unsigned)(R * K + C) * 2u; voffB[i] = (unsigned)(Rb * K + C) * 2u; }
    const size_t kstep = (size_t)(BK * 2);
    const size_t hstep = (size_t)HALF * K * 2;
    const size_t tstep = 2 * hstep;
    const unsigned ldsw = (unsigned)wid * 1024u;
    const int aoff = lds_byte(wr * 64 + fr, fq * 8), boff = lds_byte(wc * 32 + fr, fq * 8);
#define PG8_SA(b, h) (((b) * 2 + (h)) * HTB)
#define PG8_SB(b, h) ((4 + (b) * 2 + (h)) * HTB)
#define PG8_STAGE(bufoff, gbase, voff) do { _Pragma("unroll") for (int _i = 0; _i < 2; ++_i) \
        __builtin_amdgcn_global_load_lds((const unsigned*)((const char*)(gbase) + (voff)[_i]), (PG8_LAS unsigned*)(lds + (bufoff) + ldsw + _i * 8192), 16, 0, 0); } while (0)
#define PG8_LDA(dst, b, h) do { _Pragma("unroll") for (int m = 0; m < 4; ++m) _Pragma("unroll") for (int k = 0; k < 2; ++k) dst[m][k] = *(const PG8_LAS bf16x8*)(lds + PG8_SA(b, h) + aoff + m * 2048 + k * 1024); } while (0)
#define PG8_LDB(dst, b, h) do { _Pragma("unroll") for (int n = 0; n < 2; ++n) _Pragma("unroll") for (int k = 0; k < 2; ++k) dst[n][k] = *(const PG8_LAS bf16x8*)(lds + PG8_SB(b, h) + boff + n * 2048 + k * 1024); } while (0)
#define PG8_MMA(ai, bj, At, Bt) do { __builtin_amdgcn_s_setprio(1); _Pragma("unroll") for (int m = 0; m < 4; ++m) _Pragma("unroll") for (int n = 0; n < 2; ++n) _Pragma("unroll") for (int k = 0; k < 2; ++k) \
        acc[ai][bj][m][n] = __builtin_amdgcn_mfma_f32_16x16x32_bf16(Bt[n][k], At[m][k], acc[ai][bj][m][n], 0, 0, 0); __builtin_amdgcn_s_setprio(0); } while (0)
#define PG8_WAIT_V(n) asm volatile("s_waitcnt vmcnt(" #n ")" ::: "memory")
#define PG8_WAIT_L(n) asm volatile("s_waitcnt lgkmcnt(" #n ")" ::: "memory")
#define PG8_BAR __builtin_amdgcn_s_barrier()
#define PG8_SCHED __builtin_amdgcn_sched_barrier(0)
    Unit cur, nxt; int ui = 0;
    if (!S.next(0, cur)) return;
    f32x4 acc[2][2][4][2];
#pragma unroll
    for (int a = 0; a < 2; ++a)
#pragma unroll
        for (int b = 0; b < 2; ++b)
#pragma unroll
            for (int m = 0; m < 4; ++m)
#pragma unroll
                for (int n = 0; n < 2; ++n) acc[a][b][m][n] = (f32x4){0.f, 0.f, 0.f, 0.f};
    bf16x8 At[4][2], B0[2][2], B1[2][2];
    const char* cA = (const char*)g.A + (size_t)cur.pm * tstep; const char* cB = (const char*)g.Bt + (size_t)cur.pn * tstep;
    S.a_ready(cur);
    if constexpr (SP2) {
        PG8_STAGE(PG8_SB(0, 0), cB, voffB); PG8_STAGE(PG8_SB(0, 1), cB + hstep, voffB); PG8_STAGE(PG8_SA(0, 0), cA, voffA); PG8_STAGE(PG8_SA(0, 1), cA + hstep, voffA);
        if (wr == 1) PG8_BAR;
        PG8_WAIT_V(2); PG8_BAR;
        PG8_STAGE(PG8_SB(1, 0), cB + kstep, voffB); PG8_STAGE(PG8_SA(1, 0), cA + kstep, voffA); PG8_STAGE(PG8_SB(1, 1), cB + hstep + kstep, voffB);
        PG8_WAIT_V(6); PG8_BAR;
    } else {
        PG8_STAGE(PG8_SB(0, 0), cB, voffB); PG8_STAGE(PG8_SA(0, 0), cA, voffA); PG8_STAGE(PG8_SB(0, 1), cB + hstep, voffB); PG8_STAGE(PG8_SA(0, 1), cA + hstep, voffA);
        if (wr == 1) PG8_BAR;
        PG8_WAIT_V(4); PG8_BAR;
        PG8_STAGE(PG8_SB(1, 0), cB + kstep, voffB); PG8_STAGE(PG8_SA(1, 0), cA + kstep, voffA); PG8_STAGE(PG8_SB(1, 1), cB + hstep + kstep, voffB);
        PG8_WAIT_V(6); PG8_BAR;
    }
    for (;;) {
        const bool has_next = S.next(ui + 1, nxt);
        const char* nA = has_next ? (const char*)g.A + (size_t)nxt.pm * tstep : cA; const char* nB = has_next ? (const char*)g.Bt + (size_t)nxt.pn * tstep : cB;
        for (int t = 0; t < nt; t += 2) {
            const bool last = (t == nt - 2);
            const char* a1 = cA + (size_t)(t + 1) * kstep;
            const char* a2 = last ? nA : cA + (size_t)(t + 2) * kstep; const char* b2 = last ? nB : cB + (size_t)(t + 2) * kstep;
            const char* a3 = a2 + kstep; const char* b3 = b2 + kstep;
            if (last && has_next) S.a_ready(nxt);
            if constexpr (SP2) {
            PG8_LDB(B0, 0, 0); PG8_LDB(B1, 0, 1); PG8_SCHED; PG8_LDA(At, 0, 0); PG8_STAGE(PG8_SA(1, 1), a1 + hstep, voffA);
            PG8_WAIT_V(8); PG8_WAIT_L(0); PG8_BAR; PG8_MMA(0, 0, At, B0); PG8_MMA(0, 1, At, B1); PG8_BAR; PG8_SCHED;
            PG8_LDA(At, 0, 1); PG8_STAGE(PG8_SB(0, 0), b2, voffB); PG8_STAGE(PG8_SB(0, 1), b2 + hstep, voffB); PG8_STAGE(PG8_SA(0, 0), a2, voffA);
            PG8_WAIT_V(8); PG8_WAIT_L(0); PG8_BAR; PG8_MMA(1, 0, At, B0); PG8_MMA(1, 1, At, B1); PG8_BAR; PG8_SCHED;
            PG8_LDB(B0, 1, 0); PG8_LDB(B1, 1, 1); PG8_SCHED; PG8_LDA(At, 1, 0); PG8_STAGE(PG8_SA(0, 1), a2 + hstep, voffA);
            PG8_WAIT_V(8); PG8_WAIT_L(0); PG8_BAR; PG8_MMA(0, 0, At, B0); PG8_MMA(0, 1, At, B1); PG8_BAR; PG8_SCHED;
            PG8_LDA(At, 1, 1); PG8_STAGE(PG8_SB(1, 0), b3, voffB); PG8_STAGE(PG8_SB(1, 1), b3 + hstep, voffB); PG8_STAGE(PG8_SA(1, 0), a3, voffA);
            PG8_WAIT_V(8); PG8_WAIT_L(0); PG8_BAR; PG8_MMA(1, 0, At, B0); PG8_MMA(1, 1, At, B1); PG8_BAR; PG8_SCHED;
            } else {
            PG8_LDB(B0, 0, 0); PG8_SCHED; PG8_LDA(At, 0, 0); PG8_STAGE(PG8_SA(1, 1), a1 + hstep, voffA);
            PG8_WAIT_L(8); PG8_BAR; PG8_WAIT_L(0); PG8_MMA(0, 0, At, B0); PG8_BAR; PG8_SCHED;
            PG8_LDB(B1, 0, 1); PG8_STAGE(PG8_SB(0, 0), b2, voffB);
            PG8_BAR; PG8_WAIT_L(0); PG8_MMA(0, 1, At, B1); PG8_BAR;
            PG8_LDA(At, 0, 1); PG8_STAGE(PG8_SA(0, 0), a2, voffA);
            PG8_BAR; PG8_WAIT_L(0); PG8_MMA(1, 0, At, B0); PG8_BAR; PG8_SCHED;
            PG8_STAGE(PG8_SB(0, 1), b2 + hstep, voffB);
            PG8_WAIT_V(6); PG8_BAR; PG8_MMA(1, 1, At, B1); PG8_BAR;
            PG8_LDB(B0, 1, 0); PG8_SCHED; PG8_LDA(At, 1, 0); PG8_STAGE(PG8_SA(0, 1), a2 + hstep, voffA);
            PG8_WAIT_L(8); PG8_BAR; PG8_WAIT_L(0); PG8_MMA(0, 0, At, B0); PG8_BAR; PG8_SCHED;
            PG8_LDB(B1, 1, 1); PG8_STAGE(PG8_SB(1, 0), b3, voffB);
            PG8_BAR; PG8_WAIT_L(0); PG8_MMA(0, 1, At, B1); PG8_BAR;
            PG8_LDA(At, 1, 1); PG8_STAGE(PG8_SA(1, 0), a3, voffA);
            PG8_BAR; PG8_WAIT_L(0); PG8_MMA(1, 0, At, B0); PG8_BAR; PG8_SCHED;
            PG8_STAGE(PG8_SB(1, 1), b3 + hstep, voffB);
            PG8_WAIT_V(6); PG8_BAR; PG8_MMA(1, 1, At, B1); PG8_BAR;
            }
        }
        if constexpr (ALIGN_EPI) { if (wr == 0) PG8_BAR; }
        if constexpr (!Epi::AFTER_DRAIN) { E(acc, cur, wr, wc, fr, fq); S.done(cur); }
        if (!has_next) break;
#pragma unroll
        for (int a = 0; a < 2; ++a)
#pragma unroll
            for (int b = 0; b < 2; ++b)
#pragma unroll
                for (int m = 0; m < 4; ++m)
#pragma unroll
                    for (int n = 0; n < 2; ++n) acc[a][b][m][n] = (f32x4){0.f, 0.f, 0.f, 0.f};
        cur = nxt; cA = nA; cB = nB; ++ui;
        if constexpr (ALIGN_EPI) { if (wr == 1) PG8_BAR; }
    }
    PG8_WAIT_V(0);
    if constexpr (!ALIGN_EPI) { if (wr == 0) PG8_BAR; }
    PG8_BAR;
    if constexpr (Epi::AFTER_DRAIN) { E.fused(acc, cur, wr, wc, fr, fq, lds, wid, lane); S.done(cur); }
#undef PG8_SA
#undef PG8_SB
#undef PG8_STAGE
#undef PG8_LDA
#undef PG8_LDB
#undef PG8_MMA
#undef PG8_WAIT_V
#undef PG8_WAIT_L
#undef PG8_BAR
#undef PG8_SCHED
}
}

constexpr int BATCH = 4, T = 4096, D = 1024, M = BATCH * T, DIN = 12288, DEPTH = 2, NWAVES = 8;
constexpr int NA = 8192, NB = 4096;
constexpr float EPS = 1e-6f;
#ifndef N_LAUNCHES
#define N_LAUNCHES 15
#endif
constexpr int NPHASES = 1 + 7 * DEPTH;

constexpr size_t MiB = 1u << 20;
constexpr size_t WS_CTL = 0, CTL_ZERO_BYTES = 1 * MiB;
constexpr size_t WS_R1 = 1 * MiB, WS_R2 = 326 * MiB;
constexpr size_t RW_IN = 0, RW_A = 24 * MiB, RW_B = 26 * MiB, RW_O = 30 * MiB;
constexpr size_t WS_COS = 33 * MiB, WS_SIN = 35 * MiB;
constexpr size_t WS_RSTD = 37 * MiB, WS_SSQ = 37 * MiB + 65536;
constexpr size_t WS_XB = 38 * MiB;
constexpr size_t WS_U = 70 * MiB, WS_BZ = 102 * MiB;
constexpr size_t WS_QT = 134 * MiB, WS_KT = 166 * MiB;
constexpr size_t WS_V = 198 * MiB;
constexpr size_t WS_O = 262 * MiB;
constexpr size_t WS_SG = WS_QT;
constexpr size_t WS_YAG = WS_V;
constexpr size_t WS_MG = WS_U;
constexpr size_t WS_END = 358 * MiB;
constexpr int CW_BAR = 4096;

constexpr int RING_BYTES = 131072, LDSCTL_OFF = RING_BYTES, MISC_OFF = LDSCTL_OFF + 320, LDS_BYTES = 147456;

#define GAS __attribute__((address_space(1)))
#define LAS __attribute__((address_space(3)))
typedef unsigned short bf16;
typedef unsigned v4u __attribute__((ext_vector_type(4)));
typedef unsigned v2u __attribute__((ext_vector_type(2)));
typedef float f32x4 __attribute__((ext_vector_type(4)));
typedef float f32x16 __attribute__((ext_vector_type(16)));
typedef short bf16x8 __attribute__((ext_vector_type(8)));
typedef short s16x4 __attribute__((ext_vector_type(4)));
typedef float f32x2_t __attribute__((ext_vector_type(2)));
typedef __bf16 bf16x2_t __attribute__((ext_vector_type(2)));
typedef GAS unsigned gu32;
#define LDS_WAIT() asm volatile("s_waitcnt lgkmcnt(0)" ::: "memory")
#define MFMA32(a, b, c) __builtin_amdgcn_mfma_f32_32x32x16_bf16((a), (b), (c), 0, 0, 0)

__device__ __forceinline__ unsigned pk2(float lo, float hi) { f32x2_t v = {lo, hi}; bf16x2_t b = __builtin_convertvector(v, bf16x2_t); return __builtin_bit_cast(unsigned, b); }
__device__ __forceinline__ float bf_lo(unsigned u) { return __uint_as_float(u << 16); }
__device__ __forceinline__ float bf_hi(unsigned u) { return __uint_as_float(u & 0xffff0000u); }
__device__ __forceinline__ float sigm(float x) { return __builtin_amdgcn_rcpf(1.0f + __expf(-x)); }
__device__ __forceinline__ int crow(int r, int hi) { return (r & 3) + 8 * (r >> 2) + 4 * hi; }
__device__ __forceinline__ float log2_gamma(int h) { return h == 0 ? -0.04580368961312479f : h == 1 ? -0.02272007650008353f : h == 2 ? -0.011315313227834146f : -0.005646563141142063f; }
typedef short v4i16_t __attribute__((ext_vector_type(4)));
__device__ __forceinline__ s16x4 vtr(const LAS char* p) { return __builtin_bit_cast(s16x4, __builtin_amdgcn_ds_read_tr16_b64_v4i16((LAS v4i16_t*)p)); }
__device__ __forceinline__ bf16x8 trpair(const LAS char* p, int hi_off) { const s16x4 lo = vtr(p), hi = vtr(p + hi_off); return (bf16x8){lo[0], lo[1], lo[2], lo[3], hi[0], hi[1], hi[2], hi[3]}; }

using pg8::Unit;
struct EpiA {
    static constexpr bool PERM = false, AFTER_DRAIN = false;
    const float* rstd; const float* cosT; const float* sinT; bf16* U; bf16* BZ; bf16* QT; bf16* KT; bf16* V;
    __device__ __forceinline__ void operator()(const f32x4 (&acc)[2][2][4][2], const Unit& u, int wr, int wc, int fr, int fq) const {
        const int row0 = u.pm * 256 + wr * 64 + fr;
        if (u.pn < 16) {
            const int ch0 = u.pn * 64 + wc * 16 + fq * 4;
#pragma unroll
            for (int ai = 0; ai < 2; ++ai)
#pragma unroll
                for (int m = 0; m < 4; ++m) {
                    const int row = row0 + ai * 128 + m * 16; const float rs = rstd[row];
                    const f32x4 b = acc[ai][0][m][0] * rs, c = acc[ai][0][m][1] * rs, x = acc[ai][1][m][0] * rs, z = acc[ai][1][m][1] * rs;
                    const f32x4 uu = c * x; f32x4 bz;
#pragma unroll
                    for (int j = 0; j < 4; ++j) bz[j] = b[j] * z[j] * sigm(z[j]);
                    v2u w0, w1; w0.x = pk2(uu[0], uu[1]); w0.y = pk2(uu[2], uu[3]); w1.x = pk2(bz[0], bz[1]); w1.y = pk2(bz[2], bz[3]);
                    *(v2u*)(U + (size_t)row * 1024 + ch0) = w0; *(v2u*)(BZ + (size_t)row * 1024 + ch0) = w1;
                    asm volatile("" ::: "memory");
                }
        } else if (u.pn < 24) {
            const int hd = (u.pn - 16) & 3; const bool isk = u.pn >= 20; bf16* dst = isk ? KT : QT;
            const float lg = log2_gamma(hd); const int f0 = wc * 32 + fq * 8;
#pragma unroll
            for (int ai = 0; ai < 2; ++ai)
#pragma unroll
                for (int m = 0; m < 4; ++m) {
                    const int row = row0 + ai * 128 + m * 16; const int pos = row & (T - 1); const float p = (float)(pos & 511);
                    const float sc = rstd[row] * (isk ? exp2f(-p * lg) * 0.0625f : exp2f(p * lg));
                    const f32x4 c0 = *(const f32x4*)(cosT + (size_t)pos * 128 + f0), c1 = *(const f32x4*)(cosT + (size_t)pos * 128 + f0 + 4);
                    const f32x4 s0 = *(const f32x4*)(sinT + (size_t)pos * 128 + f0), s1 = *(const f32x4*)(sinT + (size_t)pos * 128 + f0 + 4);
                    const f32x4 t1a = acc[ai][0][m][0], t1b = acc[ai][0][m][1], t2a = acc[ai][1][m][0], t2b = acc[ai][1][m][1];
                    const f32x4 o1a = (t1a * c0 - t2a * s0) * sc, o1b = (t1b * c1 - t2b * s1) * sc, o2a = (t1a * s0 + t2a * c0) * sc, o2b = (t1b * s1 + t2b * c1) * sc;
                    v4u w1, w2; w1.x = pk2(o1a[0], o1a[1]); w1.y = pk2(o1a[2], o1a[3]); w1.z = pk2(o1b[0], o1b[1]); w1.w = pk2(o1b[2], o1b[3]);
                    w2.x = pk2(o2a[0], o2a[1]); w2.y = pk2(o2a[2], o2a[3]); w2.z = pk2(o2b[0], o2b[1]); w2.w = pk2(o2b[2], o2b[3]);
                    bf16* rp = dst + (size_t)row * 1024 + hd * 256 + f0;
                    *(v4u*)rp = w1; *(v4u*)(rp + 128) = w2;
                    asm volatile("" ::: "memory");
                }
        } else {
            const int col0 = (u.pn - 24) * 256 + wc * 32 + fq * 8;
#pragma unroll
            for (int ai = 0; ai < 2; ++ai)
#pragma unroll
                for (int m = 0; m < 4; ++m) {
                    const int row = row0 + ai * 128 + m * 16; const float rs = rstd[row];
#pragma unroll
                    for (int bj = 0; bj < 2; ++bj) { const f32x4 a = acc[ai][bj][m][0] * rs, b = acc[ai][bj][m][1] * rs;
                        v4u w; w.x = pk2(a[0], a[1]); w.y = pk2(a[2], a[3]); w.z = pk2(b[0], b[1]); w.w = pk2(b[2], b[3]);
                        *(v4u*)(V + (size_t)row * 2048 + col0 + bj * 128) = w; }
                    asm volatile("" ::: "memory");
                }
        }
    }
};
struct EpiB {
    static constexpr bool PERM = false, AFTER_DRAIN = false;
    const float* rstd; const float* ssq; bf16* O; bf16* SG;
    __device__ __forceinline__ void operator()(const f32x4 (&acc)[2][2][4][2], const Unit& u, int wr, int wc, int fr, int fq) const {
        const int row0 = u.pm * 256 + wr * 64 + fr;
        if (u.pn < 8) {
            const int hd = u.pn >> 1, col0 = u.pn * 256 + wc * 32 + fq * 8;
#pragma unroll
            for (int ai = 0; ai < 2; ++ai)
#pragma unroll
                for (int m = 0; m < 4; ++m) {
                    const int row = row0 + ai * 128 + m * 16; const float rs = rstd[row];
                    const float rg = rsqrtf(ssq[(size_t)row * 4 + hd] * (1.0f / 512.0f) + EPS);
#pragma unroll
                    for (int bj = 0; bj < 2; ++bj) {
                        bf16* op = O + (size_t)row * 2048 + col0 + bj * 128; const v4u ov = *(const v4u*)op;
                        const f32x4 za = acc[ai][bj][m][0] * rs, zb = acc[ai][bj][m][1] * rs;
                        float r[8];
                        r[0] = bf_lo(ov.x) * rg * za[0] * sigm(za[0]); r[1] = bf_hi(ov.x) * rg * za[1] * sigm(za[1]);
                        r[2] = bf_lo(ov.y) * rg * za[2] * sigm(za[2]); r[3] = bf_hi(ov.y) * rg * za[3] * sigm(za[3]);
                        r[4] = bf_lo(ov.z) * rg * zb[0] * sigm(zb[0]); r[5] = bf_hi(ov.z) * rg * zb[1] * sigm(zb[1]);
                        r[6] = bf_lo(ov.w) * rg * zb[2] * sigm(zb[2]); r[7] = bf_hi(ov.w) * rg * zb[3] * sigm(zb[3]);
                        v4u w; w.x = pk2(r[0], r[1]); w.y = pk2(r[2], r[3]); w.z = pk2(r[4], r[5]); w.w = pk2(r[6], r[7]);
                        *(v4u*)op = w;
                    }
                    asm volatile("" ::: "memory");
                }
        } else {
            const int col0 = (u.pn - 8) * 256 + wc * 32 + fq * 8;
#pragma unroll
            for (int ai = 0; ai < 2; ++ai)
#pragma unroll
                for (int m = 0; m < 4; ++m) {
                    const int row = row0 + ai * 128 + m * 16; const float rs = rstd[row];
#pragma unroll
                    for (int bj = 0; bj < 2; ++bj) { const f32x4 a = acc[ai][bj][m][0] * rs, b = acc[ai][bj][m][1] * rs;
                        v4u w; w.x = pk2(sigm(a[0]), sigm(a[1])); w.y = pk2(sigm(a[2]), sigm(a[3])); w.z = pk2(sigm(b[0]), sigm(b[1])); w.w = pk2(sigm(b[2]), sigm(b[3]));
                        *(v4u*)(SG + (size_t)row * 2048 + col0 + bj * 128) = w; }
                    asm volatile("" ::: "memory");
                }
        }
    }
};
struct EpiYA {
    static constexpr bool PERM = false, AFTER_DRAIN = false;
    const bf16* SG; float* YAG;
    __device__ __forceinline__ void operator()(const f32x4 (&acc)[2][2][4][2], const Unit& u, int wr, int wc, int fr, int fq) const {
        const int row0 = u.pm * 256 + wr * 64 + fr, col0 = u.pn * 256 + wc * 32 + fq * 8;
#pragma unroll
        for (int ai = 0; ai < 2; ++ai)
#pragma unroll
            for (int m = 0; m < 4; ++m) { const int row = row0 + ai * 128 + m * 16;
#pragma unroll
                for (int bj = 0; bj < 2; ++bj) { const v4u g = *(const v4u*)(SG + (size_t)row * 2048 + col0 + bj * 128);
                    f32x4 a = acc[ai][bj][m][0], b = acc[ai][bj][m][1];
                    a[0] *= bf_lo(g.x); a[1] *= bf_hi(g.x); a[2] *= bf_lo(g.y); a[3] *= bf_hi(g.y); b[0] *= bf_lo(g.z); b[1] *= bf_hi(g.z); b[2] *= bf_lo(g.w); b[3] *= bf_hi(g.w);
                    float* yp = YAG + (size_t)row * 1024 + col0 + bj * 128; *(f32x4*)yp = a; *(f32x4*)(yp + 4) = b; } asm volatile("" ::: "memory"); }
    }
};
struct EpiMG {
    static constexpr bool PERM = false, AFTER_DRAIN = false;
    const bf16* SG; const float* YAG; bf16* MG;
    __device__ __forceinline__ void operator()(const f32x4 (&acc)[2][2][4][2], const Unit& u, int wr, int wc, int fr, int fq) const {
        const int row0 = u.pm * 256 + wr * 64 + fr, col0 = u.pn * 256 + wc * 32 + fq * 8;
#pragma unroll
        for (int ai = 0; ai < 2; ++ai)
#pragma unroll
            for (int m = 0; m < 4; ++m) { const int row = row0 + ai * 128 + m * 16;
#pragma unroll
                for (int bj = 0; bj < 2; ++bj) { const v4u g = *(const v4u*)(SG + (size_t)row * 2048 + 1024 + col0 + bj * 128);
                    const float* yp = YAG + (size_t)row * 1024 + col0 + bj * 128; f32x4 a = *(const f32x4*)yp, b = *(const f32x4*)(yp + 4);
                    const f32x4 ca = acc[ai][bj][m][0], cb = acc[ai][bj][m][1];
                    a[0] += ca[0] * bf_lo(g.x); a[1] += ca[1] * bf_hi(g.x); a[2] += ca[2] * bf_lo(g.y); a[3] += ca[3] * bf_hi(g.y);
                    b[0] += cb[0] * bf_lo(g.z); b[1] += cb[1] * bf_hi(g.z); b[2] += cb[2] * bf_lo(g.w); b[3] += cb[3] * bf_hi(g.w);
                    v4u w; w.x = pk2(a[0], a[1]); w.y = pk2(a[2], a[3]); w.z = pk2(b[0], b[1]); w.w = pk2(b[2], b[3]);
                    *(v4u*)(MG + (size_t)row * 1024 + col0 + bj * 128) = w; } asm volatile("" ::: "memory"); }
    }
};
struct EpiRes {
    static constexpr bool PERM = false, AFTER_DRAIN = false;
    const float* xres; float* xout;
    __device__ __forceinline__ void operator()(const f32x4 (&acc)[2][2][4][2], const Unit& u, int wr, int wc, int fr, int fq) const {
        const int row0 = u.pm * 256 + wr * 64 + fr, col0 = u.pn * 256 + wc * 32 + fq * 4;
#pragma unroll
        for (int ai = 0; ai < 2; ++ai)
#pragma unroll
            for (int m = 0; m < 4; ++m) { const size_t off = (size_t)(row0 + ai * 128 + m * 16) * 1024 + col0;
#pragma unroll
                for (int bj = 0; bj < 2; ++bj)
#pragma unroll
                    for (int n = 0; n < 2; ++n) { const f32x4 r = *(const f32x4*)(xres + off + bj * 128 + n * 16); *(f32x4*)(xout + off + bj * 128 + n * 16) = r + acc[ai][bj][m][n]; } asm volatile("" ::: "memory"); }
    }
};
#define XB_TMO      128
#define XB_XCNT(j)  (256  + 64 * (j))
#define XB_XSUB(j)  (1280 + 64 * (j))
#define XB_XGEN(j)  (2304 + 64 * (j))
#define XB_TOP      3328
#define XB_TOPGEN   3392
#define XCD_BAR_WORDS 3456
#define XB_SPIN_CAP (1u << 18)

__device__ __forceinline__ unsigned xb_ld(unsigned* p)              { return __hip_atomic_load(p, __ATOMIC_RELAXED, __HIP_MEMORY_SCOPE_AGENT); }
__device__ __forceinline__ unsigned xb_add(unsigned* p, unsigned v) { return __hip_atomic_fetch_add(p, v, __ATOMIC_RELAXED, __HIP_MEMORY_SCOPE_AGENT); }
__device__ __forceinline__ unsigned xb_xcc_id() { return (unsigned)__builtin_amdgcn_s_getreg((3 << 11) | 20) & 0xFu; }
#define XB_SPIN(cond, bar) do { unsigned _sp = 0; while (cond) { __builtin_amdgcn_s_sleep(1); \
    if ((++_sp & 255u) == 0u) { if (xb_ld(&(bar)[XB_TMO])) break; if (_sp > XB_SPIN_CAP) { atomicAdd(&(bar)[XB_TMO], 1u); break; } } } } while (0)

struct XcdBarrier {
    unsigned* bar; unsigned x;
    volatile LAS unsigned* st;
};

__device__ __forceinline__ XcdBarrier xcd_barrier_post(unsigned* bar, volatile LAS unsigned* st) {
    XcdBarrier b; b.bar = bar; b.x = xb_xcc_id(); b.st = st;
    if (threadIdx.x == 0) (void)xb_add(&bar[XB_XCNT(b.x)], 1u);
    return b;
}
__device__ __forceinline__ void xcd_barrier_complete(unsigned* bar, unsigned x, unsigned& nloc, unsigned& nx) {
    const unsigned G = gridDim.x * gridDim.y * gridDim.z;
    unsigned sum, cnt, mine, sp = 0u;
    for (;;) {
        sum = 0u; cnt = 0u; mine = 0u;
#pragma unroll
        for (unsigned j = 0; j < 16; ++j) { const unsigned c = xb_ld(&bar[XB_XCNT(j)]); sum += c; cnt += (c > 0u) ? 1u : 0u; mine = (j == x) ? c : mine; }
        if (sum == G) break;
        __builtin_amdgcn_s_sleep(1);
        if ((++sp & 255u) == 0u) { if (xb_ld(&bar[XB_TMO])) break; if (sp > XB_SPIN_CAP) { atomicAdd(&bar[XB_TMO], 1u); break; } }
    }
    nloc = mine > 0u ? mine : 1u; nx = cnt > 0u ? cnt : 1u;
}

__device__ __forceinline__ void xcd_barrier(const XcdBarrier& b) {
    asm volatile("s_waitcnt vmcnt(0)" ::: "memory");
    __syncthreads();
    if (threadIdx.x == 0) {
        unsigned* bar = b.bar;
        __builtin_amdgcn_s_waitcnt(0);
        unsigned nloc = b.st[0], nx = b.st[1];
        if (nloc == 0u) { xcd_barrier_complete(bar, b.x, nloc, nx); b.st[0] = nloc; b.st[1] = nx; }
        const unsigned old = xb_add(&bar[XB_XSUB(b.x)], 1u);
        const unsigned gen = old / nloc;
        if (old + 1u == (gen + 1u) * nloc) {
            __builtin_amdgcn_fence(__ATOMIC_RELEASE, "agent");
            asm volatile("s_waitcnt vmcnt(0)" ::: "memory");
            const unsigned og = xb_add(&bar[XB_TOP], 1u);
            const unsigned tg = og / nx;
            if (og + 1u == (tg + 1u) * nx) xb_add(&bar[XB_TOPGEN], 1u);
            else XB_SPIN(xb_ld(&bar[XB_TOPGEN]) == tg, bar);
            __builtin_amdgcn_fence(__ATOMIC_ACQUIRE, "agent");
            xb_add(&bar[XB_XGEN(b.x)], 1u);
            asm volatile("s_waitcnt vmcnt(0)" ::: "memory");
        } else {
            XB_SPIN(xb_ld(&bar[XB_XGEN(b.x)]) == gen, bar);
            __builtin_amdgcn_fence(__ATOMIC_ACQUIRE, "agent");
            asm volatile("s_waitcnt vmcnt(0)" ::: "memory");
        }
    }
    __syncthreads();
}

struct Frame {
    LAS unsigned char* lds; volatile LAS unsigned* MISC; gu32* ctl;
    int tid, lane, wave, vcu, G;
    const float* in[9]; float* out; unsigned char* ws;
};
__device__ __forceinline__ float wave_sum(float v) {
#pragma unroll
    for (int o = 1; o < 64; o <<= 1) v += __shfl_xor(v, o);
    return v;
}
__device__ __forceinline__ int prow(int mode, int n) {
    if (mode == 0) return n;
    if (mode == 2 && n < 4096) { const int type = n >> 10, chg = n & 1023, pc = chg >> 6, ch = chg & 63;
        return 256 * pc + 128 * (type >> 1) + 32 * (ch >> 4) + 16 * (type & 1) + 4 * ((ch >> 2) & 3) + (ch & 3); }
    const int l32 = n & 31; return (n & ~31) | (16 * ((l32 >> 2) & 1) + 4 * (l32 >> 3) + (l32 & 3));
}
__device__ __forceinline__ void cvt_item(const float* W, int K, int N, bf16* WT, const float* gk, int mode, LAS float* scr, int item, int lane) {
    const int nblk = N / 32, kb = item / nblk, nb = item % nblk, k0 = 64 * kb, n0 = 32 * nb;
#pragma unroll 8
    for (int i = 0; i < 32; ++i) { const int kk = 2 * i + (lane >> 5); float v = W[(size_t)(k0 + kk) * N + n0 + (lane & 31)]; if (gk) v *= gk[k0 + kk]; scr[kk * 33 + (lane & 31)] = v; }
    LDS_WAIT(); asm volatile("" ::: "memory");
    const int c = lane & 7;
#pragma unroll
    for (int j = 0; j < 4; ++j) { const int n = (lane >> 3) + 8 * j; const LAS float* s = scr + (8 * c) * 33 + n;
        v4u o; o.x = pk2(s[0 * 33], s[1 * 33]); o.y = pk2(s[2 * 33], s[3 * 33]); o.z = pk2(s[4 * 33], s[5 * 33]); o.w = pk2(s[6 * 33], s[7 * 33]);
        *(GAS v4u*)(WT + (size_t)prow(mode, n0 + n) * K + k0 + 8 * c) = o; }
    LDS_WAIT(); asm volatile("" ::: "memory");
}
__device__ __forceinline__ void convert_layer(Frame& F, int l, unsigned char* region) {
    LAS float* scr = (LAS float*)(F.lds + F.wave * 16384);
    const int gw = F.vcu * NWAVES + F.wave, NGW = F.G * NWAVES;
    constexpr int I_IN = (D / 64) * (DIN / 32), I_A = (D / 64) * (D / 32), I_B = (2 * D / 64) * (D / 32), I_O = I_A;
    const float* w_in = F.in[2] + (size_t)l * D * DIN; const float* ng = F.in[1] + (size_t)l * D;
    const float* w_a = F.in[5] + (size_t)l * D * D; const float* w_b = F.in[6] + (size_t)l * 2 * D * D; const float* w_o = F.in[7] + (size_t)l * D * D;
    for (int it = gw; it < I_IN + I_A + I_B + I_O; it += NGW) {
        int r = it;
        if (r < I_IN) { cvt_item(w_in, D, DIN, (bf16*)(region + RW_IN), ng, 2, scr, r, F.lane); continue; } r -= I_IN;
        if (r < I_A) { cvt_item(w_a, D, D, (bf16*)(region + RW_A), nullptr, 1, scr, r, F.lane); continue; } r -= I_A;
        if (r < I_B) { cvt_item(w_b, 2 * D, D, (bf16*)(region + RW_B), nullptr, 1, scr, r, F.lane); continue; } r -= I_B;
        cvt_item(w_o, D, D, (bf16*)(region + RW_O), nullptr, 0, scr, r, F.lane);
    }
}
__device__ __forceinline__ void rownorm(Frame& F, const float* src, bf16* xb, float* rstd) {
    const int gw = F.vcu * NWAVES + F.wave, NGW = F.G * NWAVES;
    for (int m = gw; m < M; m += NGW) {
        const GAS f32x4* xr = (const GAS f32x4*)(src + (size_t)m * D) + F.lane;
        f32x4 v[4]; float s = 0.f;
#pragma unroll
        for (int j = 0; j < 4; ++j) { v[j] = xr[64 * j]; s += (v[j].x * v[j].x + v[j].y * v[j].y) + (v[j].z * v[j].z + v[j].w * v[j].w); }
        s = wave_sum(s);
        if (F.lane == 0) rstd[m] = rsqrtf(s * (1.f / D) + EPS);
        GAS v2u* o8 = (GAS v2u*)(xb + (size_t)m * D) + F.lane;
#pragma unroll
        for (int j = 0; j < 4; ++j) { v2u w; w.x = pk2(v[j].x, v[j].y); w.y = pk2(v[j].z, v[j].w); o8[64 * j] = w; }
    }
}
__device__ __forceinline__ void final_norm(Frame& F, float* x, const float* g) {
    const int gw = F.vcu * NWAVES + F.wave, NGW = F.G * NWAVES;
    for (int m = gw; m < M; m += NGW) {
        GAS f32x4* xr = (GAS f32x4*)(x + (size_t)m * D) + F.lane; const GAS f32x4* gr = (const GAS f32x4*)g + F.lane;
        f32x4 v[4]; float s = 0.f;
#pragma unroll
        for (int j = 0; j < 4; ++j) { v[j] = xr[64 * j]; s += (v[j].x * v[j].x + v[j].y * v[j].y) + (v[j].z * v[j].z + v[j].w * v[j].w); }
        const float r = rsqrtf(wave_sum(s) * (1.f / D) + EPS);
#pragma unroll
        for (int j = 0; j < 4; ++j) xr[64 * j] = v[j] * r * gr[64 * j];
    }
}
__device__ __forceinline__ void rotary_tables(Frame& F, float* cosT, float* sinT) {
    const int gt = F.vcu * (NWAVES * 64) + F.tid, NT = F.G * NWAVES * 64;
    for (int idx = gt; idx < T * 128; idx += NT) {
        const int pos = idx >> 7, f = idx & 127;
        double inv = 1.0, bq = 0.930572040929699;
#pragma unroll
        for (int bit = 0; bit < 7; ++bit) { if ((f >> bit) & 1) inv *= bq; bq *= bq; }
        const double a = (double)pos * inv;
        const double kd = __builtin_rint(a * 0.6366197723675814);
        const double r = (a - kd * 1.5707963267948966) - kd * 6.123233995736766e-17;
        const double r2 = r * r;
        double sp = -1.0 / 355687428096000.0;
        sp = sp * r2 + 1.0 / 1307674368000.0; sp = sp * r2 - 1.0 / 6227020800.0; sp = sp * r2 + 1.0 / 39916800.0; sp = sp * r2 - 1.0 / 362880.0;
        sp = sp * r2 + 1.0 / 5040.0; sp = sp * r2 - 1.0 / 120.0; sp = sp * r2 + 1.0 / 6.0; const double sn = r - r * r2 * sp;
        double cp = 1.0 / 20922789888000.0;
        cp = cp * r2 - 1.0 / 87178291200.0; cp = cp * r2 + 1.0 / 479001600.0; cp = cp * r2 - 1.0 / 3628800.0; cp = cp * r2 + 1.0 / 40320.0;
        cp = cp * r2 - 1.0 / 720.0; cp = cp * r2 + 1.0 / 24.0; cp = cp * r2 - 0.5; const double cs = 1.0 + r2 * cp;
        const int k = (int)kd & 3;
        const double c = (k == 0) ? cs : (k == 1) ? -sn : (k == 2) ? -cs : sn;
        const double s = (k == 0) ? sn : (k == 1) ? cs : (k == 2) ? -sn : -cs;
        cosT[idx] = (float)c; sinT[idx] = (float)s;
    }
}
__device__ __forceinline__ void conv_pass(Frame& F, const bf16* U, bf16* BZ, const float* cw, const float* cb) {
    const int gt = F.vcu * (NWAVES * 64) + F.tid, NT = F.G * NWAVES * 64;
    for (int v = gt; v < M * 128; v += NT) {
        const int row = v >> 7, c8 = (v & 127) * 8, t = row & (T - 1);
        const v4u z4 = {0u, 0u, 0u, 0u};
        const v4u u0 = *(const v4u*)(U + (size_t)row * 1024 + c8);
        const v4u u1 = t >= 1 ? *(const v4u*)(U + (size_t)(row - 1) * 1024 + c8) : z4;
        const v4u u2 = t >= 2 ? *(const v4u*)(U + (size_t)(row - 2) * 1024 + c8) : z4;
        bf16* bp = BZ + (size_t)row * 1024 + c8; const v4u bz = *(const v4u*)bp;
        float w0[8], w1[8], w2[8], bb[8];
        *(f32x4*)&w0[0] = *(const f32x4*)(cw + c8); *(f32x4*)&w0[4] = *(const f32x4*)(cw + c8 + 4);
        *(f32x4*)&w1[0] = *(const f32x4*)(cw + 1024 + c8); *(f32x4*)&w1[4] = *(const f32x4*)(cw + 1024 + c8 + 4);
        *(f32x4*)&w2[0] = *(const f32x4*)(cw + 2048 + c8); *(f32x4*)&w2[4] = *(const f32x4*)(cw + 2048 + c8 + 4);
        *(f32x4*)&bb[0] = *(const f32x4*)(cb + c8); *(f32x4*)&bb[4] = *(const f32x4*)(cb + c8 + 4);
        float y[8];
#pragma unroll
        for (int i = 0; i < 4; ++i) {
            const unsigned a0 = u0[i], a1 = u1[i], a2 = u2[i], bzz = bz[i];
            y[2 * i]     = bf_lo(bzz) * (w0[2 * i] * bf_lo(a2) + w1[2 * i] * bf_lo(a1) + w2[2 * i] * bf_lo(a0) + bb[2 * i]);
            y[2 * i + 1] = bf_hi(bzz) * (w0[2 * i + 1] * bf_hi(a2) + w1[2 * i + 1] * bf_hi(a1) + w2[2 * i + 1] * bf_hi(a0) + bb[2 * i + 1]);
        }
        v4u w; w.x = pk2(y[0], y[1]); w.y = pk2(y[2], y[3]); w.z = pk2(y[4], y[5]); w.w = pk2(y[6], y[7]);
        *(v4u*)bp = w;
    }
}
constexpr int CH_KSTR = 576, CH_VSTR = 64, CH_VOFF = 128 * CH_KSTR;
__device__ __forceinline__ void chain_item(Frame& F, int bh, int sl, const bf16* KT, const bf16* V, bf16* ST) {
    int tid_ = F.tid; asm volatile("" : "+v"(tid_));
    const int b = bh >> 2, h = bh & 3, tid = tid_, lane = tid & 63, w = __builtin_amdgcn_readfirstlane(tid >> 6);
    const int hl = lane >> 5, l31 = lane & 31, q = (lane & 15) >> 2, p = lane & 3, blk = (lane >> 4) & 1;
    LAS char* Kt = (LAS char*)F.lds; LAS char* Vt = Kt + CH_VOFF;
    const float g512 = exp2f(512.0f * log2_gamma(h));
    f32x16 S;
#pragma unroll
    for (int i = 0; i < 16; ++i) S[i] = 0.f;
    bf16* STb = ST + (size_t)bh * 8 * 512 * 256;
    for (int s = 0; s < 8; ++s) {
#pragma unroll
        for (int g = 0; g < 4; ++g) { v2u w2; w2.x = pk2(S[4 * g], S[4 * g + 1]); w2.y = pk2(S[4 * g + 2], S[4 * g + 3]);
            *(v2u*)(STb + ((size_t)s * 512 + sl * 32 + l31) * 256 + w * 32 + 8 * g + 4 * hl) = w2; }
        if (s == 7) break;
        for (int kb = 0; kb < 4; ++kb) {
            const size_t rowbase = (size_t)b * T + s * 512 + kb * 128;
            __syncthreads();
#pragma unroll
            for (int i = 0; i < 8; ++i) { const int id = tid + 512 * i, r = id >> 5, c = id & 31;
                const v4u x = *(const v4u*)(KT + (rowbase + r) * 1024 + h * 256 + c * 8); *(LAS v4u*)(Kt + r * CH_KSTR + c * 16) = x; }
            { const int r = tid >> 2, c = tid & 3; const v4u x = *(const v4u*)(V + (rowbase + r) * 2048 + h * 512 + sl * 32 + c * 8); *(LAS v4u*)(Vt + r * CH_VSTR + c * 16) = x; }
            __syncthreads();
#pragma unroll
            for (int ks = 0; ks < 8; ++ks) {
                const int kr = 16 * ks + 8 * hl + q;
                const bf16x8 A = trpair(Kt + kr * CH_KSTR + 2 * (32 * w + 16 * blk + 4 * p), 4 * CH_KSTR);
                const bf16x8 B = trpair(Vt + kr * CH_VSTR + 2 * (16 * blk + 4 * p), 4 * CH_VSTR);
                S = MFMA32(A, B, S);
            }
        }
#pragma unroll
        for (int i = 0; i < 16; ++i) S[i] *= g512;
    }
}
constexpr int AP_KSTR = 528, AP_VSTR = 1088, AP_VOFF = 64 * AP_KSTR, AP_RED = AP_VOFF + 64 * AP_VSTR;
__device__ __forceinline__ void apply_item(Frame& F, int bh, int r, const bf16* QT, const bf16* KT, const bf16* V, const bf16* ST, bf16* O, float* ssq) {
    int tid_ = F.tid; asm volatile("" : "+v"(tid_));
    const int b = bh >> 2, h = bh & 3, tid = tid_, lane = tid & 63, w = __builtin_amdgcn_readfirstlane(tid >> 6);
    const int hl = lane >> 5, l31 = lane & 31, q = (lane & 15) >> 2, p = lane & 3, blk = (lane >> 4) & 1;
    const int ig = w & 3, dh = w >> 2, s = r >> 2, t0 = r * 128;
    LAS char* Ks = (LAS char*)F.lds; LAS char* Vs = Ks + AP_VOFF; LAS float* red = (LAS float*)(Ks + AP_RED);
    f32x16 acc[8];
#pragma unroll
    for (int mt = 0; mt < 8; ++mt)
#pragma unroll
        for (int i = 0; i < 16; ++i) acc[mt][i] = 0.f;
    const bf16* qrow = QT + ((size_t)b * T + t0 + 32 * ig + l31) * 1024 + h * 256 + 8 * hl;
    for (int rp = 4 * s; rp <= r; ++rp) {
        const bool diag = (rp == r);
        for (int half = 0; half < 2; ++half) {
            const size_t keybase = (size_t)b * T + rp * 128 + half * 64;
            __syncthreads();
#pragma unroll
            for (int i = 0; i < 4; ++i) { const int id = tid + 512 * i, rr = id >> 5, c = id & 31;
                const v4u x = *(const v4u*)(KT + (keybase + rr) * 1024 + h * 256 + c * 8); *(LAS v4u*)(Ks + rr * AP_KSTR + c * 16) = x; }
#pragma unroll
            for (int i = 0; i < 8; ++i) { const int id = tid + 512 * i, rr = id >> 6, c = id & 63;
                const v4u x = *(const v4u*)(V + (keybase + rr) * 2048 + h * 512 + c * 8); *(LAS v4u*)(Vs + rr * AP_VSTR + c * 16) = x; }
            __syncthreads();
            for (int jt = 0; jt < 2; ++jt) {
                const int kt = 2 * half + jt;
                if (diag && kt > ig) continue;
                f32x16 X;
#pragma unroll
                for (int i = 0; i < 16; ++i) X[i] = 0.f;
#pragma unroll
                for (int ks = 0; ks < 16; ++ks) {
                    const bf16x8 A = *(const LAS bf16x8*)(Ks + (32 * jt + l31) * AP_KSTR + (16 * ks + 8 * hl) * 2);
                    const bf16x8 B = *(const bf16x8*)(qrow + 16 * ks);
                    X = MFMA32(A, B, X);
                }
                if (diag && kt == ig) {
#pragma unroll
                    for (int i = 0; i < 16; ++i) if (crow(i, hl) > l31) X[i] = 0.f;
                }
                v4u p0, p1;
                p0.x = pk2(X[0], X[1]); p0.y = pk2(X[2], X[3]); p0.z = pk2(X[4], X[5]); p0.w = pk2(X[6], X[7]);
                p1.x = pk2(X[8], X[9]); p1.y = pk2(X[10], X[11]); p1.z = pk2(X[12], X[13]); p1.w = pk2(X[14], X[15]);
                const bf16x8 P0 = __builtin_bit_cast(bf16x8, p0), P1 = __builtin_bit_cast(bf16x8, p1);
                const LAS char* vb = Vs + (32 * jt + 4 * hl + q) * AP_VSTR + 2 * (256 * dh + 16 * blk + 4 * p);
#pragma unroll
                for (int mt = 0; mt < 8; ++mt) {
                    const bf16x8 A0 = trpair(vb + 64 * mt, 8 * AP_VSTR);
                    const bf16x8 A1 = trpair(vb + 64 * mt + 16 * AP_VSTR, 8 * AP_VSTR);
                    acc[mt] = MFMA32(A0, P0, acc[mt]);
                    acc[mt] = MFMA32(A1, P1, acc[mt]);
                }
            }
        }
    }
    {
        const bf16* stp = ST + ((size_t)(bh * 8 + s) * 512 + 256 * dh + l31) * 256 + 8 * hl;
#pragma unroll 1
        for (int ks = 0; ks < 16; ++ks) {
            const bf16x8 B = *(const bf16x8*)(qrow + 16 * ks);
#pragma unroll
            for (int mt = 0; mt < 8; ++mt) { const bf16x8 A = *(const bf16x8*)(stp + (size_t)mt * 32 * 256 + 16 * ks); acc[mt] = MFMA32(A, B, acc[mt]); }
        }
    }
    float ss = 0.f;
#pragma unroll
    for (int mt = 0; mt < 8; ++mt)
#pragma unroll
        for (int i = 0; i < 16; ++i) ss += acc[mt][i] * acc[mt][i];
    ss += __shfl_xor(ss, 32);
    __syncthreads();
    if (hl == 0) red[dh * 128 + 32 * ig + l31] = ss;
    bf16* orow = O + ((size_t)b * T + t0 + 32 * ig + l31) * 2048 + h * 512 + 256 * dh + 4 * hl;
#pragma unroll
    for (int mt = 0; mt < 8; ++mt)
#pragma unroll
        for (int g = 0; g < 4; ++g) { v2u w2; w2.x = pk2(acc[mt][4 * g], acc[mt][4 * g + 1]); w2.y = pk2(acc[mt][4 * g + 2], acc[mt][4 * g + 3]); *(v2u*)(orow + 32 * mt + 8 * g) = w2; }
    __syncthreads();
    if (tid < 128) ssq[((size_t)b * T + t0 + tid) * 4 + h] = red[tid] + red[128 + tid];
}

struct Args { const float* in[9]; float* out; unsigned char* ws; int ph_lo, ph_hi, li, pad; };
__global__ void __launch_bounds__(NWAVES * 64, 2) fwd_kernel(Args args) {
    extern __shared__ __attribute__((aligned(16))) unsigned char lds[];
    Frame F;
    F.lds = (LAS unsigned char*)lds; F.MISC = (volatile LAS unsigned*)(F.lds + MISC_OFF);
    F.tid = threadIdx.x; F.lane = F.tid & 63; F.wave = __builtin_amdgcn_readfirstlane(F.tid >> 6);
    F.G = gridDim.x; { const int bx = blockIdx.x; F.vcu = (F.G % 8 == 0) ? (bx % 8) * (F.G / 8) + bx / 8 : bx; }
    F.ws = args.ws; F.ctl = (gu32*)(args.ws + WS_CTL); F.out = args.out;
#pragma unroll
    for (int i = 0; i < 9; ++i) F.in[i] = args.in[i];
    for (int u = F.tid; u < (LDS_BYTES - LDSCTL_OFF) / 4; u += NWAVES * 64) ((LAS unsigned*)(F.lds + LDSCTL_OFF))[u] = 0u;
    __syncthreads();
    XcdBarrier bar; bar.bar = (unsigned*)(F.ctl + CW_BAR); bar.x = 0; bar.st = nullptr;
    if (N_LAUNCHES == 1) bar = xcd_barrier_post((unsigned*)(F.ctl + CW_BAR), F.MISC + 8);
    const int lo = args.ph_lo, hi = args.ph_hi;
#define IN(k) (lo <= (k) && (k) < hi)
#define SEAM(k) do { if (IN(k) && IN((k) + 1)) xcd_barrier(bar); } while (0)
#define PHASE_PTRS() unsigned long long z0_ = 0ull; asm volatile("" : "+s"(z0_)); unsigned char* ws = args.ws + z0_; \
    Frame P = F; { int t_ = threadIdx.x; asm volatile("" : "+v"(t_)); P.tid = t_; P.lane = t_ & 63; P.wave = __builtin_amdgcn_readfirstlane(t_ >> 6); } \
    float* cosT = (float*)(ws + WS_COS); float* sinT = (float*)(ws + WS_SIN); float* rstd = (float*)(ws + WS_RSTD); float* ssq = (float*)(ws + WS_SSQ); \
    bf16* XB = (bf16*)(ws + WS_XB); bf16* U = (bf16*)(ws + WS_U); bf16* BZ = (bf16*)(ws + WS_BZ); bf16* QT = (bf16*)(ws + WS_QT); bf16* KT = (bf16*)(ws + WS_KT); \
    bf16* V = (bf16*)(ws + WS_V); bf16* O = (bf16*)(ws + WS_O); bf16* SG = (bf16*)(ws + WS_SG); float* YAG = (float*)(ws + WS_YAG); bf16* MG = (bf16*)(ws + WS_MG); \
    unsigned char* RW = ws + ((l & 1) ? WS_R2 : WS_R1); unsigned char* RS = ws + ((l & 1) ? WS_R1 : WS_R2); bf16* ST = (bf16*)RS; \
    (void)cosT; (void)sinT; (void)rstd; (void)ssq; (void)XB; (void)U; (void)BZ; (void)QT; (void)KT; (void)V; (void)O; (void)SG; (void)YAG; (void)MG; (void)RW; (void)RS; (void)ST

    if (IN(0)) {
        const int l = 0; PHASE_PTRS();
        convert_layer(P, 0, ws + WS_R1);
        rotary_tables(P, cosT, sinT);
        rownorm(P, args.in[0], XB, rstd);
    }
    SEAM(0);
#pragma unroll 1
    for (int l = 0; l < DEPTH; ++l) {
        const int pb = 1 + 7 * l;
        if (IN(pb + 0)) {
            PHASE_PTRS();
            pg8::Gemm g{XB, (const bf16*)(RW + RW_IN), M, NA, D}; pg8::StaticOrder S; S.init(M, NA, F.G, (int)blockIdx.x);
            EpiA E{rstd, cosT, sinT, U, BZ, QT, KT, V};
            pg8::gemm_phase<EpiA, pg8::StaticOrder, true, true>(F.lds, g, S, E);
        }
        SEAM(pb + 0);
        if (IN(pb + 1)) {
            PHASE_PTRS();
            if (F.G == 256) chain_item(P, F.vcu >> 4, F.vcu & 15, KT, V, ST);
            else for (int it = F.vcu; it < 256; it += F.G) chain_item(P, it >> 4, it & 15, KT, V, ST);
            conv_pass(P, U, BZ, args.in[3] + (size_t)l * 3 * D, args.in[4] + (size_t)l * D);
        }
        SEAM(pb + 1);
        if (IN(pb + 2)) {
            PHASE_PTRS();
            for (int pr = F.vcu; pr < 256; pr += F.G) {
                const int bh = pr >> 4, pi = pr & 15, s = pi >> 1;
                const int ra = (pi & 1) ? 4 * s + 1 : 4 * s + 0, rb = (pi & 1) ? 4 * s + 2 : 4 * s + 3;
#pragma unroll 1
                for (int k = 0; k < 2; ++k) apply_item(P, bh, k == 0 ? rb : ra, QT, KT, V, ST, O, ssq);
            }
        }
        SEAM(pb + 2);
        if (IN(pb + 3)) {
            PHASE_PTRS();
            if (l + 1 < DEPTH) { convert_layer(P, l + 1, RS); __syncthreads(); }
            pg8::Gemm g{XB, (const bf16*)(RW + RW_IN) + (size_t)NA * D, M, NB, D}; pg8::StaticOrder S; S.init(M, NB, F.G, (int)blockIdx.x);
            EpiB E{rstd, ssq, O, SG};
            pg8::gemm_phase<EpiB, pg8::StaticOrder, true, true>(F.lds, g, S, E);
        }
        SEAM(pb + 3);
        if (IN(pb + 4)) {
            PHASE_PTRS();
            { pg8::Gemm g{BZ, (const bf16*)(RW + RW_A), M, D, D}; pg8::StaticOrder S; S.init(M, D, F.G, (int)blockIdx.x);
              EpiYA E{SG, YAG}; pg8::gemm_phase<EpiYA, pg8::StaticOrder, false, true>(F.lds, g, S, E); }
            asm volatile("s_waitcnt vmcnt(0)" ::: "memory"); __syncthreads();
            { pg8::Gemm g{O, (const bf16*)(RW + RW_B), M, D, 2 * D}; pg8::StaticOrder S; S.init(M, D, F.G, (int)blockIdx.x);
              EpiMG E{SG, YAG, MG}; pg8::gemm_phase<EpiMG, pg8::StaticOrder, false, true>(F.lds, g, S, E); }
        }
        SEAM(pb + 4);
        if (IN(pb + 5)) {
            PHASE_PTRS();
            pg8::Gemm g{MG, (const bf16*)(RW + RW_O), M, D, D}; pg8::StaticOrder S; S.init(M, D, F.G, (int)blockIdx.x);
            EpiRes E{(l == 0) ? args.in[0] : (const float*)args.out, args.out}; pg8::gemm_phase<EpiRes, pg8::StaticOrder, false, true>(F.lds, g, S, E);
        }
        SEAM(pb + 5);
        if (IN(pb + 6)) {
            PHASE_PTRS();
            if (l + 1 < DEPTH) rownorm(P, args.out, XB, rstd);
            else final_norm(P, args.out, args.in[8]);
        }
        if (l + 1 < DEPTH) SEAM(pb + 6);
    }
#undef IN
#undef SEAM
}

extern "C" void kernel_launch(void* const* d_in, const int* in_sizes, int n_in, void* d_out, int out_size, void* d_ws, size_t ws_size, hipStream_t stream) {
    static int grid = 0;
    if (grid == 0) {
        if (n_in != 9 || in_sizes[0] != M * D || out_size != M * D || ws_size < WS_END) {
            fprintf(stderr, "kernel_launch: unexpected problem (n_in %d, in0 %d, out %d, ws %zu; need ws >= %zu); nothing launched\n", n_in, n_in > 0 ? in_sizes[0] : -1, out_size, ws_size, (size_t)WS_END); grid = -1; return; }
        int dev = 0, cus = 0, per_cu = 0;
        if (hipGetDevice(&dev) != hipSuccess || hipDeviceGetAttribute(&cus, hipDeviceAttributeMultiprocessorCount, dev) != hipSuccess) { grid = -1; return; }
        if (hipFuncSetAttribute((const void*)fwd_kernel, hipFuncAttributeMaxDynamicSharedMemorySize, LDS_BYTES) != hipSuccess) { fprintf(stderr, "kernel_launch: hipFuncSetAttribute failed\n"); grid = -1; return; }
        if (hipOccupancyMaxActiveBlocksPerMultiprocessor(&per_cu, (const void*)fwd_kernel, NWAVES * 64, LDS_BYTES) != hipSuccess || per_cu < 1) { fprintf(stderr, "kernel_launch: occupancy query says %d blocks per CU; nothing launched\n", per_cu); (void)hipGetLastError(); grid = -1; return; }
        grid = cus;
    }
    if (grid < 0) return;
    if (hipMemsetAsync((char*)d_ws + WS_CTL, 0, CTL_ZERO_BYTES, stream) != hipSuccess) return;
    Args a{};
    for (int i = 0; i < 9; ++i) a.in[i] = (const float*)d_in[i];
    a.out = (float*)d_out; a.ws = (unsigned char*)d_ws;
    if (N_LAUNCHES == 1) {
        a.ph_lo = 0; a.ph_hi = NPHASES; a.li = 0;
        hipLaunchKernelGGL(fwd_kernel, dim3(grid), dim3(NWAVES * 64), LDS_BYTES, stream, a);
    } else {
        for (int li = 0; li < NPHASES; ++li) { a.ph_lo = li; a.ph_hi = li + 1; a.li = li; hipLaunchKernelGGL(fwd_kernel, dim3(grid), dim3(NWAVES * 64), LDS_BYTES, stream, a); }
    }
}
```

```cpp
#include <hip/hip_runtime.h>
#include <cstdio>
#include <cstdint>
#ifndef N_LAUNCHES_DEFINED
#endif
namespace pg8 {
#define PG8_LAS __attribute__((address_space(3)))
typedef unsigned short bf16_t;
typedef short bf16x8 __attribute__((ext_vector_type(8)));
typedef float f32x4 __attribute__((ext_vector_type(4)));
typedef unsigned u32x4 __attribute__((ext_vector_type(4)));
constexpr int BM = 256, BK = 64, HALF = 128, HTB = HALF * BK * 2  , STAGE_BYTES = 8 * HTB, NXCD = 8, WGM = 8;

__host__ __device__ __forceinline__ int lds_byte(int r, int c) { const int st = (r >> 4) * 2 + (c >> 5), rr = r & 15, cc = c & 31, ob = rr * 64 + cc * 2; return st * 1024 + (ob ^ (((ob >> 9) & 1) << 5)); }
__host__ __device__ __forceinline__ void stage_rc(int b, int& R, int& C) { const int st = b / 1024, sb = b % 1024, swz = sb ^ (((sb >> 9) & 1) << 5); R = (st >> 1) * 16 + swz / 64; C = (st & 1) * 32 + (swz % 64) / 2; }
__host__ __device__ __forceinline__ int perm32(int rho) { const int n = rho >> 4, i = rho & 15; return 8 * (i >> 2) + 4 * n + (i & 3); }

struct Unit { int pm, pn; };
struct Gemm { const bf16_t* A; const bf16_t* Bt; int M, N, K; };

struct StaticOrder {
    int nM, nN, nwg, G, c;
    __host__ __device__ void init(int M, int N, int G_, int c_) { nM = M / BM; nN = N / BM; nwg = nM * nN; G = G_; c = c_; }
    __host__ __device__ bool next(int i, Unit& u) const {
        const long L = (long)i * G + c; if (L >= nwg) return false;
        int wgid = (int)L; { const int q = nwg / NXCD, r = nwg % NXCD, xcd = wgid % NXCD, off = wgid / NXCD; wgid = (xcd < r ? xcd * (q + 1) : r * (q + 1) + (xcd - r) * q) + off; }
        const int nig = WGM * nN, gid = wgid / nig, fm = gid * WGM, gsz = (nM - fm) < WGM ? (nM - fm) : WGM;
        u.pm = fm + ((wgid % nig) % gsz); u.pn = (wgid % nig) / gsz; return true;
    }
    __device__ __forceinline__ void a_ready(const Unit&) const {}
    __device__ __forceinline__ void done(const Unit&) const {}
};
__device__ __forceinline__ unsigned cvt_pk_bf16(float lo, float hi) { unsigned r; asm volatile("v_cvt_pk_bf16_f32 %0, %1, %2" : "=v"(r) : "v"(lo), "v"(hi)); return r; }
template <class Epi, class Sched, bool ALIGN_EPI = false, bool SP2 = false>
__device__ __forceinline__ void gemm_phase(PG8_LAS unsigned char* lds, const Gemm g, const Sched& S, const Epi& E) {
    int tid_ = threadIdx.x; asm volatile("" : "+v"(tid_));
    const int tid = tid_, wid = __builtin_amdgcn_readfirstlane(tid >> 6), lane = tid & 63, wr = wid >> 2, wc = wid & 3, fr = lane & 15, fq = lane >> 4;
    const int K = g.K, nt = K / BK;
    unsigned voffA[2], voffB[2];
#pragma unroll
    for (int i = 0; i < 2; ++i) { int R, C; stage_rc(tid * 16 + i * 8192, R, C); const int Rb = Epi::PERM ? ((R & ~31) + perm32(R & 31)) : R;
        voffA[i] = (unsigned)(R * K + C) * 2u; voffB[i] = (unsigned)(Rb * K + C) * 2u; }
    const size_t kstep = (size_t)(BK * 2);
    const size_t hstep = (size_t)HALF * K * 2;
    const size_t tstep = 2 * hstep;
    const unsigned ldsw = (unsigned)wid * 1024u;
    const int aoff = lds_byte(wr * 64 + fr, fq * 8), boff = lds_byte(wc * 32 + fr, fq * 8);
#define PG8_SA(b, h) (((b) * 2 + (h)) * HTB)
#define PG8_SB(b, h) ((4 + (b) * 2 + (h)) * HTB)
#define PG8_STAGE(bufoff, gbase, voff) do { _Pragma("unroll") for (int _i = 0; _i < 2; ++_i) \
        __builtin_amdgcn_global_load_lds((const unsigned*)((const char*)(gbase) + (voff)[_i]), (PG8_LAS unsigned*)(lds + (bufoff) + ldsw + _i * 8192), 16, 0, 0); } while (0)
#define PG8_LDA(dst, b, h) do { _Pragma("unroll") for (int m = 0; m < 4; ++m) _Pragma("unroll") for (int k = 0; k < 2; ++k) dst[m][k] = *(const PG8_LAS bf16x8*)(lds + PG8_SA(b, h) + aoff + m * 2048 + k * 1024); } while (0)
#define PG8_LDB(dst, b, h) do { _Pragma("unroll") for (int n = 0; n < 2; ++n) _Pragma("unroll") for (int k = 0; k < 2; ++k) dst[n][k] = *(const PG8_LAS bf16x8*)(lds + PG8_SB(b, h) + boff + n * 2048 + k * 1024); } while (0)
#define PG8_MMA(ai, bj, At, Bt) do { __builtin_amdgcn_s_setprio(1); _Pragma("unroll") for (int m = 0; m < 4; ++m) _Pragma("unroll") for (int n = 0; n < 2; ++n) _Pragma("unroll") for (int k = 0; k < 2; ++k) \
        acc[ai][bj][m][n] = __builtin_amdgcn_mfma_f32_16x16x32_bf16(Bt[n][k], At[m][k], acc[ai][bj][m][n], 0, 0, 0); __builtin_amdgcn_s_setprio(0); } while (0)
#define PG8_WAIT_V(n) asm volatile("s_waitcnt vmcnt(" #n ")" ::: "memory")
#define PG8_WAIT_L(n) asm volatile("s_waitcnt lgkmcnt(" #n ")" ::: "memory")
#define PG8_BAR __builtin_amdgcn_s_barrier()
#define PG8_SCHED __builtin_amdgcn_sched_barrier(0)
    Unit cur, nxt; int ui = 0;
    if (!S.next(0, cur)) return;
    f32x4 acc[2][2][4][2];
#pragma unroll
    for (int a = 0; a < 2; ++a)
#pragma unroll
        for (int b = 0; b < 2; ++b)
#pragma unroll
            for (int m = 0; m < 4; ++m)
#pragma unroll
                for (int n = 0; n < 2; ++n) acc[a][b][m][n] = (f32x4){0.f, 0.f, 0.f, 0.f};
    bf16x8 At[4][2], B0[2][2], B1[2][2];
    const char* cA = (const char*)g.A + (size_t)cur.pm * tstep; const char* cB = (const char*)g.Bt + (size_t)cur.pn * tstep;
    S.a_ready(cur);
    if constexpr (SP2) {
        PG8_STAGE(PG8_SB(0, 0), cB, voffB); PG8_STAGE(PG8_SB(0, 1), cB + hstep, voffB); PG8_STAGE(PG8_SA(0, 0), cA, voffA); PG8_STAGE(PG8_SA(0, 1), cA + hstep, voffA);
        if (wr == 1) PG8_BAR;
        PG8_WAIT_V(2); PG8_BAR;
        PG8_STAGE(PG8_SB(1, 0), cB + kstep, voffB); PG8_STAGE(PG8_SA(1, 0), cA + kstep, voffA); PG8_STAGE(PG8_SB(1, 1), cB + hstep + kstep, voffB);
        PG8_WAIT_V(6); PG8_BAR;
    } else {
        PG8_STAGE(PG8_SB(0, 0), cB, voffB); PG8_STAGE(PG8_SA(0, 0), cA, voffA); PG8_STAGE(PG8_SB(0, 1), cB + hstep, voffB); PG8_STAGE(PG8_SA(0, 1), cA + hstep, voffA);
        if (wr == 1) PG8_BAR;
        PG8_WAIT_V(4); PG8_BAR;
        PG8_STAGE(PG8_SB(1, 0), cB + kstep, voffB); PG8_STAGE(PG8_SA(1, 0), cA + kstep, voffA); PG8_STAGE(PG8_SB(1, 1), cB + hstep + kstep, voffB);
        PG8_WAIT_V(6); PG8_BAR;
    }
    for (;;) {
        const bool has_next = S.next(ui + 1, nxt);
        const char* nA = has_next ? (const char*)g.A + (size_t)nxt.pm * tstep : cA; const char* nB = has_next ? (const char*)g.Bt + (size_t)nxt.pn * tstep : cB;
        for (int t = 0; t < nt; t += 2) {
            const bool last = (t == nt - 2);
            const char* a1 = cA + (size_t)(t + 1) * kstep;
            const char* a2 = last ? nA : cA + (size_t)(t + 2) * kstep; const char* b2 = last ? nB : cB + (size_t)(t + 2) * kstep;
            const char* a3 = a2 + kstep; const char* b3 = b2 + kstep;
            if (last && has_next) S.a_ready(nxt);
            if constexpr (SP2) {
            PG8_LDB(B0, 0, 0); PG8_LDB(B1, 0, 1); PG8_SCHED; PG8_LDA(At, 0, 0); PG8_STAGE(PG8_SA(1, 1), a1 + hstep, voffA);
            PG8_WAIT_V(8); PG8_WAIT_L(0); PG8_BAR; PG8_MMA(0, 0, At, B0); PG8_MMA(0, 1, At, B1); PG8_BAR; PG8_SCHED;
            PG8_LDA(At, 0, 1); PG8_STAGE(PG8_SB(0, 0), b2, voffB); PG8_STAGE(PG8_SB(0, 1), b2 + hstep, voffB); PG8_STAGE(PG8_SA(0, 0), a2, voffA);
            PG8_WAIT_V(8); PG8_WAIT_L(0); PG8_BAR; PG8_MMA(1, 0, At, B0); PG8_MMA(1, 1, At, B1); PG8_BAR; PG8_SCHED;
            PG8_LDB(B0, 1, 0); PG8_LDB(B1, 1, 1); PG8_SCHED; PG8_LDA(At, 1, 0); PG8_STAGE(PG8_SA(0, 1), a2 + hstep, voffA);
            PG8_WAIT_V(8); PG8_WAIT_L(0); PG8_BAR; PG8_MMA(0, 0, At, B0); PG8_MMA(0, 1, At, B1); PG8_BAR; PG8_SCHED;
            PG8_LDA(At, 1, 1); PG8_STAGE(PG8_SB(1, 0), b3, voffB); PG8_STAGE(PG8_SB(1, 1), b3 + hstep, voffB); PG8_STAGE(PG8_SA(1, 0), a3, voffA);
            PG8_WAIT_V(8); PG8_WAIT_L(0); PG8_BAR; PG8_MMA(1, 0, At, B0); PG8_MMA(1, 1, At, B1); PG8_BAR; PG8_SCHED;
            } else {
            PG8_LDB(B0, 0, 0); PG8_SCHED; PG8_LDA(At, 0, 0); PG8_STAGE(PG8_SA(1, 1), a1 + hstep, voffA);
            PG8_WAIT_L(8); PG8_BAR; PG8_WAIT_L(0); PG8_MMA(0, 0, At, B0); PG8_BAR; PG8_SCHED;
            PG8_LDB(B1, 0, 1); PG8_STAGE(PG8_SB(0, 0), b2, voffB);
            PG8_BAR; PG8_WAIT_L(0); PG8_MMA(0, 1, At, B1); PG8_BAR;
            PG8_LDA(At, 0, 1); PG8_STAGE(PG8_SA(0, 0), a2, voffA);
            PG8_BAR; PG8_WAIT_L(0); PG8_MMA(1, 0, At, B0); PG8_BAR; PG8_SCHED;
            PG8_STAGE(PG8_SB(0, 1), b2 + hstep, voffB);
            PG8_WAIT_V(6); PG8_BAR; PG8_MMA(1, 1, At, B1); PG8_BAR;
            PG8_LDB(B0, 1, 0); PG8_SCHED; PG8_LDA(At, 1, 0); PG8_STAGE(PG8_SA(0, 1), a2 + hstep, voffA);
            PG8_WAIT_L(8); PG8_BAR; PG8_WAIT_L(0); PG8_MMA(0, 0, At, B0); PG8_BAR; PG8_SCHED;
            PG8_LDB(B1, 1, 1); PG8_STAGE(PG8_SB(1, 0), b3, voffB);
            PG8_BAR; PG8_WAIT_L(0); PG8_MMA(0, 1, At, B1); PG8_BAR;
            PG8_LDA(At, 1, 1); PG8_STAGE(PG8_SA(1, 0), a3, voffA);
            PG8_BAR; PG8_WAIT_L(0); PG8_MMA(1, 0, At, B0); PG8_BAR; PG8_SCHED;
            PG8_STAGE(PG8_SB(1, 1), b3 + hstep, voffB);
            PG8_WAIT_V(6); PG8_BAR; PG8_MMA(1, 1, At, B1); PG8_BAR;
            }
        }
        if constexpr (ALIGN_EPI) { if (wr == 0) PG8_BAR; }
        if constexpr (!Epi::AFTER_DRAIN) { E(acc, cur, wr, wc, fr, fq); S.done(cur); }
        if (!has_next) break;
#pragma unroll
        for (int a = 0; a < 2; ++a)
#pragma unroll
            for (int b = 0; b < 2; ++b)
#pragma unroll
                for (int m = 0; m < 4; ++m)
#pragma unroll
                    for (int n = 0; n < 2; ++n) acc[a][b][m][n] = (f32x4){0.f, 0.f, 0.f, 0.f};
        cur = nxt; cA = nA; cB = nB; ++ui;
        if constexpr (ALIGN_EPI) { if (wr == 1) PG8_BAR; }
    }
    PG8_WAIT_V(0);
    if constexpr (!ALIGN_EPI) { if (wr == 0) PG8_BAR; }
    PG8_BAR;
    if constexpr (Epi::AFTER_DRAIN) { E.fused(acc, cur, wr, wc, fr, fq, lds, wid, lane); S.done(cur); }
#undef PG8_SA
#undef PG8_SB
#undef PG8_STAGE
#undef PG8_LDA
#undef PG8_LDB
#undef PG8_MMA
#undef PG8_WAIT_V
#undef PG8_WAIT_L
#undef PG8_BAR
#undef PG8_SCHED
}
}

constexpr int BATCH = 4, T = 4096, D = 1024, M = BATCH * T, DIN = 12288, DEPTH = 2, NWAVES = 8;
constexpr int NA = 8192, NB = 4096;
constexpr float EPS = 1e-6f;
#ifndef N_LAUNCHES
#define N_LAUNCHES 1
#endif
constexpr int NPHASES = 1 + 7 * DEPTH;

constexpr size_t MiB = 1u << 20;
constexpr size_t WS_CTL = 0, CTL_ZERO_BYTES = 1 * MiB;
constexpr size_t WS_R1 = 1 * MiB, WS_R2 = 326 * MiB;
constexpr size_t RW_IN = 0, RW_A = 24 * MiB, RW_B = 26 * MiB, RW_O = 30 * MiB;
constexpr size_t WS_COS = 33 * MiB, WS_SIN = 35 * MiB;
constexpr size_t WS_RSTD = 37 * MiB, WS_SSQ = 37 * MiB + 65536;
constexpr size_t WS_XB = 38 * MiB;
constexpr size_t WS_U = 70 * MiB, WS_BZ = 102 * MiB;
constexpr size_t WS_QT = 134 * MiB, WS_KT = 166 * MiB;
constexpr size_t WS_V = 198 * MiB;
constexpr size_t WS_O = 262 * MiB;
constexpr size_t WS_SG = WS_QT;
constexpr size_t WS_YAG = WS_V;
constexpr size_t WS_MG = WS_U;
constexpr size_t WS_END = 358 * MiB;
constexpr int CW_BAR = 4096;

constexpr int RING_BYTES = 131072, LDSCTL_OFF = RING_BYTES, MISC_OFF = LDSCTL_OFF + 320, LDS_BYTES = 147456;

#define GAS __attribute__((address_space(1)))
#define LAS __attribute__((address_space(3)))
typedef unsigned short bf16;
typedef unsigned v4u __attribute__((ext_vector_type(4)));
typedef unsigned v2u __attribute__((ext_vector_type(2)));
typedef float f32x4 __attribute__((ext_vector_type(4)));
typedef float f32x16 __attribute__((ext_vector_type(16)));
typedef short bf16x8 __attribute__((ext_vector_type(8)));
typedef short s16x4 __attribute__((ext_vector_type(4)));
typedef float f32x2_t __attribute__((ext_vector_type(2)));
typedef __bf16 bf16x2_t __attribute__((ext_vector_type(2)));
typedef GAS unsigned gu32;
#define LDS_WAIT() asm volatile("s_waitcnt lgkmcnt(0)" ::: "memory")
#define MFMA32(a, b, c) __builtin_amdgcn_mfma_f32_32x32x16_bf16((a), (b), (c), 0, 0, 0)

__device__ __forceinline__ unsigned pk2(float lo, float hi) { f32x2_t v = {lo, hi}; bf16x2_t b = __builtin_convertvector(v, bf16x2_t); return __builtin_bit_cast(unsigned, b); }
__device__ __forceinline__ float bf_lo(unsigned u) { return __uint_as_float(u << 16); }
__device__ __forceinline__ float bf_hi(unsigned u) { return __uint_as_float(u & 0xffff0000u); }
__device__ __forceinline__ float sigm(float x) { return __builtin_amdgcn_rcpf(1.0f + __expf(-x)); }
__device__ __forceinline__ int crow(int r, int hi) { return (r & 3) + 8 * (r >> 2) + 4 * hi; }
__device__ __forceinline__ float log2_gamma(int h) { return h == 0 ? -0.04580368961312479f : h == 1 ? -0.02272007650008353f : h == 2 ? -0.011315313227834146f : -0.005646563141142063f; }
typedef short v4i16_t __attribute__((ext_vector_type(4)));
__device__ __forceinline__ s16x4 vtr(const LAS char* p) { return __builtin_bit_cast(s16x4, __builtin_amdgcn_ds_read_tr16_b64_v4i16((LAS v4i16_t*)p)); }
__device__ __forceinline__ bf16x8 trpair(const LAS char* p, int hi_off) { const s16x4 lo = vtr(p), hi = vtr(p + hi_off); return (bf16x8){lo[0], lo[1], lo[2], lo[3], hi[0], hi[1], hi[2], hi[3]}; }

using pg8::Unit;
struct EpiA {
    static constexpr bool PERM = false, AFTER_DRAIN = false;
    const float* rstd; const float* cosT; const float* sinT; bf16* U; bf16* BZ; bf16* QT; bf16* KT; bf16* V;
    __device__ __forceinline__ void operator()(const f32x4 (&acc)[2][2][4][2], const Unit& u, int wr, int wc, int fr, int fq) const {
        const int row0 = u.pm * 256 + wr * 64 + fr;
        if (u.pn < 16) {
            const int ch0 = u.pn * 64 + wc * 16 + fq * 4;
#pragma unroll
            for (int ai = 0; ai < 2; ++ai)
#pragma unroll
                for (int m = 0; m < 4; ++m) {
                    const int row = row0 + ai * 128 + m * 16; const float rs = rstd[row];
                    const f32x4 b = acc[ai][0][m][0] * rs, c = acc[ai][0][m][1] * rs, x = acc[ai][1][m][0] * rs, z = acc[ai][1][m][1] * rs;
                    const f32x4 uu = c * x; f32x4 bz;
#pragma unroll
                    for (int j = 0; j < 4; ++j) bz[j] = b[j] * z[j] * sigm(z[j]);
                    v2u w0, w1; w0.x = pk2(uu[0], uu[1]); w0.y = pk2(uu[2], uu[3]); w1.x = pk2(bz[0], bz[1]); w1.y = pk2(bz[2], bz[3]);
                    *(v2u*)(U + (size_t)row * 1024 + ch0) = w0; *(v2u*)(BZ + (size_t)row * 1024 + ch0) = w1;
                    asm volatile("" ::: "memory");
                }
        } else if (u.pn < 24) {
            const int hd = (u.pn - 16) & 3; const bool isk = u.pn >= 20; bf16* dst = isk ? KT : QT;
            const float lg = log2_gamma(hd); const int f0 = wc * 32 + fq * 8;
#pragma unroll
            for (int ai = 0; ai < 2; ++ai)
#pragma unroll
                for (int m = 0; m < 4; ++m) {
                    const int row = row0 + ai * 128 + m * 16; const int pos = row & (T - 1); const float p = (float)(pos & 511);
                    const float sc = rstd[row] * (isk ? exp2f(-p * lg) * 0.0625f : exp2f(p * lg));
                    const f32x4 c0 = *(const f32x4*)(cosT + (size_t)pos * 128 + f0), c1 = *(const f32x4*)(cosT + (size_t)pos * 128 + f0 + 4);
                    const f32x4 s0 = *(const f32x4*)(sinT + (size_t)pos * 128 + f0), s1 = *(const f32x4*)(sinT + (size_t)pos * 128 + f0 + 4);
                    const f32x4 t1a = acc[ai][0][m][0], t1b = acc[ai][0][m][1], t2a = acc[ai][1][m][0], t2b = acc[ai][1][m][1];
                    const f32x4 o1a = (t1a * c0 - t2a * s0) * sc, o1b = (t1b * c1 - t2b * s1) * sc, o2a = (t1a * s0 + t2a * c0) * sc, o2b = (t1b * s1 + t2b * c1) * sc;
                    v4u w1, w2; w1.x = pk2(o1a[0], o1a[1]); w1.y = pk2(o1a[2], o1a[3]); w1.z = pk2(o1b[0], o1b[1]); w1.w = pk2(o1b[2], o1b[3]);
                    w2.x = pk2(o2a[0], o2a[1]); w2.y = pk2(o2a[2], o2a[3]); w2.z = pk2(o2b[0], o2b[1]); w2.w = pk2(o2b[2], o2b[3]);
                    bf16* rp = dst + (size_t)row * 1024 + hd * 256 + f0;
                    *(v4u*)rp = w1; *(v4u*)(rp + 128) = w2;
                    asm volatile("" ::: "memory");
                }
        } else {
            const int col0 = (u.pn - 24) * 256 + wc * 32 + fq * 8;
#pragma unroll
            for (int ai = 0; ai < 2; ++ai)
#pragma unroll
                for (int m = 0; m < 4; ++m) {
                    const int row = row0 + ai * 128 + m * 16; const float rs = rstd[row];
#pragma unroll
                    for (int bj = 0; bj < 2; ++bj) { const f32x4 a = acc[ai][bj][m][0] * rs, b = acc[ai][bj][m][1] * rs;
                        v4u w; w.x = pk2(a[0], a[1]); w.y = pk2(a[2], a[3]); w.z = pk2(b[0], b[1]); w.w = pk2(b[2], b[3]);
                        *(v4u*)(V + (size_t)row * 2048 + col0 + bj * 128) = w; }
                    asm volatile("" ::: "memory");
                }
        }
    }
};
struct EpiB {
    static constexpr bool PERM = false, AFTER_DRAIN = false;
    const float* rstd; const float* ssq; bf16* O; bf16* SG;
    __device__ __forceinline__ void operator()(const f32x4 (&acc)[2][2][4][2], const Unit& u, int wr, int wc, int fr, int fq) const {
        const int row0 = u.pm * 256 + wr * 64 + fr;
        if (u.pn < 8) {
            const int hd = u.pn >> 1, col0 = u.pn * 256 + wc * 32 + fq * 8;
#pragma unroll
            for (int ai = 0; ai < 2; ++ai)
#pragma unroll
                for (int m = 0; m < 4; ++m) {
                    const int row = row0 + ai * 128 + m * 16; const float rs = rstd[row];
                    const float rg = rsqrtf(ssq[(size_t)row * 4 + hd] * (1.0f / 512.0f) + EPS);
#pragma unroll
                    for (int bj = 0; bj < 2; ++bj) {
                        bf16* op = O + (size_t)row * 2048 + col0 + bj * 128; const v4u ov = *(const v4u*)op;
                        const f32x4 za = acc[ai][bj][m][0] * rs, zb = acc[ai][bj][m][1] * rs;
                        float r[8];
                        r[0] = bf_lo(ov.x) * rg * za[0] * sigm(za[0]); r[1] = bf_hi(ov.x) * rg * za[1] * sigm(za[1]);
                        r[2] = bf_lo(ov.y) * rg * za[2] * sigm(za[2]); r[3] = bf_hi(ov.y) * rg * za[3] * sigm(za[3]);
                        r[4] = bf_lo(ov.z) * rg * zb[0] * sigm(zb[0]); r[5] = bf_hi(ov.z) * rg * zb[1] * sigm(zb[1]);
                        r[6] = bf_lo(ov.w) * rg * zb[2] * sigm(zb[2]); r[7] = bf_hi(ov.w) * rg * zb[3] * sigm(zb[3]);
                        v4u w; w.x = pk2(r[0], r[1]); w.y = pk2(r[2], r[3]); w.z = pk2(r[4], r[5]); w.w = pk2(r[6], r[7]);
                        *(v4u*)op = w;
                    }
                    asm volatile("" ::: "memory");
                }
        } else {
            const int col0 = (u.pn - 8) * 256 + wc * 32 + fq * 8;
#pragma unroll
            for (int ai = 0; ai < 2; ++ai)
#pragma unroll
                for (int m = 0; m < 4; ++m) {
                    const int row = row0 + ai * 128 + m * 16; const float rs = rstd[row];
#pragma unroll
                    for (int bj = 0; bj < 2; ++bj) { const f32x4 a = acc[ai][bj][m][0] * rs, b = acc[ai][bj][m][1] * rs;
                        v4u w; w.x = pk2(sigm(a[0]), sigm(a[1])); w.y = pk2(sigm(a[2]), sigm(a[3])); w.z = pk2(sigm(b[0]), sigm(b[1])); w.w = pk2(sigm(b[2]), sigm(b[3]));
                        *(v4u*)(SG + (size_t)row * 2048 + col0 + bj * 128) = w; }
                    asm volatile("" ::: "memory");
                }
        }
    }
};
struct EpiYA {
    static constexpr bool PERM = false, AFTER_DRAIN = false;
    const bf16* SG; float* YAG;
    __device__ __forceinline__ void operator()(const f32x4 (&acc)[2][2][4][2], const Unit& u, int wr, int wc, int fr, int fq) const {
        const int row0 = u.pm * 256 + wr * 64 + fr, col0 = u.pn * 256 + wc * 32 + fq * 8;
#pragma unroll
        for (int ai = 0; ai < 2; ++ai)
#pragma unroll
            for (int m = 0; m < 4; ++m) { const int row = row0 + ai * 128 + m * 16;
#pragma unroll
                for (int bj = 0; bj < 2; ++bj) { const v4u g = *(const v4u*)(SG + (size_t)row * 2048 + col0 + bj * 128);
                    f32x4 a = acc[ai][bj][m][0], b = acc[ai][bj][m][1];
                    a[0] *= bf_lo(g.x); a[1] *= bf_hi(g.x); a[2] *= bf_lo(g.y); a[3] *= bf_hi(g.y); b[0] *= bf_lo(g.z); b[1] *= bf_hi(g.z); b[2] *= bf_lo(g.w); b[3] *= bf_hi(g.w);
                    float* yp = YAG + (size_t)row * 1024 + col0 + bj * 128; *(f32x4*)yp = a; *(f32x4*)(yp + 4) = b; } asm volatile("" ::: "memory"); }
    }
};
struct EpiMG {
    static constexpr bool PERM = false, AFTER_DRAIN = false;
    const bf16* SG; const float* YAG; bf16* MG;
    __device__ __forceinline__ void operator()(const f32x4 (&acc)[2][2][4][2], const Unit& u, int wr, int wc, int fr, int fq) const {
        const int row0 = u.pm * 256 + wr * 64 + fr, col0 = u.pn * 256 + wc * 32 + fq * 8;
#pragma unroll
        for (int ai = 0; ai < 2; ++ai)
#pragma unroll
            for (int m = 0; m < 4; ++m) { const int row = row0 + ai * 128 + m * 16;
#pragma unroll
                for (int bj = 0; bj < 2; ++bj) { const v4u g = *(const v4u*)(SG + (size_t)row * 2048 + 1024 + col0 + bj * 128);
                    const float* yp = YAG + (size_t)row * 1024 + col0 + bj * 128; f32x4 a = *(const f32x4*)yp, b = *(const f32x4*)(yp + 4);
                    const f32x4 ca = acc[ai][bj][m][0], cb = acc[ai][bj][m][1];
                    a[0] += ca[0] * bf_lo(g.x); a[1] += ca[1] * bf_hi(g.x); a[2] += ca[2] * bf_lo(g.y); a[3] += ca[3] * bf_hi(g.y);
                    b[0] += cb[0] * bf_lo(g.z); b[1] += cb[1] * bf_hi(g.z); b[2] += cb[2] * bf_lo(g.w); b[3] += cb[3] * bf_hi(g.w);
                    v4u w; w.x = pk2(a[0], a[1]); w.y = pk2(a[2], a[3]); w.z = pk2(b[0], b[1]); w.w = pk2(b[2], b[3]);
                    *(v4u*)(MG + (size_t)row * 1024 + col0 + bj * 128) = w; } asm volatile("" ::: "memory"); }
    }
};
struct EpiRes {
    static constexpr bool PERM = false, AFTER_DRAIN = false;
    const float* xres; float* xout;
    __device__ __forceinline__ void operator()(const f32x4 (&acc)[2][2][4][2], const Unit& u, int wr, int wc, int fr, int fq) const {
        const int row0 = u.pm * 256 + wr * 64 + fr, col0 = u.pn * 256 + wc * 32 + fq * 4;
#pragma unroll
        for (int ai = 0; ai < 2; ++ai)
#pragma unroll
            for (int m = 0; m < 4; ++m) { const size_t off = (size_t)(row0 + ai * 128 + m * 16) * 1024 + col0;
#pragma unroll
                for (int bj = 0; bj < 2; ++bj)
#pragma unroll
                    for (int n = 0; n < 2; ++n) { const f32x4 r = *(const f32x4*)(xres + off + bj * 128 + n * 16); *(f32x4*)(xout + off + bj * 128 + n * 16) = r + acc[ai][bj][m][n]; } asm volatile("" ::: "memory"); }
    }
};
#define XB_TMO      128
#define XB_XCNT(j)  (256  + 64 * (j))
#define XB_XSUB(j)  (1280 + 64 * (j))
#define XB_XGEN(j)  (2304 + 64 * (j))
#define XB_TOP      3328
#define XB_TOPGEN   3392
#define XCD_BAR_WORDS 3456
#define XB_SPIN_CAP (1u << 18)

__device__ __forceinline__ unsigned xb_ld(unsigned* p)              { return __hip_atomic_load(p, __ATOMIC_RELAXED, __HIP_MEMORY_SCOPE_AGENT); }
__device__ __forceinline__ unsigned xb_add(unsigned* p, unsigned v) { return __hip_atomic_fetch_add(p, v, __ATOMIC_RELAXED, __HIP_MEMORY_SCOPE_AGENT); }
__device__ __forceinline__ unsigned xb_xcc_id() { return (unsigned)__builtin_amdgcn_s_getreg((3 << 11) | 20) & 0xFu; }
#define XB_SPIN(cond, bar) do { unsigned _sp = 0; while (cond) { __builtin_amdgcn_s_sleep(1); \
    if ((++_sp & 255u) == 0u) { if (xb_ld(&(bar)[XB_TMO])) break; if (_sp > XB_SPIN_CAP) { atomicAdd(&(bar)[XB_TMO], 1u); break; } } } } while (0)

struct XcdBarrier {
    unsigned* bar; unsigned x;
    volatile LAS unsigned* st;
};

__device__ __forceinline__ XcdBarrier xcd_barrier_post(unsigned* bar, volatile LAS unsigned* st) {
    XcdBarrier b; b.bar = bar; b.x = xb_xcc_id(); b.st = st;
    if (threadIdx.x == 0) (void)xb_add(&bar[XB_XCNT(b.x)], 1u);
    return b;
}
__device__ __forceinline__ void xcd_barrier_complete(unsigned* bar, unsigned x, unsigned& nloc, unsigned& nx) {
    const unsigned G = gridDim.x * gridDim.y * gridDim.z;
    unsigned sum, cnt, mine, sp = 0u;
    for (;;) {
        sum = 0u; cnt = 0u; mine = 0u;
#pragma unroll
        for (unsigned j = 0; j < 16; ++j) { const unsigned c = xb_ld(&bar[XB_XCNT(j)]); sum += c; cnt += (c > 0u) ? 1u : 0u; mine = (j == x) ? c : mine; }
        if (sum == G) break;
        __builtin_amdgcn_s_sleep(1);
        if ((++sp & 255u) == 0u) { if (xb_ld(&bar[XB_TMO])) break; if (sp > XB_SPIN_CAP) { atomicAdd(&bar[XB_TMO], 1u); break; } }
    }
    nloc = mine > 0u ? mine : 1u; nx = cnt > 0u ? cnt : 1u;
}

__device__ __forceinline__ void xcd_barrier(const XcdBarrier& b) {
    asm volatile("s_waitcnt vmcnt(0)" ::: "memory");
    __syncthreads();
    if (threadIdx.x == 0) {
        unsigned* bar = b.bar;
        __builtin_amdgcn_s_waitcnt(0);
        unsigned nloc = b.st[0], nx = b.st[1];
        if (nloc == 0u) { xcd_barrier_complete(bar, b.x, nloc, nx); b.st[0] = nloc; b.st[1] = nx; }
        const unsigned old = xb_add(&bar[XB_XSUB(b.x)], 1u);
        const unsigned gen = old / nloc;
        if (old + 1u == (gen + 1u) * nloc) {
            __builtin_amdgcn_fence(__ATOMIC_RELEASE, "agent");
            asm volatile("s_waitcnt vmcnt(0)" ::: "memory");
            const unsigned og = xb_add(&bar[XB_TOP], 1u);
            const unsigned tg = og / nx;
            if (og + 1u == (tg + 1u) * nx) xb_add(&bar[XB_TOPGEN], 1u);
            else XB_SPIN(xb_ld(&bar[XB_TOPGEN]) == tg, bar);
            __builtin_amdgcn_fence(__ATOMIC_ACQUIRE, "agent");
            xb_add(&bar[XB_XGEN(b.x)], 1u);
            asm volatile("s_waitcnt vmcnt(0)" ::: "memory");
        } else {
            XB_SPIN(xb_ld(&bar[XB_XGEN(b.x)]) == gen, bar);
            __builtin_amdgcn_fence(__ATOMIC_ACQUIRE, "agent");
            asm volatile("s_waitcnt vmcnt(0)" ::: "memory");
        }
    }
    __syncthreads();
}

struct Frame {
    LAS unsigned char* lds; volatile LAS unsigned* MISC; gu32* ctl;
    int tid, lane, wave, vcu, G;
    const float* in[9]; float* out; unsigned char* ws;
};
__device__ __forceinline__ float wave_sum(float v) {
#pragma unroll
    for (int o = 1; o < 64; o <<= 1) v += __shfl_xor(v, o);
    return v;
}
__device__ __forceinline__ int prow(int mode, int n) {
    if (mode == 0) return n;
    if (mode == 2 && n < 4096) { const int type = n >> 10, chg = n & 1023, pc = chg >> 6, ch = chg & 63;
        return 256 * pc + 128 * (type >> 1) + 32 * (ch >> 4) + 16 * (type & 1) + 4 * ((ch >> 2) & 3) + (ch & 3); }
    const int l32 = n & 31; return (n & ~31) | (16 * ((l32 >> 2) & 1) + 4 * (l32 >> 3) + (l32 & 3));
}
__device__ __forceinline__ void cvt_item(const float* W, int K, int N, bf16* WT, const float* gk, int mode, LAS float* scr, int item, int lane) {
    const int nblk = N / 32, kb = item / nblk, nb = item % nblk, k0 = 64 * kb, n0 = 32 * nb;
#pragma unroll 8
    for (int i = 0; i < 32; ++i) { const int kk = 2 * i + (lane >> 5); float v = W[(size_t)(k0 + kk) * N + n0 + (lane & 31)]; if (gk) v *= gk[k0 + kk]; scr[kk * 33 + (lane & 31)] = v; }
    LDS_WAIT(); asm volatile("" ::: "memory");
    const int c = lane & 7;
#pragma unroll
    for (int j = 0; j < 4; ++j) { const int n = (lane >> 3) + 8 * j; const LAS float* s = scr + (8 * c) * 33 + n;
        v4u o; o.x = pk2(s[0 * 33], s[1 * 33]); o.y = pk2(s[2 * 33], s[3 * 33]); o.z = pk2(s[4 * 33], s[5 * 33]); o.w = pk2(s[6 * 33], s[7 * 33]);
        *(GAS v4u*)(WT + (size_t)prow(mode, n0 + n) * K + k0 + 8 * c) = o; }
    LDS_WAIT(); asm volatile("" ::: "memory");
}
__device__ __forceinline__ void convert_layer(Frame& F, int l, unsigned char* region) {
    LAS float* scr = (LAS float*)(F.lds + F.wave * 16384);
    const int gw = F.vcu * NWAVES + F.wave, NGW = F.G * NWAVES;
    constexpr int I_IN = (D / 64) * (DIN / 32), I_A = (D / 64) * (D / 32), I_B = (2 * D / 64) * (D / 32), I_O = I_A;
    const float* w_in = F.in[2] + (size_t)l * D * DIN; const float* ng = F.in[1] + (size_t)l * D;
    const float* w_a = F.in[5] + (size_t)l * D * D; const float* w_b = F.in[6] + (size_t)l * 2 * D * D; const float* w_o = F.in[7] + (size_t)l * D * D;
    for (int it = gw; it < I_IN + I_A + I_B + I_O; it += NGW) {
        int r = it;
        if (r < I_IN) { cvt_item(w_in, D, DIN, (bf16*)(region + RW_IN), ng, 2, scr, r, F.lane); continue; } r -= I_IN;
        if (r < I_A) { cvt_item(w_a, D, D, (bf16*)(region + RW_A), nullptr, 1, scr, r, F.lane); continue; } r -= I_A;
        if (r < I_B) { cvt_item(w_b, 2 * D, D, (bf16*)(region + RW_B), nullptr, 1, scr, r, F.lane); continue; } r -= I_B;
        cvt_item(w_o, D, D, (bf16*)(region + RW_O), nullptr, 0, scr, r, F.lane);
    }
}
__device__ __forceinline__ void rownorm(Frame& F, const float* src, bf16* xb, float* rstd) {
    const int gw = F.vcu * NWAVES + F.wave, NGW = F.G * NWAVES;
    for (int m = gw; m < M; m += NGW) {
        const GAS f32x4* xr = (const GAS f32x4*)(src + (size_t)m * D) + F.lane;
        f32x4 v[4]; float s = 0.f;
#pragma unroll
        for (int j = 0; j < 4; ++j) { v[j] = xr[64 * j]; s += (v[j].x * v[j].x + v[j].y * v[j].y) + (v[j].z * v[j].z + v[j].w * v[j].w); }
        s = wave_sum(s);
        if (F.lane == 0) rstd[m] = rsqrtf(s * (1.f / D) + EPS);
        GAS v2u* o8 = (GAS v2u*)(xb + (size_t)m * D) + F.lane;
#pragma unroll
        for (int j = 0; j < 4; ++j) { v2u w; w.x = pk2(v[j].x, v[j].y); w.y = pk2(v[j].z, v[j].w); o8[64 * j] = w; }
    }
}
__device__ __forceinline__ void final_norm(Frame& F, float* x, const float* g) {
    const int gw = F.vcu * NWAVES + F.wave, NGW = F.G * NWAVES;
    for (int m = gw; m < M; m += NGW) {
        GAS f32x4* xr = (GAS f32x4*)(x + (size_t)m * D) + F.lane; const GAS f32x4* gr = (const GAS f32x4*)g + F.lane;
        f32x4 v[4]; float s = 0.f;
#pragma unroll
        for (int j = 0; j < 4; ++j) { v[j] = xr[64 * j]; s += (v[j].x * v[j].x + v[j].y * v[j].y) + (v[j].z * v[j].z + v[j].w * v[j].w); }
        const float r = rsqrtf(wave_sum(s) * (1.f / D) + EPS);
#pragma unroll
        for (int j = 0; j < 4; ++j) xr[64 * j] = v[j] * r * gr[64 * j];
    }
}
__device__ __forceinline__ void rotary_tables(Frame& F, float* cosT, float* sinT) {
    const int gt = F.vcu * (NWAVES * 64) + F.tid, NT = F.G * NWAVES * 64;
    for (int idx = gt; idx < T * 128; idx += NT) {
        const int pos = idx >> 7, f = idx & 127;
        double inv = 1.0, bq = 0.930572040929699;
#pragma unroll
        for (int bit = 0; bit < 7; ++bit) { if ((f >> bit) & 1) inv *= bq; bq *= bq; }
        const double a = (double)pos * inv;
        const double kd = __builtin_rint(a * 0.6366197723675814);
        const double r = (a - kd * 1.5707963267948966) - kd * 6.123233995736766e-17;
        const double r2 = r * r;
        double sp = -1.0 / 355687428096000.0;
        sp = sp * r2 + 1.0 / 1307674368000.0; sp = sp * r2 - 1.0 / 6227020800.0; sp = sp * r2 + 1.0 / 39916800.0; sp = sp * r2 - 1.0 / 362880.0;
        sp = sp * r2 + 1.0 / 5040.0; sp = sp * r2 - 1.0 / 120.0; sp = sp * r2 + 1.0 / 6.0; const double sn = r - r * r2 * sp;
        double cp = 1.0 / 20922789888000.0;
        cp = cp * r2 - 1.0 / 87178291200.0; cp = cp * r2 + 1.0 / 479001600.0; cp = cp * r2 - 1.0 / 3628800.0; cp = cp * r2 + 1.0 / 40320.0;
        cp = cp * r2 - 1.0 / 720.0; cp = cp * r2 + 1.0 / 24.0; cp = cp * r2 - 0.5; const double cs = 1.0 + r2 * cp;
        const int k = (int)kd & 3;
        const double c = (k == 0) ? cs : (k == 1) ? -sn : (k == 2) ? -cs : sn;
        const double s = (k == 0) ? sn : (k == 1) ? cs : (k == 2) ? -sn : -cs;
        cosT[idx] = (float)c; sinT[idx] = (float)s;
    }
}
__device__ __forceinline__ void conv_pass(Frame& F, const bf16* U, bf16* BZ, const float* cw, const float* cb) {
    const int gt = F.vcu * (NWAVES * 64) + F.tid, NT = F.G * NWAVES * 64;
    for (int v = gt; v < M * 128; v += NT) {
        const int row = v >> 7, c8 = (v & 127) * 8, t = row & (T - 1);
        const v4u z4 = {0u, 0u, 0u, 0u};
        const v4u u0 = *(const v4u*)(U + (size_t)row * 1024 + c8);
        const v4u u1 = t >= 1 ? *(const v4u*)(U + (size_t)(row - 1) * 1024 + c8) : z4;
        const v4u u2 = t >= 2 ? *(const v4u*)(U + (size_t)(row - 2) * 1024 + c8) : z4;
        bf16* bp = BZ + (size_t)row * 1024 + c8; const v4u bz = *(const v4u*)bp;
        float w0[8], w1[8], w2[8], bb[8];
        *(f32x4*)&w0[0] = *(const f32x4*)(cw + c8); *(f32x4*)&w0[4] = *(const f32x4*)(cw + c8 + 4);
        *(f32x4*)&w1[0] = *(const f32x4*)(cw + 1024 + c8); *(f32x4*)&w1[4] = *(const f32x4*)(cw + 1024 + c8 + 4);
        *(f32x4*)&w2[0] = *(const f32x4*)(cw + 2048 + c8); *(f32x4*)&w2[4] = *(const f32x4*)(cw + 2048 + c8 + 4);
        *(f32x4*)&bb[0] = *(const f32x4*)(cb + c8); *(f32x4*)&bb[4] = *(const f32x4*)(cb + c8 + 4);
        float y[8];
#pragma unroll
        for (int i = 0; i < 4; ++i) {
            const unsigned a0 = u0[i], a1 = u1[i], a2 = u2[i], bzz = bz[i];
            y[2 * i]     = bf_lo(bzz) * (w0[2 * i] * bf_lo(a2) + w1[2 * i] * bf_lo(a1) + w2[2 * i] * bf_lo(a0) + bb[2 * i]);
            y[2 * i + 1] = bf_hi(bzz) * (w0[2 * i + 1] * bf_hi(a2) + w1[2 * i + 1] * bf_hi(a1) + w2[2 * i + 1] * bf_hi(a0) + bb[2 * i + 1]);
        }
        v4u w; w.x = pk2(y[0], y[1]); w.y = pk2(y[2], y[3]); w.z = pk2(y[4], y[5]); w.w = pk2(y[6], y[7]);
        *(v4u*)bp = w;
    }
}
constexpr int CH_KSTR = 576, CH_VSTR = 64, CH_VOFF = 128 * CH_KSTR;
__device__ __forceinline__ void chain_item(Frame& F, int bh, int sl, const bf16* KT, const bf16* V, bf16* ST) {
    int tid_ = F.tid; asm volatile("" : "+v"(tid_));
    const int b = bh >> 2, h = bh & 3, tid = tid_, lane = tid & 63, w = __builtin_amdgcn_readfirstlane(tid >> 6);
    const int hl = lane >> 5, l31 = lane & 31, q = (lane & 15) >> 2, p = lane & 3, blk = (lane >> 4) & 1;
    LAS char* Kt = (LAS char*)F.lds; LAS char* Vt = Kt + CH_VOFF;
    const float g512 = exp2f(512.0f * log2_gamma(h));
    f32x16 S;
#pragma unroll
    for (int i = 0; i < 16; ++i) S[i] = 0.f;
    bf16* STb = ST + (size_t)bh * 8 * 512 * 256;
    for (int s = 0; s < 8; ++s) {
#pragma unroll
        for (int g = 0; g < 4; ++g) { v2u w2; w2.x = pk2(S[4 * g], S[4 * g + 1]); w2.y = pk2(S[4 * g + 2], S[4 * g + 3]);
            *(v2u*)(STb + ((size_t)s * 512 + sl * 32 + l31) * 256 + w * 32 + 8 * g + 4 * hl) = w2; }
        if (s == 7) break;
        for (int kb = 0; kb < 4; ++kb) {
            const size_t rowbase = (size_t)b * T + s * 512 + kb * 128;
            __syncthreads();
#pragma unroll
            for (int i = 0; i < 8; ++i) { const int id = tid + 512 * i, r = id >> 5, c = id & 31;
                const v4u x = *(const v4u*)(KT + (rowbase + r) * 1024 + h * 256 + c * 8); *(LAS v4u*)(Kt + r * CH_KSTR + c * 16) = x; }
            { const int r = tid >> 2, c = tid & 3; const v4u x = *(const v4u*)(V + (rowbase + r) * 2048 + h * 512 + sl * 32 + c * 8); *(LAS v4u*)(Vt + r * CH_VSTR + c * 16) = x; }
            __syncthreads();
#pragma unroll
            for (int ks = 0; ks < 8; ++ks) {
                const int kr = 16 * ks + 8 * hl + q;
                const bf16x8 A = trpair(Kt + kr * CH_KSTR + 2 * (32 * w + 16 * blk + 4 * p), 4 * CH_KSTR);
                const bf16x8 B = trpair(Vt + kr * CH_VSTR + 2 * (16 * blk + 4 * p), 4 * CH_VSTR);
                S = MFMA32(A, B, S);
            }
        }
#pragma unroll
        for (int i = 0; i < 16; ++i) S[i] *= g512;
    }
}
constexpr int AP_KSTR = 528, AP_VSTR = 1088, AP_VOFF = 64 * AP_KSTR, AP_RED = AP_VOFF + 64 * AP_VSTR;
__device__ __forceinline__ void apply_item(Frame& F, int bh, int r, const bf16* QT, const bf16* KT, const bf16* V, const bf16* ST, bf16* O, float* ssq) {
    int tid_ = F.tid; asm volatile("" : "+v"(tid_));
    const int b = bh >> 2, h = bh & 3, tid = tid_, lane = tid & 63, w = __builtin_amdgcn_readfirstlane(tid >> 6);
    const int hl = lane >> 5, l31 = lane & 31, q = (lane & 15) >> 2, p = lane & 3, blk = (lane >> 4) & 1;
    const int ig = w & 3, dh = w >> 2, s = r >> 2, t0 = r * 128;
    LAS char* Ks = (LAS char*)F.lds; LAS char* Vs = Ks + AP_VOFF; LAS float* red = (LAS float*)(Ks + AP_RED);
    f32x16 acc[8];
#pragma unroll
    for (int mt = 0; mt < 8; ++mt)
#pragma unroll
        for (int i = 0; i < 16; ++i) acc[mt][i] = 0.f;
    const bf16* qrow = QT + ((size_t)b * T + t0 + 32 * ig + l31) * 1024 + h * 256 + 8 * hl;
    for (int rp = 4 * s; rp <= r; ++rp) {
        const bool diag = (rp == r);
        for (int half = 0; half < 2; ++half) {
            const size_t keybase = (size_t)b * T + rp * 128 + half * 64;
            __syncthreads();
#pragma unroll
            for (int i = 0; i < 4; ++i) { const int id = tid + 512 * i, rr = id >> 5, c = id & 31;
                const v4u x = *(const v4u*)(KT + (keybase + rr) * 1024 + h * 256 + c * 8); *(LAS v4u*)(Ks + rr * AP_KSTR + c * 16) = x; }
#pragma unroll
            for (int i = 0; i < 8; ++i) { const int id = tid + 512 * i, rr = id >> 6, c = id & 63;
                const v4u x = *(const v4u*)(V + (keybase + rr) * 2048 + h * 512 + c * 8); *(LAS v4u*)(Vs + rr * AP_VSTR + c * 16) = x; }
            __syncthreads();
            for (int jt = 0; jt < 2; ++jt) {
                const int kt = 2 * half + jt;
                if (diag && kt > ig) continue;
                f32x16 X;
#pragma unroll
                for (int i = 0; i < 16; ++i) X[i] = 0.f;
#pragma unroll
                for (int ks = 0; ks < 16; ++ks) {
                    const bf16x8 A = *(const LAS bf16x8*)(Ks + (32 * jt + l31) * AP_KSTR + (16 * ks + 8 * hl) * 2);
                    const bf16x8 B = *(const bf16x8*)(qrow + 16 * ks);
                    X = MFMA32(A, B, X);
                }
                if (diag && kt == ig) {
#pragma unroll
                    for (int i = 0; i < 16; ++i) if (crow(i, hl) > l31) X[i] = 0.f;
                }
                v4u p0, p1;
                p0.x = pk2(X[0], X[1]); p0.y = pk2(X[2], X[3]); p0.z = pk2(X[4], X[5]); p0.w = pk2(X[6], X[7]);
                p1.x = pk2(X[8], X[9]); p1.y = pk2(X[10], X[11]); p1.z = pk2(X[12], X[13]); p1.w = pk2(X[14], X[15]);
                const bf16x8 P0 = __builtin_bit_cast(bf16x8, p0), P1 = __builtin_bit_cast(bf16x8, p1);
                const LAS char* vb = Vs + (32 * jt + 4 * hl + q) * AP_VSTR + 2 * (256 * dh + 16 * blk + 4 * p);
#pragma unroll
                for (int mt = 0; mt < 8; ++mt) {
                    const bf16x8 A0 = trpair(vb + 64 * mt, 8 * AP_VSTR);
                    const bf16x8 A1 = trpair(vb + 64 * mt + 16 * AP_VSTR, 8 * AP_VSTR);
                    acc[mt] = MFMA32(A0, P0, acc[mt]);
                    acc[mt] = MFMA32(A1, P1, acc[mt]);
                }
            }
        }
    }
    {
        const bf16* stp = ST + ((size_t)(bh * 8 + s) * 512 + 256 * dh + l31) * 256 + 8 * hl;
#pragma unroll 1
        for (int ks = 0; ks < 16; ++ks) {
            const bf16x8 B = *(const bf16x8*)(qrow + 16 * ks);
#pragma unroll
            for (int mt = 0; mt < 8; ++mt) { const bf16x8 A = *(const bf16x8*)(stp + (size_t)mt * 32 * 256 + 16 * ks); acc[mt] = MFMA32(A, B, acc[mt]); }
        }
    }
    float ss = 0.f;
#pragma unroll
    for (int mt = 0; mt < 8; ++mt)
#pragma unroll
        for (int i = 0; i < 16; ++i) ss += acc[mt][i] * acc[mt][i];
    ss += __shfl_xor(ss, 32);
    __syncthreads();
    if (hl == 0) red[dh * 128 + 32 * ig + l31] = ss;
    bf16* orow = O + ((size_t)b * T + t0 + 32 * ig + l31) * 2048 + h * 512 + 256 * dh + 4 * hl;
#pragma unroll
    for (int mt = 0; mt < 8; ++mt)
#pragma unroll
        for (int g = 0; g < 4; ++g) { v2u w2; w2.x = pk2(acc[mt][4 * g], acc[mt][4 * g + 1]); w2.y = pk2(acc[mt][4 * g + 2], acc[mt][4 * g + 3]); *(v2u*)(orow + 32 * mt + 8 * g) = w2; }
    __syncthreads();
    if (tid < 128) ssq[((size_t)b * T + t0 + tid) * 4 + h] = red[tid] + red[128 + tid];
}

struct Args { const float* in[9]; float* out; unsigned char* ws; int ph_lo, ph_hi, li, pad; };
__global__ void __launch_bounds__(NWAVES * 64, 2) fwd_kernel(Args args) {
    extern __shared__ __attribute__((aligned(16))) unsigned char lds[];
    Frame F;
    F.lds = (LAS unsigned char*)lds; F.MISC = (volatile LAS unsigned*)(F.lds + MISC_OFF);
    F.tid = threadIdx.x; F.lane = F.tid & 63; F.wave = __builtin_amdgcn_readfirstlane(F.tid >> 6);
    F.G = gridDim.x; { const int bx = blockIdx.x; F.vcu = (F.G % 8 == 0) ? (bx % 8) * (F.G / 8) + bx / 8 : bx; }
    F.ws = args.ws; F.ctl = (gu32*)(args.ws + WS_CTL); F.out = args.out;
#pragma unroll
    for (int i = 0; i < 9; ++i) F.in[i] = args.in[i];
    for (int u = F.tid; u < (LDS_BYTES - LDSCTL_OFF) / 4; u += NWAVES * 64) ((LAS unsigned*)(F.lds + LDSCTL_OFF))[u] = 0u;
    __syncthreads();
    XcdBarrier bar; bar.bar = (unsigned*)(F.ctl + CW_BAR); bar.x = 0; bar.st = nullptr;
    if (N_LAUNCHES == 1) bar = xcd_barrier_post((unsigned*)(F.ctl + CW_BAR), F.MISC + 8);
    const int lo = args.ph_lo, hi = args.ph_hi;
#define IN(k) (lo <= (k) && (k) < hi)
#define SEAM(k) do { if (IN(k) && IN((k) + 1)) xcd_barrier(bar); } while (0)
#define PHASE_PTRS() unsigned long long z0_ = 0ull; asm volatile("" : "+s"(z0_)); unsigned char* ws = args.ws + z0_; \
    Frame P = F; { int t_ = threadIdx.x; asm volatile("" : "+v"(t_)); P.tid = t_; P.lane = t_ & 63; P.wave = __builtin_amdgcn_readfirstlane(t_ >> 6); } \
    float* cosT = (float*)(ws + WS_COS); float* sinT = (float*)(ws + WS_SIN); float* rstd = (float*)(ws + WS_RSTD); float* ssq = (float*)(ws + WS_SSQ); \
    bf16* XB = (bf16*)(ws + WS_XB); bf16* U = (bf16*)(ws + WS_U); bf16* BZ = (bf16*)(ws + WS_BZ); bf16* QT = (bf16*)(ws + WS_QT); bf16* KT = (bf16*)(ws + WS_KT); \
    bf16* V = (bf16*)(ws + WS_V); bf16* O = (bf16*)(ws + WS_O); bf16* SG = (bf16*)(ws + WS_SG); float* YAG = (float*)(ws + WS_YAG); bf16* MG = (bf16*)(ws + WS_MG); \
    unsigned char* RW = ws + ((l & 1) ? WS_R2 : WS_R1); unsigned char* RS = ws + ((l & 1) ? WS_R1 : WS_R2); bf16* ST = (bf16*)RS; \
    (void)cosT; (void)sinT; (void)rstd; (void)ssq; (void)XB; (void)U; (void)BZ; (void)QT; (void)KT; (void)V; (void)O; (void)SG; (void)YAG; (void)MG; (void)RW; (void)RS; (void)ST

    if (IN(0)) {
        const int l = 0; PHASE_PTRS();
        convert_layer(P, 0, ws + WS_R1);
        rotary_tables(P, cosT, sinT);
        rownorm(P, args.in[0], XB, rstd);
    }
    SEAM(0);
#pragma unroll 1
    for (int l = 0; l < DEPTH; ++l) {
        const int pb = 1 + 7 * l;
        if (IN(pb + 0)) {
            PHASE_PTRS();
            pg8::Gemm g{XB, (const bf16*)(RW + RW_IN), M, NA, D}; pg8::StaticOrder S; S.init(M, NA, F.G, (int)blockIdx.x);
            EpiA E{rstd, cosT, sinT, U, BZ, QT, KT, V};
            pg8::gemm_phase<EpiA, pg8::StaticOrder, true, true>(F.lds, g, S, E);
        }
        SEAM(pb + 0);
        if (IN(pb + 1)) {
            PHASE_PTRS();
            if (F.G == 256) chain_item(P, F.vcu >> 4, F.vcu & 15, KT, V, ST);
            else for (int it = F.vcu; it < 256; it += F.G) chain_item(P, it >> 4, it & 15, KT, V, ST);
            conv_pass(P, U, BZ, args.in[3] + (size_t)l * 3 * D, args.in[4] + (size_t)l * D);
        }
        SEAM(pb + 1);
        if (IN(pb + 2)) {
            PHASE_PTRS();
            for (int pr = F.vcu; pr < 256; pr += F.G) {
                const int bh = pr >> 4, pi = pr & 15, s = pi >> 1;
                const int ra = (pi & 1) ? 4 * s + 1 : 4 * s + 0, rb = (pi & 1) ? 4 * s + 2 : 4 * s + 3;
#pragma unroll 1
                for (int k = 0; k < 2; ++k) apply_item(P, bh, k == 0 ? rb : ra, QT, KT, V, ST, O, ssq);
            }
        }
        SEAM(pb + 2);
        if (IN(pb + 3)) {
            PHASE_PTRS();
            if (l + 1 < DEPTH) { convert_layer(P, l + 1, RS); __syncthreads(); }
            pg8::Gemm g{XB, (const bf16*)(RW + RW_IN) + (size_t)NA * D, M, NB, D}; pg8::StaticOrder S; S.init(M, NB, F.G, (int)blockIdx.x);
            EpiB E{rstd, ssq, O, SG};
            pg8::gemm_phase<EpiB, pg8::StaticOrder, true, true>(F.lds, g, S, E);
        }
        SEAM(pb + 3);
        if (IN(pb + 4)) {
            PHASE_PTRS();
            { pg8::Gemm g{BZ, (const bf16*)(RW + RW_A), M, D, D}; pg8::StaticOrder S; S.init(M, D, F.G, (int)blockIdx.x);
              EpiYA E{SG, YAG}; pg8::gemm_phase<EpiYA, pg8::StaticOrder, false, true>(F.lds, g, S, E); }
            asm volatile("s_waitcnt vmcnt(0)" ::: "memory"); __syncthreads();
            { pg8::Gemm g{O, (const bf16*)(RW + RW_B), M, D, 2 * D}; pg8::StaticOrder S; S.init(M, D, F.G, (int)blockIdx.x);
              EpiMG E{SG, YAG, MG}; pg8::gemm_phase<EpiMG, pg8::StaticOrder, false, true>(F.lds, g, S, E); }
        }
        SEAM(pb + 4);
        if (IN(pb + 5)) {
            PHASE_PTRS();
            pg8::Gemm g{MG, (const bf16*)(RW + RW_O), M, D, D}; pg8::StaticOrder S; S.init(M, D, F.G, (int)blockIdx.x);
            EpiRes E{(l == 0) ? args.in[0] : (const float*)args.out, args.out}; pg8::gemm_phase<EpiRes, pg8::StaticOrder, false, true>(F.lds, g, S, E);
        }
        SEAM(pb + 5);
        if (IN(pb + 6)) {
            PHASE_PTRS();
            if (l + 1 < DEPTH) rownorm(P, args.out, XB, rstd);
            else final_norm(P, args.out, args.in[8]);
        }
        if (l + 1 < DEPTH) SEAM(pb + 6);
    }
#undef IN
#undef SEAM
}

extern "C" void kernel_launch(void* const* d_in, const int* in_sizes, int n_in, void* d_out, int out_size, void* d_ws, size_t ws_size, hipStream_t stream) {
    static int grid = 0;
    if (grid == 0) {
        if (n_in != 9 || in_sizes[0] != M * D || out_size != M * D || ws_size < WS_END) {
            fprintf(stderr, "kernel_launch: unexpected problem (n_in %d, in0 %d, out %d, ws %zu; need ws >= %zu); nothing launched\n", n_in, n_in > 0 ? in_sizes[0] : -1, out_size, ws_size, (size_t)WS_END); grid = -1; return; }
        int dev = 0, cus = 0, per_cu = 0;
        if (hipGetDevice(&dev) != hipSuccess || hipDeviceGetAttribute(&cus, hipDeviceAttributeMultiprocessorCount, dev) != hipSuccess) { grid = -1; return; }
        if (hipFuncSetAttribute((const void*)fwd_kernel, hipFuncAttributeMaxDynamicSharedMemorySize, LDS_BYTES) != hipSuccess) { fprintf(stderr, "kernel_launch: hipFuncSetAttribute failed\n"); grid = -1; return; }
        if (hipOccupancyMaxActiveBlocksPerMultiprocessor(&per_cu, (const void*)fwd_kernel, NWAVES * 64, LDS_BYTES) != hipSuccess || per_cu < 1) { fprintf(stderr, "kernel_launch: occupancy query says %d blocks per CU; nothing launched\n", per_cu); (void)hipGetLastError(); grid = -1; return; }
        grid = cus;
    }
    if (grid < 0) return;
    if (hipMemsetAsync((char*)d_ws + WS_CTL, 0, CTL_ZERO_BYTES, stream) != hipSuccess) return;
    Args a{};
    for (int i = 0; i < 9; ++i) a.in[i] = (const float*)d_in[i];
    a.out = (float*)d_out; a.ws = (unsigned char*)d_ws;
    if (N_LAUNCHES == 1) {
        a.ph_lo = 0; a.ph_hi = NPHASES; a.li = 0;
        hipLaunchKernelGGL(fwd_kernel, dim3(grid), dim3(NWAVES * 64), LDS_BYTES, stream, a);
    } else {
        for (int li = 0; li < NPHASES; ++li) { a.ph_lo = li; a.ph_hi = li + 1; a.li = li; hipLaunchKernelGGL(fwd_kernel, dim3(grid), dim3(NWAVES * 64), LDS_BYTES, stream, a); }
    }
}
```

```cpp
#include <hip/hip_runtime.h>
#include <cstdio>
#include <cstdint>
namespace pg8 {
#define PG8_LAS __attribute__((address_space(3)))
typedef unsigned short bf16_t;
typedef short bf16x8 __attribute__((ext_vector_type(8)));
typedef float f32x4 __attribute__((ext_vector_type(4)));
typedef unsigned u32x4 __attribute__((ext_vector_type(4)));
constexpr int BM = 256, BK = 64, HALF = 128, HTB = HALF * BK * 2  , STAGE_BYTES = 8 * HTB, NXCD = 8, WGM = 8;

__host__ __device__ __forceinline__ int lds_byte(int r, int c) { const int st = (r >> 4) * 2 + (c >> 5), rr = r & 15, cc = c & 31, ob = rr * 64 + cc * 2; return st * 1024 + (ob ^ (((ob >> 9) & 1) << 5)); }
__host__ __device__ __forceinline__ void stage_rc(int b, int& R, int& C) { const int st = b / 1024, sb = b % 1024, swz = sb ^ (((sb >> 9) & 1) << 5); R = (st >> 1) * 16 + swz / 64; C = (st & 1) * 32 + (swz % 64) / 2; }
__host__ __device__ __forceinline__ int perm32(int rho) { const int n = rho >> 4, i = rho & 15; return 8 * (i >> 2) + 4 * n + (i & 3); }

struct Unit { int pm, pn; };
struct Gemm { const bf16_t* A; const bf16_t* Bt; int M, N, K; };

struct StaticOrder {
    int nM, nN, nwg, G, c;
    __host__ __device__ void init(int M, int N, int G_, int c_) { nM = M / BM; nN = N / BM; nwg = nM * nN; G = G_; c = c_; }
    __host__ __device__ bool next(int i, Unit& u) const {
        const long L = (long)i * G + c; if (L >= nwg) return false;
        int wgid = (int)L; { const int q = nwg / NXCD, r = nwg % NXCD, xcd = wgid % NXCD, off = wgid / NXCD; wgid = (xcd < r ? xcd * (q + 1) : r * (q + 1) + (xcd - r) * q) + off; }
        const int nig = WGM * nN, gid = wgid / nig, fm = gid * WGM, gsz = (nM - fm) < WGM ? (nM - fm) : WGM;
        u.pm = fm + ((wgid % nig) % gsz); u.pn = (wgid % nig) / gsz; return true;
    }
    __device__ __forceinline__ void a_ready(const Unit&) const {}
    __device__ __forceinline__ void done(const Unit&) const {}
};
__device__ __forceinline__ unsigned cvt_pk_bf16(float lo, float hi) { unsigned r; asm volatile("v_cvt_pk_bf16_f32 %0, %1, %2" : "=v"(r) : "v"(lo), "v"(hi)); return r; }
template <class Epi, class Sched, bool ALIGN_EPI = false, bool SP2 = false>
__device__ __forceinline__ void gemm_phase(PG8_LAS unsigned char* lds, const Gemm g, const Sched& S, const Epi& E) {
    int tid_ = threadIdx.x; asm volatile("" : "+v"(tid_));
    const int tid = tid_, wid = __builtin_amdgcn_readfirstlane(tid >> 6), lane = tid & 63, wr = wid >> 2, wc = wid & 3, fr = lane & 15, fq = lane >> 4;
    const int K = g.K, nt = K / BK;
    unsigned voffA[2], voffB[2];
#pragma unroll
    for (int i = 0; i < 2; ++i) { int R, C; stage_rc(tid * 16 + i * 8192, R, C); const int Rb = Epi::PERM ? ((R & ~31) + perm32(R & 31)) : R;
        voffA[i] = (unsigned)(R * K + C) * 2u; voffB[i] = (unsigned)(Rb * K + C) * 2u; }
    const size_t kstep = (size_t)(BK * 2);
    const size_t hstep = (size_t)HALF * K * 2;
    const size_t tstep = 2 * hstep;
    const unsigned ldsw = (unsigned)wid * 1024u;
    const int aoff = lds_byte(wr * 64 + fr, fq * 8), boff = lds_byte(wc * 32 + fr, fq * 8);
#define PG8_SA(b, h) (((b) * 2 + (h)) * HTB)
#define PG8_SB(b, h) ((4 + (b) * 2 + (h)) * HTB)
#define PG8_STAGE(bufoff, gbase, voff) do { _Pragma("unroll") for (int _i = 0; _i < 2; ++_i) \
        __builtin_amdgcn_global_load_lds((const unsigned*)((const char*)(gbase) + (voff)[_i]), (PG8_LAS unsigned*)(lds + (bufoff) + ldsw + _i * 8192), 16, 0, 0); } while (0)
#define PG8_LDA(dst, b, h) do { _Pragma("unroll") for (int m = 0; m < 4; ++m) _Pragma("unroll") for (int k = 0; k < 2; ++k) dst[m][k] = *(const PG8_LAS bf16x8*)(lds + PG8_SA(b, h) + aoff + m * 2048 + k * 1024); } while (0)
#define PG8_LDB(dst, b, h) do { _Pragma("unroll") for (int n = 0; n < 2; ++n) _Pragma("unroll") for (int k = 0; k < 2; ++k) dst[n][k] = *(const PG8_LAS bf16x8*)(lds + PG8_SB(b, h) + boff + n * 2048 + k * 1024); } while (0)
#define PG8_MMA(ai, bj, At, Bt) do { __builtin_amdgcn_s_setprio(1); _Pragma("unroll") for (int m = 0; m < 4; ++m) _Pragma("unroll") for (int n = 0; n < 2; ++n) _Pragma("unroll") for (int k = 0; k < 2; ++k) \
        acc[ai][bj][m][n] = __builtin_amdgcn_mfma_f32_16x16x32_bf16(Bt[n][k], At[m][k], acc[ai][bj][m][n], 0, 0, 0); __builtin_amdgcn_s_setprio(0); } while (0)
#define PG8_WAIT_V(n) asm volatile("s_waitcnt vmcnt(" #n ")" ::: "memory")
#define PG8_WAIT_L(n) asm volatile("s_waitcnt lgkmcnt(" #n ")" ::: "memory")
#define PG8_BAR __builtin_amdgcn_s_barrier()
#define PG8_SCHED __builtin_amdgcn_sched_barrier(0)
    Unit cur, nxt; int ui = 0;
    if (!S.next(0, cur)) return;
    f32x4 acc[2][2][4][2];
#pragma unroll
    for (int a = 0; a < 2; ++a)
#pragma unroll
        for (int b = 0; b < 2; ++b)
#pragma unroll
            for (int m = 0; m < 4; ++m)
#pragma unroll
                for (int n = 0; n < 2; ++n) acc[a][b][m][n] = (f32x4){0.f, 0.f, 0.f, 0.f};
    bf16x8 At[4][2], B0[2][2], B1[2][2];
    const char* cA = (const char*)g.A + (size_t)cur.pm * tstep; const char* cB = (const char*)g.Bt + (size_t)cur.pn * tstep;
    S.a_ready(cur);
    if constexpr (SP2) {
        PG8_STAGE(PG8_SB(0, 0), cB, voffB); PG8_STAGE(PG8_SB(0, 1), cB + hstep, voffB); PG8_STAGE(PG8_SA(0, 0), cA, voffA); PG8_STAGE(PG8_SA(0, 1), cA + hstep, voffA);
        if (wr == 1) PG8_BAR;
        PG8_WAIT_V(2); PG8_BAR;
        PG8_STAGE(PG8_SB(1, 0), cB + kstep, voffB); PG8_STAGE(PG8_SA(1, 0), cA + kstep, voffA); PG8_STAGE(PG8_SB(1, 1), cB + hstep + kstep, voffB);
        PG8_WAIT_V(6); PG8_BAR;
    } else {
        PG8_STAGE(PG8_SB(0, 0), cB, voffB); PG8_STAGE(PG8_SA(0, 0), cA, voffA); PG8_STAGE(PG8_SB(0, 1), cB + hstep, voffB); PG8_STAGE(PG8_SA(0, 1), cA + hstep, voffA);
        if (wr == 1) PG8_BAR;
        PG8_WAIT_V(4); PG8_BAR;
        PG8_STAGE(PG8_SB(1, 0), cB + kstep, voffB); PG8_STAGE(PG8_SA(1, 0), cA + kstep, voffA); PG8_STAGE(PG8_SB(1, 1), cB + hstep + kstep, voffB);
        PG8_WAIT_V(6); PG8_BAR;
    }
    for (;;) {
        const bool has_next = S.next(ui + 1, nxt);
        const char* nA = has_next ? (const char*)g.A + (size_t)nxt.pm * tstep : cA; const char* nB = has_next ? (const char*)g.Bt + (size_t)nxt.pn * tstep : cB;
        for (int t = 0; t < nt; t += 2) {
            const bool last = (t == nt - 2);
            const char* a1 = cA + (size_t)(t + 1) * kstep;
            const char* a2 = last ? nA : cA + (size_t)(t + 2) * kstep; const char* b2 = last ? nB : cB + (size_t)(t + 2) * kstep;
            const char* a3 = a2 + kstep; const char* b3 = b2 + kstep;
            if (last && has_next) S.a_ready(nxt);
            if constexpr (SP2) {
            PG8_LDB(B0, 0, 0); PG8_LDB(B1, 0, 1); PG8_SCHED; PG8_LDA(At, 0, 0); PG8_STAGE(PG8_SA(1, 1), a1 + hstep, voffA);
            PG8_WAIT_V(8); PG8_WAIT_L(0); PG8_BAR; PG8_MMA(0, 0, At, B0); PG8_MMA(0, 1, At, B1); PG8_BAR; PG8_SCHED;
            PG8_LDA(At, 0, 1); PG8_STAGE(PG8_SB(0, 0), b2, voffB); PG8_STAGE(PG8_SB(0, 1), b2 + hstep, voffB); PG8_STAGE(PG8_SA(0, 0), a2, voffA);
            PG8_WAIT_V(8); PG8_WAIT_L(0); PG8_BAR; PG8_MMA(1, 0, At, B0); PG8_MMA(1, 1, At, B1); PG8_BAR; PG8_SCHED;
            PG8_LDB(B0, 1, 0); PG8_LDB(B1, 1, 1); PG8_SCHED; PG8_LDA(At, 1, 0); PG8_STAGE(PG8_SA(0, 1), a2 + hstep, voffA);
            PG8_WAIT_V(8); PG8_WAIT_L(0); PG8_BAR; PG8_MMA(0, 0, At, B0); PG8_MMA(0, 1, At, B1); PG8_BAR; PG8_SCHED;
            PG8_LDA(At, 1, 1); PG8_STAGE(PG8_SB(1, 0), b3, voffB); PG8_STAGE(PG8_SB(1, 1), b3 + hstep, voffB); PG8_STAGE(PG8_SA(1, 0), a3, voffA);
            PG8_WAIT_V(8); PG8_WAIT_L(0); PG8_BAR; PG8_MMA(1, 0, At, B0); PG8_MMA(1, 1, At, B1); PG8_BAR; PG8_SCHED;
            } else {
            PG8_LDB(B0, 0, 0); PG8_SCHED; PG8_LDA(At, 0, 0); PG8_STAGE(PG8_SA(1, 1), a1 + hstep, voffA);
            PG8_WAIT_L(8); PG8_BAR; PG8_WAIT_L(0); PG8_MMA(0, 0, At, B0); PG8_BAR; PG8_SCHED;
            PG8_LDB(B1, 0, 1); PG8_STAGE(PG8_SB(0, 0), b2, voffB);
            PG8_BAR; PG8_WAIT_L(0); PG8_MMA(0, 1, At, B1); PG8_BAR;
            PG8_LDA(At, 0, 1); PG8_STAGE(PG8_SA(0, 0), a2, voffA);
            PG8_BAR; PG8_WAIT_L(0); PG8_MMA(1, 0, At, B0); PG8_BAR; PG8_SCHED;
            PG8_STAGE(PG8_SB(0, 1), b2 + hstep, voffB);
            PG8_WAIT_V(6); PG8_BAR; PG8_MMA(1, 1, At, B1); PG8_BAR;
            PG8_LDB(B0, 1, 0); PG8_SCHED; PG8_LDA(At, 1, 0); PG8_STAGE(PG8_SA(0, 1), a2 + hstep, voffA);
            PG8_WAIT_L(8); PG8_BAR; PG8_WAIT_L(0); PG8_MMA(0, 0, At, B0); PG8_BAR; PG8_SCHED;
            PG8_LDB(B1, 1, 1); PG8_STAGE(PG8_SB(1, 0), b3, voffB);
            PG8_BAR; PG8_WAIT_L(0); PG8_MMA(0, 1, At, B1); PG8_BAR;
            PG8_LDA(At, 1, 1); PG8_STAGE(PG8_SA(1, 0), a3, voffA);
            PG8_BAR; PG8_WAIT_L(0); PG8_MMA(1, 0, At, B0); PG8_BAR; PG8_SCHED;
            PG8_STAGE(PG8_SB(1, 1), b3 + hstep, voffB);
            PG8_WAIT_V(6); PG8_BAR; PG8_MMA(1, 1, At, B1); PG8_BAR;
            }
        }
        if constexpr (ALIGN_EPI) { if (wr == 0) PG8_BAR; }
        if constexpr (!Epi::AFTER_DRAIN) { E(acc, cur, wr, wc, fr, fq); S.done(cur); }
        if (!has_next) break;
#pragma unroll
        for (int a = 0; a < 2; ++a)
#pragma unroll
            for (int b = 0; b < 2; ++b)
#pragma unroll
                for (int m = 0; m < 4; ++m)
#pragma unroll
                    for (int n = 0; n < 2; ++n) acc[a][b][m][n] = (f32x4){0.f, 0.f, 0.f, 0.f};
        cur = nxt; cA = nA; cB = nB; ++ui;
        if constexpr (ALIGN_EPI) { if (wr == 1) PG8_BAR; }
    }
    PG8_WAIT_V(0);
    if constexpr (!ALIGN_EPI) { if (wr == 0) PG8_BAR; }
    PG8_BAR;
    if constexpr (Epi::AFTER_DRAIN) { E.fused(acc, cur, wr, wc, fr, fq, lds, wid, lane); S.done(cur); }
#undef PG8_SA
#undef PG8_SB
#undef PG8_STAGE
#undef PG8_LDA
#undef PG8_LDB
#undef PG8_MMA
#undef PG8_WAIT_V
#undef PG8_WAIT_L
#undef PG8_BAR
#undef PG8_SCHED
}
}

constexpr int BATCH = 4, T = 4096, D = 1024, M = BATCH * T, DIN = 12288, DEPTH = 2, NWAVES = 8;
constexpr int NA = 8192, NB = 4096;
constexpr float EPS = 1e-6f;
#ifndef N_LAUNCHES
#define N_LAUNCHES 1
#endif
constexpr int NPHASES = 1 + 7 * DEPTH;

constexpr size_t MiB = 1u << 20;
constexpr size_t WS_CTL = 0, CTL_ZERO_BYTES = 1 * MiB;
constexpr size_t WS_R1 = 1 * MiB, WS_R2 = 326 * MiB;
constexpr size_t RW_IN = 0, RW_A = 24 * MiB, RW_B = 26 * MiB, RW_O = 30 * MiB;
constexpr size_t WS_COS = 33 * MiB, WS_SIN = 35 * MiB;
constexpr size_t WS_RSTD = 37 * MiB, WS_SSQ = 37 * MiB + 65536;
constexpr size_t WS_XB = 38 * MiB;
constexpr size_t WS_U = 70 * MiB, WS_BZ = 102 * MiB;
constexpr size_t WS_QT = 134 * MiB, WS_KT = 166 * MiB;
constexpr size_t WS_V = 198 * MiB;
constexpr size_t WS_O = 262 * MiB;
constexpr size_t WS_SG = WS_QT;
constexpr size_t WS_YAG = WS_V;
constexpr size_t WS_MG = WS_U;
constexpr size_t WS_END = 358 * MiB;
constexpr int CW_BAR = 4096;

constexpr int RING_BYTES = 147456, LDSCTL_OFF = RING_BYTES, MISC_OFF = LDSCTL_OFF + 320, LDS_BYTES = RING_BYTES + 1024;

#define GAS __attribute__((address_space(1)))
#define LAS __attribute__((address_space(3)))
typedef unsigned short bf16;
typedef unsigned v4u __attribute__((ext_vector_type(4)));
typedef unsigned v2u __attribute__((ext_vector_type(2)));
typedef float f32x4 __attribute__((ext_vector_type(4)));
typedef float f32x16 __attribute__((ext_vector_type(16)));
typedef short bf16x8 __attribute__((ext_vector_type(8)));
typedef short s16x4 __attribute__((ext_vector_type(4)));
typedef float f32x2_t __attribute__((ext_vector_type(2)));
typedef __bf16 bf16x2_t __attribute__((ext_vector_type(2)));
typedef GAS unsigned gu32;
#define LDS_WAIT() asm volatile("s_waitcnt lgkmcnt(0)" ::: "memory")
#define MFMA32(a, b, c) __builtin_amdgcn_mfma_f32_32x32x16_bf16((a), (b), (c), 0, 0, 0)

__device__ __forceinline__ unsigned pk2(float lo, float hi) { f32x2_t v = {lo, hi}; bf16x2_t b = __builtin_convertvector(v, bf16x2_t); return __builtin_bit_cast(unsigned, b); }
__device__ __forceinline__ float bf_lo(unsigned u) { return __uint_as_float(u << 16); }
__device__ __forceinline__ float bf_hi(unsigned u) { return __uint_as_float(u & 0xffff0000u); }
__device__ __forceinline__ float sigm(float x) { return __builtin_amdgcn_rcpf(1.0f + __expf(-x)); }
__device__ __forceinline__ int crow(int r, int hi) { return (r & 3) + 8 * (r >> 2) + 4 * hi; }
__device__ __forceinline__ float log2_gamma(int h) { return h == 0 ? -0.04580368961312479f : h == 1 ? -0.02272007650008353f : h == 2 ? -0.011315313227834146f : -0.005646563141142063f; }
typedef short v4i16_t __attribute__((ext_vector_type(4)));
__device__ __forceinline__ s16x4 vtr(const LAS char* p) { return __builtin_bit_cast(s16x4, __builtin_amdgcn_ds_read_tr16_b64_v4i16((LAS v4i16_t*)p)); }
__device__ __forceinline__ bf16x8 trpair(const LAS char* p, int hi_off) { const s16x4 lo = vtr(p), hi = vtr(p + hi_off); return (bf16x8){lo[0], lo[1], lo[2], lo[3], hi[0], hi[1], hi[2], hi[3]}; }

using pg8::Unit;
struct EpiA {
    static constexpr bool PERM = false, AFTER_DRAIN = false;
    const float* rstd; const float* cosT; const float* sinT; bf16* U; bf16* BZ; bf16* QT; bf16* KT; bf16* V;
    __device__ __forceinline__ void operator()(const f32x4 (&acc)[2][2][4][2], const Unit& u, int wr, int wc, int fr, int fq) const {
        const int row0 = u.pm * 256 + wr * 64 + fr;
        if (u.pn < 16) {
            const int ch0 = u.pn * 64 + wc * 16 + fq * 4;
#pragma unroll
            for (int ai = 0; ai < 2; ++ai)
#pragma unroll
                for (int m = 0; m < 4; ++m) {
                    const int row = row0 + ai * 128 + m * 16; const float rs = rstd[row];
                    const f32x4 b = acc[ai][0][m][0] * rs, c = acc[ai][0][m][1] * rs, x = acc[ai][1][m][0] * rs, z = acc[ai][1][m][1] * rs;
                    const f32x4 uu = c * x; f32x4 bz;
#pragma unroll
                    for (int j = 0; j < 4; ++j) bz[j] = b[j] * z[j] * sigm(z[j]);
                    v2u w0, w1; w0.x = pk2(uu[0], uu[1]); w0.y = pk2(uu[2], uu[3]); w1.x = pk2(bz[0], bz[1]); w1.y = pk2(bz[2], bz[3]);
                    *(v2u*)(U + (size_t)row * 1024 + ch0) = w0; *(v2u*)(BZ + (size_t)row * 1024 + ch0) = w1;
                    asm volatile("" ::: "memory");
                }
        } else if (u.pn < 24) {
            const int hd = (u.pn - 16) & 3; const bool isk = u.pn >= 20; bf16* dst = isk ? KT : QT;
            const float lg = log2_gamma(hd); const int f0 = wc * 32 + fq * 8;
#pragma unroll
            for (int ai = 0; ai < 2; ++ai)
#pragma unroll
                for (int m = 0; m < 4; ++m) {
                    const int row = row0 + ai * 128 + m * 16; const int pos = row & (T - 1); const float p = (float)(pos & 511);
                    const float sc = rstd[row] * (isk ? exp2f(-p * lg) * 0.0625f : exp2f(p * lg));
                    const f32x4 c0 = *(const f32x4*)(cosT + (size_t)pos * 128 + f0), c1 = *(const f32x4*)(cosT + (size_t)pos * 128 + f0 + 4);
                    const f32x4 s0 = *(const f32x4*)(sinT + (size_t)pos * 128 + f0), s1 = *(const f32x4*)(sinT + (size_t)pos * 128 + f0 + 4);
                    const f32x4 t1a = acc[ai][0][m][0], t1b = acc[ai][0][m][1], t2a = acc[ai][1][m][0], t2b = acc[ai][1][m][1];
                    const f32x4 o1a = (t1a * c0 - t2a * s0) * sc, o1b = (t1b * c1 - t2b * s1) * sc, o2a = (t1a * s0 + t2a * c0) * sc, o2b = (t1b * s1 + t2b * c1) * sc;
                    v4u w1, w2; w1.x = pk2(o1a[0], o1a[1]); w1.y = pk2(o1a[2], o1a[3]); w1.z = pk2(o1b[0], o1b[1]); w1.w = pk2(o1b[2], o1b[3]);
                    w2.x = pk2(o2a[0], o2a[1]); w2.y = pk2(o2a[2], o2a[3]); w2.z = pk2(o2b[0], o2b[1]); w2.w = pk2(o2b[2], o2b[3]);
                    bf16* rp = dst + (size_t)row * 1024 + hd * 256 + f0;
                    *(v4u*)rp = w1; *(v4u*)(rp + 128) = w2;
                    asm volatile("" ::: "memory");
                }
        } else {
            const int col0 = (u.pn - 24) * 256 + wc * 32 + fq * 8;
#pragma unroll
            for (int ai = 0; ai < 2; ++ai)
#pragma unroll
                for (int m = 0; m < 4; ++m) {
                    const int row = row0 + ai * 128 + m * 16; const float rs = rstd[row];
#pragma unroll
                    for (int bj = 0; bj < 2; ++bj) { const f32x4 a = acc[ai][bj][m][0] * rs, b = acc[ai][bj][m][1] * rs;
                        v4u w; w.x = pk2(a[0], a[1]); w.y = pk2(a[2], a[3]); w.z = pk2(b[0], b[1]); w.w = pk2(b[2], b[3]);
                        *(v4u*)(V + (size_t)row * 2048 + col0 + bj * 128) = w; }
                    asm volatile("" ::: "memory");
                }
        }
    }
};
struct EpiB {
    static constexpr bool PERM = false, AFTER_DRAIN = false;
    const float* rstd; const float* ssq; bf16* O; bf16* SG;
    __device__ __forceinline__ void operator()(const f32x4 (&acc)[2][2][4][2], const Unit& u, int wr, int wc, int fr, int fq) const {
        const int row0 = u.pm * 256 + wr * 64 + fr;
        if (u.pn < 8) {
            const int hd = u.pn >> 1, col0 = u.pn * 256 + wc * 32 + fq * 8;
#pragma unroll
            for (int ai = 0; ai < 2; ++ai)
#pragma unroll
                for (int m = 0; m < 4; ++m) {
                    const int row = row0 + ai * 128 + m * 16; const float rs = rstd[row];
                    const float rg = rsqrtf(ssq[(size_t)row * 4 + hd] * (1.0f / 512.0f) + EPS);
#pragma unroll
                    for (int bj = 0; bj < 2; ++bj) {
                        bf16* op = O + (size_t)row * 2048 + col0 + bj * 128; const v4u ov = *(const v4u*)op;
                        const f32x4 za = acc[ai][bj][m][0] * rs, zb = acc[ai][bj][m][1] * rs;
                        float r[8];
                        r[0] = bf_lo(ov.x) * rg * za[0] * sigm(za[0]); r[1] = bf_hi(ov.x) * rg * za[1] * sigm(za[1]);
                        r[2] = bf_lo(ov.y) * rg * za[2] * sigm(za[2]); r[3] = bf_hi(ov.y) * rg * za[3] * sigm(za[3]);
                        r[4] = bf_lo(ov.z) * rg * zb[0] * sigm(zb[0]); r[5] = bf_hi(ov.z) * rg * zb[1] * sigm(zb[1]);
                        r[6] = bf_lo(ov.w) * rg * zb[2] * sigm(zb[2]); r[7] = bf_hi(ov.w) * rg * zb[3] * sigm(zb[3]);
                        v4u w; w.x = pk2(r[0], r[1]); w.y = pk2(r[2], r[3]); w.z = pk2(r[4], r[5]); w.w = pk2(r[6], r[7]);
                        *(v4u*)op = w;
                    }
                    asm volatile("" ::: "memory");
                }
        } else {
            const int col0 = (u.pn - 8) * 256 + wc * 32 + fq * 8;
#pragma unroll
            for (int ai = 0; ai < 2; ++ai)
#pragma unroll
                for (int m = 0; m < 4; ++m) {
                    const int row = row0 + ai * 128 + m * 16; const float rs = rstd[row];
#pragma unroll
                    for (int bj = 0; bj < 2; ++bj) { const f32x4 a = acc[ai][bj][m][0] * rs, b = acc[ai][bj][m][1] * rs;
                        v4u w; w.x = pk2(sigm(a[0]), sigm(a[1])); w.y = pk2(sigm(a[2]), sigm(a[3])); w.z = pk2(sigm(b[0]), sigm(b[1])); w.w = pk2(sigm(b[2]), sigm(b[3]));
                        *(v4u*)(SG + (size_t)row * 2048 + col0 + bj * 128) = w; }
                    asm volatile("" ::: "memory");
                }
        }
    }
};
struct EpiYA {
    static constexpr bool PERM = false, AFTER_DRAIN = false;
    const bf16* SG; float* YAG;
    __device__ __forceinline__ void operator()(const f32x4 (&acc)[2][2][4][2], const Unit& u, int wr, int wc, int fr, int fq) const {
        const int row0 = u.pm * 256 + wr * 64 + fr, col0 = u.pn * 256 + wc * 32 + fq * 8;
#pragma unroll
        for (int ai = 0; ai < 2; ++ai)
#pragma unroll
            for (int m = 0; m < 4; ++m) { const int row = row0 + ai * 128 + m * 16;
#pragma unroll
                for (int bj = 0; bj < 2; ++bj) { const v4u g = *(const v4u*)(SG + (size_t)row * 2048 + col0 + bj * 128);
                    f32x4 a = acc[ai][bj][m][0], b = acc[ai][bj][m][1];
                    a[0] *= bf_lo(g.x); a[1] *= bf_hi(g.x); a[2] *= bf_lo(g.y); a[3] *= bf_hi(g.y); b[0] *= bf_lo(g.z); b[1] *= bf_hi(g.z); b[2] *= bf_lo(g.w); b[3] *= bf_hi(g.w);
                    float* yp = YAG + (size_t)row * 1024 + col0 + bj * 128; *(f32x4*)yp = a; *(f32x4*)(yp + 4) = b; } asm volatile("" ::: "memory"); }
    }
};
struct EpiMG {
    static constexpr bool PERM = false, AFTER_DRAIN = false;
    const bf16* SG; const float* YAG; bf16* MG;
    __device__ __forceinline__ void operator()(const f32x4 (&acc)[2][2][4][2], const Unit& u, int wr, int wc, int fr, int fq) const {
        const int row0 = u.pm * 256 + wr * 64 + fr, col0 = u.pn * 256 + wc * 32 + fq * 8;
#pragma unroll
        for (int ai = 0; ai < 2; ++ai)
#pragma unroll
            for (int m = 0; m < 4; ++m) { const int row = row0 + ai * 128 + m * 16;
#pragma unroll
                for (int bj = 0; bj < 2; ++bj) { const v4u g = *(const v4u*)(SG + (size_t)row * 2048 + 1024 + col0 + bj * 128);
                    const float* yp = YAG + (size_t)row * 1024 + col0 + bj * 128; f32x4 a = *(const f32x4*)yp, b = *(const f32x4*)(yp + 4);
                    const f32x4 ca = acc[ai][bj][m][0], cb = acc[ai][bj][m][1];
                    a[0] += ca[0] * bf_lo(g.x); a[1] += ca[1] * bf_hi(g.x); a[2] += ca[2] * bf_lo(g.y); a[3] += ca[3] * bf_hi(g.y);
                    b[0] += cb[0] * bf_lo(g.z); b[1] += cb[1] * bf_hi(g.z); b[2] += cb[2] * bf_lo(g.w); b[3] += cb[3] * bf_hi(g.w);
                    v4u w; w.x = pk2(a[0], a[1]); w.y = pk2(a[2], a[3]); w.z = pk2(b[0], b[1]); w.w = pk2(b[2], b[3]);
                    *(v4u*)(MG + (size_t)row * 1024 + col0 + bj * 128) = w; } asm volatile("" ::: "memory"); }
    }
};
struct EpiRes {
    static constexpr bool PERM = false, AFTER_DRAIN = false;
    const float* xres; float* xout;
    __device__ __forceinline__ void operator()(const f32x4 (&acc)[2][2][4][2], const Unit& u, int wr, int wc, int fr, int fq) const {
        const int row0 = u.pm * 256 + wr * 64 + fr, col0 = u.pn * 256 + wc * 32 + fq * 4;
#pragma unroll
        for (int ai = 0; ai < 2; ++ai)
#pragma unroll
            for (int m = 0; m < 4; ++m) { const size_t off = (size_t)(row0 + ai * 128 + m * 16) * 1024 + col0;
#pragma unroll
                for (int bj = 0; bj < 2; ++bj)
#pragma unroll
                    for (int n = 0; n < 2; ++n) { const f32x4 r = *(const f32x4*)(xres + off + bj * 128 + n * 16); *(f32x4*)(xout + off + bj * 128 + n * 16) = r + acc[ai][bj][m][n]; } asm volatile("" ::: "memory"); }
    }
};
#define XB_TMO      128
#define XB_XCNT(j)  (256  + 64 * (j))
#define XB_XSUB(j)  (1280 + 64 * (j))
#define XB_XGEN(j)  (2304 + 64 * (j))
#define XB_TOP      3328
#define XB_TOPGEN   3392
#define XCD_BAR_WORDS 3456
#define XB_SPIN_CAP (1u << 18)

__device__ __forceinline__ unsigned xb_ld(unsigned* p)              { return __hip_atomic_load(p, __ATOMIC_RELAXED, __HIP_MEMORY_SCOPE_AGENT); }
__device__ __forceinline__ unsigned xb_add(unsigned* p, unsigned v) { return __hip_atomic_fetch_add(p, v, __ATOMIC_RELAXED, __HIP_MEMORY_SCOPE_AGENT); }
__device__ __forceinline__ unsigned xb_xcc_id() { return (unsigned)__builtin_amdgcn_s_getreg((3 << 11) | 20) & 0xFu; }
#define XB_SPIN(cond, bar) do { unsigned _sp = 0; while (cond) { __builtin_amdgcn_s_sleep(1); \
    if ((++_sp & 255u) == 0u) { if (xb_ld(&(bar)[XB_TMO])) break; if (_sp > XB_SPIN_CAP) { atomicAdd(&(bar)[XB_TMO], 1u); break; } } } } while (0)

struct XcdBarrier {
    unsigned* bar; unsigned x;
    volatile LAS unsigned* st;
};

__device__ __forceinline__ XcdBarrier xcd_barrier_post(unsigned* bar, volatile LAS unsigned* st) {
    XcdBarrier b; b.bar = bar; b.x = xb_xcc_id(); b.st = st;
    if (threadIdx.x == 0) (void)xb_add(&bar[XB_XCNT(b.x)], 1u);
    return b;
}
__device__ __forceinline__ void xcd_barrier_complete(unsigned* bar, unsigned x, unsigned& nloc, unsigned& nx) {
    const unsigned G = gridDim.x * gridDim.y * gridDim.z;
    unsigned sum, cnt, mine, sp = 0u;
    for (;;) {
        sum = 0u; cnt = 0u; mine = 0u;
#pragma unroll
        for (unsigned j = 0; j < 16; ++j) { const unsigned c = xb_ld(&bar[XB_XCNT(j)]); sum += c; cnt += (c > 0u) ? 1u : 0u; mine = (j == x) ? c : mine; }
        if (sum == G) break;
        __builtin_amdgcn_s_sleep(1);
        if ((++sp & 255u) == 0u) { if (xb_ld(&bar[XB_TMO])) break; if (sp > XB_SPIN_CAP) { atomicAdd(&bar[XB_TMO], 1u); break; } }
    }
    nloc = mine > 0u ? mine : 1u; nx = cnt > 0u ? cnt : 1u;
}

__device__ __forceinline__ void xcd_barrier(const XcdBarrier& b) {
    asm volatile("s_waitcnt vmcnt(0)" ::: "memory");
    __syncthreads();
    if (threadIdx.x == 0) {
        unsigned* bar = b.bar;
        __builtin_amdgcn_s_waitcnt(0);
        unsigned nloc = b.st[0], nx = b.st[1];
        if (nloc == 0u) { xcd_barrier_complete(bar, b.x, nloc, nx); b.st[0] = nloc; b.st[1] = nx; }
        const unsigned old = xb_add(&bar[XB_XSUB(b.x)], 1u);
        const unsigned gen = old / nloc;
        if (old + 1u == (gen + 1u) * nloc) {
            __builtin_amdgcn_fence(__ATOMIC_RELEASE, "agent");
            asm volatile("s_waitcnt vmcnt(0)" ::: "memory");
            const unsigned og = xb_add(&bar[XB_TOP], 1u);
            const unsigned tg = og / nx;
            if (og + 1u == (tg + 1u) * nx) xb_add(&bar[XB_TOPGEN], 1u);
            else XB_SPIN(xb_ld(&bar[XB_TOPGEN]) == tg, bar);
            __builtin_amdgcn_fence(__ATOMIC_ACQUIRE, "agent");
            xb_add(&bar[XB_XGEN(b.x)], 1u);
            asm volatile("s_waitcnt vmcnt(0)" ::: "memory");
        } else {
            XB_SPIN(xb_ld(&bar[XB_XGEN(b.x)]) == gen, bar);
            __builtin_amdgcn_fence(__ATOMIC_ACQUIRE, "agent");
            asm volatile("s_waitcnt vmcnt(0)" ::: "memory");
        }
    }
    __syncthreads();
}

struct Frame {
    LAS unsigned char* lds; volatile LAS unsigned* MISC; gu32* ctl;
    int tid, lane, wave, vcu, G;
    const float* in[9]; float* out; unsigned char* ws;
};
__device__ __forceinline__ float wave_sum(float v) {
#pragma unroll
    for (int o = 1; o < 64; o <<= 1) v += __shfl_xor(v, o);
    return v;
}
__device__ __forceinline__ int prow(int mode, int n) {
    if (mode == 0) return n;
    if (mode == 2 && n < 4096) { const int type = n >> 10, chg = n & 1023, pc = chg >> 6, ch = chg & 63;
        return 256 * pc + 128 * (type >> 1) + 32 * (ch >> 4) + 16 * (type & 1) + 4 * ((ch >> 2) & 3) + (ch & 3); }
    const int l32 = n & 31; return (n & ~31) | (16 * ((l32 >> 2) & 1) + 4 * (l32 >> 3) + (l32 & 3));
}
__device__ __forceinline__ void cvt_item(const float* W, int K, int N, bf16* WT, const float* gk, int mode, LAS float* scr, int item, int lane) {
    const int nblk = N / 32, kb = item / nblk, nb = item % nblk, k0 = 64 * kb, n0 = 32 * nb;
#pragma unroll 8
    for (int i = 0; i < 32; ++i) { const int kk = 2 * i + (lane >> 5); float v = W[(size_t)(k0 + kk) * N + n0 + (lane & 31)]; if (gk) v *= gk[k0 + kk]; scr[kk * 33 + (lane & 31)] = v; }
    LDS_WAIT(); asm volatile("" ::: "memory");
    const int c = lane & 7;
#pragma unroll
    for (int j = 0; j < 4; ++j) { const int n = (lane >> 3) + 8 * j; const LAS float* s = scr + (8 * c) * 33 + n;
        v4u o; o.x = pk2(s[0 * 33], s[1 * 33]); o.y = pk2(s[2 * 33], s[3 * 33]); o.z = pk2(s[4 * 33], s[5 * 33]); o.w = pk2(s[6 * 33], s[7 * 33]);
        *(GAS v4u*)(WT + (size_t)prow(mode, n0 + n) * K + k0 + 8 * c) = o; }
    LDS_WAIT(); asm volatile("" ::: "memory");
}
__device__ __forceinline__ void convert_layer(Frame& F, int l, unsigned char* region) {
    LAS float* scr = (LAS float*)(F.lds + F.wave * 16384);
    const int gw = F.vcu * NWAVES + F.wave, NGW = F.G * NWAVES;
    constexpr int I_IN = (D / 64) * (DIN / 32), I_A = (D / 64) * (D / 32), I_B = (2 * D / 64) * (D / 32), I_O = I_A;
    const float* w_in = F.in[2] + (size_t)l * D * DIN; const float* ng = F.in[1] + (size_t)l * D;
    const float* w_a = F.in[5] + (size_t)l * D * D; const float* w_b = F.in[6] + (size_t)l * 2 * D * D; const float* w_o = F.in[7] + (size_t)l * D * D;
    for (int it = gw; it < I_IN + I_A + I_B + I_O; it += NGW) {
        int r = it;
        if (r < I_IN) { cvt_item(w_in, D, DIN, (bf16*)(region + RW_IN), ng, 2, scr, r, F.lane); continue; } r -= I_IN;
        if (r < I_A) { cvt_item(w_a, D, D, (bf16*)(region + RW_A), nullptr, 1, scr, r, F.lane); continue; } r -= I_A;
        if (r < I_B) { cvt_item(w_b, 2 * D, D, (bf16*)(region + RW_B), nullptr, 1, scr, r, F.lane); continue; } r -= I_B;
        cvt_item(w_o, D, D, (bf16*)(region + RW_O), nullptr, 0, scr, r, F.lane);
    }
}
__device__ __forceinline__ void rownorm(Frame& F, const float* src, bf16* xb, float* rstd) {
    const int gw = F.vcu * NWAVES + F.wave, NGW = F.G * NWAVES;
    for (int m = gw; m < M; m += NGW) {
        const GAS f32x4* xr = (const GAS f32x4*)(src + (size_t)m * D) + F.lane;
        f32x4 v[4]; float s = 0.f;
#pragma unroll
        for (int j = 0; j < 4; ++j) { v[j] = xr[64 * j]; s += (v[j].x * v[j].x + v[j].y * v[j].y) + (v[j].z * v[j].z + v[j].w * v[j].w); }
        s = wave_sum(s);
        if (F.lane == 0) rstd[m] = rsqrtf(s * (1.f / D) + EPS);
        GAS v2u* o8 = (GAS v2u*)(xb + (size_t)m * D) + F.lane;
#pragma unroll
        for (int j = 0; j < 4; ++j) { v2u w; w.x = pk2(v[j].x, v[j].y); w.y = pk2(v[j].z, v[j].w); o8[64 * j] = w; }
    }
}
__device__ __forceinline__ void final_norm(Frame& F, float* x, const float* g) {
    const int gw = F.vcu * NWAVES + F.wave, NGW = F.G * NWAVES;
    for (int m = gw; m < M; m += NGW) {
        GAS f32x4* xr = (GAS f32x4*)(x + (size_t)m * D) + F.lane; const GAS f32x4* gr = (const GAS f32x4*)g + F.lane;
        f32x4 v[4]; float s = 0.f;
#pragma unroll
        for (int j = 0; j < 4; ++j) { v[j] = xr[64 * j]; s += (v[j].x * v[j].x + v[j].y * v[j].y) + (v[j].z * v[j].z + v[j].w * v[j].w); }
        const float r = rsqrtf(wave_sum(s) * (1.f / D) + EPS);
#pragma unroll
        for (int j = 0; j < 4; ++j) xr[64 * j] = v[j] * r * gr[64 * j];
    }
}
__device__ __forceinline__ void rotary_tables(Frame& F, float* cosT, float* sinT) {
    const int gt = F.vcu * (NWAVES * 64) + F.tid, NT = F.G * NWAVES * 64;
    for (int idx = gt; idx < T * 128; idx += NT) {
        const int pos = idx >> 7, f = idx & 127;
        double inv = 1.0, bq = 0.930572040929699;
#pragma unroll
        for (int bit = 0; bit < 7; ++bit) { if ((f >> bit) & 1) inv *= bq; bq *= bq; }
        const double a = (double)pos * inv;
        const double kd = __builtin_rint(a * 0.6366197723675814);
        const double r = (a - kd * 1.5707963267948966) - kd * 6.123233995736766e-17;
        const double r2 = r * r;
        double sp = -1.0 / 355687428096000.0;
        sp = sp * r2 + 1.0 / 1307674368000.0; sp = sp * r2 - 1.0 / 6227020800.0; sp = sp * r2 + 1.0 / 39916800.0; sp = sp * r2 - 1.0 / 362880.0;
        sp = sp * r2 + 1.0 / 5040.0; sp = sp * r2 - 1.0 / 120.0; sp = sp * r2 + 1.0 / 6.0; const double sn = r - r * r2 * sp;
        double cp = 1.0 / 20922789888000.0;
        cp = cp * r2 - 1.0 / 87178291200.0; cp = cp * r2 + 1.0 / 479001600.0; cp = cp * r2 - 1.0 / 3628800.0; cp = cp * r2 + 1.0 / 40320.0;
        cp = cp * r2 - 1.0 / 720.0; cp = cp * r2 + 1.0 / 24.0; cp = cp * r2 - 0.5; const double cs = 1.0 + r2 * cp;
        const int k = (int)kd & 3;
        const double c = (k == 0) ? cs : (k == 1) ? -sn : (k == 2) ? -cs : sn;
        const double s = (k == 0) ? sn : (k == 1) ? cs : (k == 2) ? -sn : -cs;
        cosT[idx] = (float)c; sinT[idx] = (float)s;
    }
}
__device__ __forceinline__ void conv_pass(Frame& F, const bf16* U, bf16* BZ, const float* cw, const float* cb) {
    const int gt = F.vcu * (NWAVES * 64) + F.tid, NT = F.G * NWAVES * 64;
    for (int v = gt; v < M * 128; v += NT) {
        const int row = v >> 7, c8 = (v & 127) * 8, t = row & (T - 1);
        const v4u z4 = {0u, 0u, 0u, 0u};
        const v4u u0 = *(const v4u*)(U + (size_t)row * 1024 + c8);
        const v4u u1 = t >= 1 ? *(const v4u*)(U + (size_t)(row - 1) * 1024 + c8) : z4;
        const v4u u2 = t >= 2 ? *(const v4u*)(U + (size_t)(row - 2) * 1024 + c8) : z4;
        bf16* bp = BZ + (size_t)row * 1024 + c8; const v4u bz = *(const v4u*)bp;
        float w0[8], w1[8], w2[8], bb[8];
        *(f32x4*)&w0[0] = *(const f32x4*)(cw + c8); *(f32x4*)&w0[4] = *(const f32x4*)(cw + c8 + 4);
        *(f32x4*)&w1[0] = *(const f32x4*)(cw + 1024 + c8); *(f32x4*)&w1[4] = *(const f32x4*)(cw + 1024 + c8 + 4);
        *(f32x4*)&w2[0] = *(const f32x4*)(cw + 2048 + c8); *(f32x4*)&w2[4] = *(const f32x4*)(cw + 2048 + c8 + 4);
        *(f32x4*)&bb[0] = *(const f32x4*)(cb + c8); *(f32x4*)&bb[4] = *(const f32x4*)(cb + c8 + 4);
        float y[8];
#pragma unroll
        for (int i = 0; i < 4; ++i) {
            const unsigned a0 = u0[i], a1 = u1[i], a2 = u2[i], bzz = bz[i];
            y[2 * i]     = bf_lo(bzz) * (w0[2 * i] * bf_lo(a2) + w1[2 * i] * bf_lo(a1) + w2[2 * i] * bf_lo(a0) + bb[2 * i]);
            y[2 * i + 1] = bf_hi(bzz) * (w0[2 * i + 1] * bf_hi(a2) + w1[2 * i + 1] * bf_hi(a1) + w2[2 * i + 1] * bf_hi(a0) + bb[2 * i + 1]);
        }
        v4u w; w.x = pk2(y[0], y[1]); w.y = pk2(y[2], y[3]); w.z = pk2(y[4], y[5]); w.w = pk2(y[6], y[7]);
        *(v4u*)bp = w;
    }
}
constexpr int CH_KSTR = 576, CH_VSTR = 64, CH_VOFF = 128 * CH_KSTR;
__device__ __forceinline__ void conv_one(int v, const bf16* U, bf16* BZ, const float* cw, const float* cb) {
    const int row = v >> 7, c8 = (v & 127) * 8, t = row & (T - 1);
    const v4u z4 = {0u, 0u, 0u, 0u};
    const v4u u0 = *(const v4u*)(U + (size_t)row * 1024 + c8);
    const v4u u1 = t >= 1 ? *(const v4u*)(U + (size_t)(row - 1) * 1024 + c8) : z4;
    const v4u u2 = t >= 2 ? *(const v4u*)(U + (size_t)(row - 2) * 1024 + c8) : z4;
    bf16* bp = BZ + (size_t)row * 1024 + c8; const v4u bz = *(const v4u*)bp;
    float w0[8], w1[8], w2[8], bb[8];
    *(f32x4*)&w0[0] = *(const f32x4*)(cw + c8); *(f32x4*)&w0[4] = *(const f32x4*)(cw + c8 + 4);
    *(f32x4*)&w1[0] = *(const f32x4*)(cw + 1024 + c8); *(f32x4*)&w1[4] = *(const f32x4*)(cw + 1024 + c8 + 4);
    *(f32x4*)&w2[0] = *(const f32x4*)(cw + 2048 + c8); *(f32x4*)&w2[4] = *(const f32x4*)(cw + 2048 + c8 + 4);
    *(f32x4*)&bb[0] = *(const f32x4*)(cb + c8); *(f32x4*)&bb[4] = *(const f32x4*)(cb + c8 + 4);
    float y[8];
#pragma unroll
    for (int i = 0; i < 4; ++i) {
        const unsigned a0 = u0[i], a1 = u1[i], a2 = u2[i], bzz = bz[i];
        y[2 * i]     = bf_lo(bzz) * (w0[2 * i] * bf_lo(a2) + w1[2 * i] * bf_lo(a1) + w2[2 * i] * bf_lo(a0) + bb[2 * i]);
        y[2 * i + 1] = bf_hi(bzz) * (w0[2 * i + 1] * bf_hi(a2) + w1[2 * i + 1] * bf_hi(a1) + w2[2 * i + 1] * bf_hi(a0) + bb[2 * i + 1]);
    }
    v4u w; w.x = pk2(y[0], y[1]); w.y = pk2(y[2], y[3]); w.z = pk2(y[4], y[5]); w.w = pk2(y[6], y[7]);
    *(v4u*)bp = w;
}
template <bool CONV>
__device__ __forceinline__ void chain_item(Frame& F, int bh, int sl, const bf16* KT, const bf16* V, bf16* ST, const bf16* U, bf16* BZ, const float* cw, const float* cb) {
    int tid_ = F.tid; asm volatile("" : "+v"(tid_));
    const int b = bh >> 2, h = bh & 3, tid = tid_, lane = tid & 63, w = __builtin_amdgcn_readfirstlane(tid >> 6);
    const int hl = lane >> 5, l31 = lane & 31, q = (lane & 15) >> 2, p = lane & 3, blk = (lane >> 4) & 1;
    LAS char* Kt = (LAS char*)F.lds; LAS char* Vt = Kt + CH_VOFF;
    const float g512 = exp2f(512.0f * log2_gamma(h));
    const int gt = F.vcu * (NWAVES * 64) + tid, NT = F.G * NWAVES * 64;
    f32x16 S;
#pragma unroll
    for (int i = 0; i < 16; ++i) S[i] = 0.f;
    bf16* STb = ST + (size_t)bh * 8 * 512 * 256 + ((size_t)sl * 32 + l31) * 256 + w * 32 + 4 * hl;
    const bf16* kg = KT + ((size_t)b * T + (tid >> 5)) * 1024 + h * 256 + (tid & 31) * 8;
    const bf16* vg = V + ((size_t)b * T + (tid >> 2)) * 2048 + h * 512 + sl * 32 + (tid & 3) * 8;
    LAS char* kl = Kt + (tid >> 5) * CH_KSTR + (tid & 31) * 16;
    LAS char* vl = Vt + (tid >> 2) * CH_VSTR + (tid & 3) * 16;
    v4u kr[8], vr;
#pragma unroll
    for (int i = 0; i < 8; ++i) kr[i] = *(const v4u*)(kg + (size_t)i * 16 * 1024);
    vr = *(const v4u*)vg;
#pragma unroll
    for (int g = 0; g < 4; ++g) { v2u w2; w2.x = 0u; w2.y = 0u; *(v2u*)(STb + 8 * g) = w2; }
#pragma unroll 1
    for (int it = 0; it < 28; ++it) {
        __syncthreads();
#pragma unroll
        for (int i = 0; i < 8; ++i) *(LAS v4u*)(kl + i * 16 * CH_KSTR) = kr[i];
        *(LAS v4u*)vl = vr;
        if (it + 1 < 28) {
#pragma unroll
            for (int i = 0; i < 8; ++i) kr[i] = *(const v4u*)(kg + (size_t)(it + 1) * 128 * 1024 + (size_t)i * 16 * 1024);
            vr = *(const v4u*)(vg + (size_t)(it + 1) * 128 * 2048);
        }
        if (CONV && it < 16) conv_one(gt + NT * it, U, BZ, cw, cb);
        __syncthreads();
#pragma unroll
        for (int ks = 0; ks < 8; ++ks) {
            const int kr_ = 16 * ks + 8 * hl + q;
            const bf16x8 A = trpair(Kt + kr_ * CH_KSTR + 2 * (32 * w + 16 * blk + 4 * p), 4 * CH_KSTR);
            const bf16x8 B = trpair(Vt + kr_ * CH_VSTR + 2 * (16 * blk + 4 * p), 4 * CH_VSTR);
            S = MFMA32(A, B, S);
        }
        if ((it & 3) == 3) {
#pragma unroll
            for (int i = 0; i < 16; ++i) S[i] *= g512;
            const int s1 = (it >> 2) + 1;
#pragma unroll
            for (int g = 0; g < 4; ++g) { v2u w2; w2.x = pk2(S[4 * g], S[4 * g + 1]); w2.y = pk2(S[4 * g + 2], S[4 * g + 3]); *(v2u*)(STb + (size_t)s1 * 512 * 256 + 8 * g) = w2; }
        }
    }
}
constexpr int AP_STR = 528, AP_VSTR = 1088, AP_KOFF = 128 * AP_STR, AP_VOFF = AP_KOFF + 32 * AP_STR, AP_SOFF = AP_KOFF, AP_RED = 8 * 32 * AP_STR;
static_assert(AP_VOFF + 32 * AP_VSTR <= RING_BYTES && AP_SOFF + 64 * AP_STR <= RING_BYTES && AP_RED + 1024 <= RING_BYTES, "apply LDS map");
__device__ __forceinline__ void apply_item(Frame& F, int bh, int r, const bf16* QT, const bf16* KT, const bf16* V, const bf16* ST, bf16* O, float* ssq) {
    int tid_ = F.tid; asm volatile("" : "+v"(tid_));
    const int b = bh >> 2, h = bh & 3, tid = tid_, lane = tid & 63, w = __builtin_amdgcn_readfirstlane(tid >> 6);
    const int hl = lane >> 5, l31 = lane & 31, q = (lane & 15) >> 2, p = lane & 3, blk = (lane >> 4) & 1;
    const int ig = w & 3, dh = w >> 2, s = r >> 2, t0 = r * 128;
    LAS char* Qs = (LAS char*)F.lds; LAS char* Ks = Qs + AP_KOFF; LAS char* Vs = Qs + AP_VOFF; LAS char* Ss = Qs + AP_SOFF; LAS float* red = (LAS float*)(Qs + AP_RED);
    f32x16 acc[8];
#pragma unroll
    for (int mt = 0; mt < 8; ++mt)
#pragma unroll
        for (int i = 0; i < 16; ++i) acc[mt][i] = 0.f;
    const int ntile = 4 * (r - 4 * s + 1), dtile0 = 4 * (r - 4 * s);
    const size_t key0 = (size_t)b * T + s * 512;
    const bf16* kg = KT + (key0 + (tid >> 5)) * 1024 + h * 256 + (tid & 31) * 8;
    const bf16* vg = V + (key0 + (tid >> 6)) * 2048 + h * 512 + (tid & 63) * 8;
    LAS char* kl = Ks + (tid >> 5) * AP_STR + (tid & 31) * 16;
    LAS char* vl = Vs + (tid >> 6) * AP_VSTR + (tid & 63) * 16;
    v4u kr[2], vr[4];
#pragma unroll
    for (int i = 0; i < 2; ++i) kr[i] = *(const v4u*)(kg + (size_t)i * 16 * 1024);
#pragma unroll
    for (int i = 0; i < 4; ++i) vr[i] = *(const v4u*)(vg + (size_t)i * 8 * 2048);
    __syncthreads();
    {
        const bf16* qg = QT + ((size_t)b * T + t0 + (tid >> 5)) * 1024 + h * 256 + (tid & 31) * 8;
        v4u qr[8];
#pragma unroll
        for (int i = 0; i < 8; ++i) qr[i] = *(const v4u*)(qg + (size_t)i * 16 * 1024);
#pragma unroll
        for (int i = 0; i < 8; ++i) *(LAS v4u*)(Qs + ((tid >> 5) + 16 * i) * AP_STR + (tid & 31) * 16) = qr[i];
    }
    const LAS char* qb = Qs + (32 * ig + l31) * AP_STR + 16 * hl;
    const LAS char* ka = Ks + l31 * AP_STR + 16 * hl;
    const LAS char* vb = Vs + (4 * hl + q) * AP_VSTR + 2 * (256 * dh + 16 * blk + 4 * p);
#pragma unroll 1
    for (int tl = 0; tl < ntile; ++tl) {
        __syncthreads();
#pragma unroll
        for (int i = 0; i < 2; ++i) *(LAS v4u*)(kl + i * 16 * AP_STR) = kr[i];
#pragma unroll
        for (int i = 0; i < 4; ++i) *(LAS v4u*)(vl + i * 8 * AP_VSTR) = vr[i];
        if (tl + 1 < ntile) {
#pragma unroll
            for (int i = 0; i < 2; ++i) kr[i] = *(const v4u*)(kg + (size_t)(tl + 1) * 32 * 1024 + (size_t)i * 16 * 1024);
#pragma unroll
            for (int i = 0; i < 4; ++i) vr[i] = *(const v4u*)(vg + (size_t)(tl + 1) * 32 * 2048 + (size_t)i * 8 * 2048);
        }
        __syncthreads();
        const int kt = tl - dtile0;
        if (kt > ig) continue;
        f32x16 X;
#pragma unroll
        for (int i = 0; i < 16; ++i) X[i] = 0.f;
#pragma unroll
        for (int ks = 0; ks < 16; ++ks) {
            const bf16x8 A = *(const LAS bf16x8*)(ka + 32 * ks);
            const bf16x8 B = *(const LAS bf16x8*)(qb + 32 * ks);
            X = MFMA32(A, B, X);
        }
        if (kt == ig) {
#pragma unroll
            for (int i = 0; i < 16; ++i) if (crow(i, hl) > l31) X[i] = 0.f;
        }
        v4u p0, p1;
        p0.x = pk2(X[0], X[1]); p0.y = pk2(X[2], X[3]); p0.z = pk2(X[4], X[5]); p0.w = pk2(X[6], X[7]);
        p1.x = pk2(X[8], X[9]); p1.y = pk2(X[10], X[11]); p1.z = pk2(X[12], X[13]); p1.w = pk2(X[14], X[15]);
        const bf16x8 P0 = __builtin_bit_cast(bf16x8, p0), P1 = __builtin_bit_cast(bf16x8, p1);
#pragma unroll
        for (int mt = 0; mt < 8; ++mt) {
            const bf16x8 A0 = trpair(vb + 64 * mt, 8 * AP_VSTR);
            const bf16x8 A1 = trpair(vb + 64 * mt + 16 * AP_VSTR, 8 * AP_VSTR);
            acc[mt] = MFMA32(A0, P0, acc[mt]);
            acc[mt] = MFMA32(A1, P1, acc[mt]);
        }
    }
    {
        const bf16* sg = ST + (size_t)(bh * 8 + s) * 512 * 256;
        const int srow = tid >> 5, sc = tid & 31;
        v4u sr[4];
#pragma unroll
        for (int i = 0; i < 4; ++i) { const int rho = srow + 16 * i; sr[i] = *(const v4u*)(sg + ((size_t)(256 * (rho >> 5) + (rho & 31))) * 256 + sc * 8); }
        const LAS char* sa = Ss + (32 * dh + l31) * AP_STR + 16 * hl;
#pragma unroll
        for (int mt = 0; mt < 8; ++mt) {
            __syncthreads();
#pragma unroll
            for (int i = 0; i < 4; ++i) *(LAS v4u*)(Ss + (srow + 16 * i) * AP_STR + sc * 16) = sr[i];
            if (mt + 1 < 8) {
#pragma unroll
                for (int i = 0; i < 4; ++i) { const int rho = srow + 16 * i; sr[i] = *(const v4u*)(sg + ((size_t)(256 * (rho >> 5) + 32 * (mt + 1) + (rho & 31))) * 256 + sc * 8); }
            }
            __syncthreads();
#pragma unroll
            for (int ks = 0; ks < 16; ++ks) {
                const bf16x8 A = *(const LAS bf16x8*)(sa + 32 * ks);
                const bf16x8 B = *(const LAS bf16x8*)(qb + 32 * ks);
                acc[mt] = MFMA32(A, B, acc[mt]);
            }
        }
    }
    float ss = 0.f;
#pragma unroll
    for (int mt = 0; mt < 8; ++mt)
#pragma unroll
        for (int i = 0; i < 16; ++i) ss += acc[mt][i] * acc[mt][i];
    ss += __shfl_xor(ss, 32);
    __syncthreads();
    if (hl == 0) red[dh * 128 + 32 * ig + l31] = ss;
    LAS char* Tw = Qs + w * (32 * AP_STR);
#pragma unroll
    for (int mt = 0; mt < 8; ++mt)
#pragma unroll
        for (int g = 0; g < 4; ++g) { v2u w2; w2.x = pk2(acc[mt][4 * g], acc[mt][4 * g + 1]); w2.y = pk2(acc[mt][4 * g + 2], acc[mt][4 * g + 3]);
            *(LAS v2u*)(Tw + l31 * AP_STR + (32 * mt + 8 * g + 4 * hl) * 2) = w2; }
    __syncthreads();
    bf16* og = O + ((size_t)b * T + t0 + 32 * ig) * 2048 + h * 512 + 256 * dh;
#pragma unroll
    for (int i = 0; i < 16; ++i) { const int id = lane + 64 * i, row = id >> 5, c = id & 31;
        const v4u x = *(const LAS v4u*)(Tw + row * AP_STR + c * 16); *(v4u*)(og + (size_t)row * 2048 + c * 8) = x; }
    if (tid < 128) ssq[((size_t)b * T + t0 + tid) * 4 + h] = red[tid] + red[128 + tid];
}
struct Args { const float* in[9]; float* out; unsigned char* ws; int ph_lo, ph_hi, li, pad; };
__global__ void __launch_bounds__(NWAVES * 64, 2) fwd_kernel(Args args) {
    extern __shared__ __attribute__((aligned(16))) unsigned char lds[];
    Frame F;
    F.lds = (LAS unsigned char*)lds; F.MISC = (volatile LAS unsigned*)(F.lds + MISC_OFF);
    F.tid = threadIdx.x; F.lane = F.tid & 63; F.wave = __builtin_amdgcn_readfirstlane(F.tid >> 6);
    F.G = gridDim.x; { const int bx = blockIdx.x; F.vcu = (F.G % 8 == 0) ? (bx % 8) * (F.G / 8) + bx / 8 : bx; }
    F.ws = args.ws; F.ctl = (gu32*)(args.ws + WS_CTL); F.out = args.out;
#pragma unroll
    for (int i = 0; i < 9; ++i) F.in[i] = args.in[i];
    for (int u = F.tid; u < (LDS_BYTES - LDSCTL_OFF) / 4; u += NWAVES * 64) ((LAS unsigned*)(F.lds + LDSCTL_OFF))[u] = 0u;
    __syncthreads();
    XcdBarrier bar; bar.bar = (unsigned*)(F.ctl + CW_BAR); bar.x = 0; bar.st = nullptr;
    if (N_LAUNCHES == 1) bar = xcd_barrier_post((unsigned*)(F.ctl + CW_BAR), F.MISC + 8);
    const int lo = args.ph_lo, hi = args.ph_hi;
#define IN(k) (lo <= (k) && (k) < hi)
#define SEAM(k) do { if (IN(k) && IN((k) + 1)) xcd_barrier(bar); } while (0)
#ifndef REP_PH
#define REP_PH -1
#endif
#define REPEAT(k) for (int rep = 0, nrep = (l == 0 && REP_PH == (k)) ? 2 : 1; rep < nrep; ++rep)
#define REPBAR() do { if (rep) xcd_barrier(bar); } while (0)
#define PHASE_PTRS() unsigned long long z0_ = 0ull; asm volatile("" : "+s"(z0_)); unsigned char* ws = args.ws + z0_; \
    Frame P = F; { int t_ = threadIdx.x; asm volatile("" : "+v"(t_)); P.tid = t_; P.lane = t_ & 63; P.wave = __builtin_amdgcn_readfirstlane(t_ >> 6); } \
    float* cosT = (float*)(ws + WS_COS); float* sinT = (float*)(ws + WS_SIN); float* rstd = (float*)(ws + WS_RSTD); float* ssq = (float*)(ws + WS_SSQ); \
    bf16* XB = (bf16*)(ws + WS_XB); bf16* U = (bf16*)(ws + WS_U); bf16* BZ = (bf16*)(ws + WS_BZ); bf16* QT = (bf16*)(ws + WS_QT); bf16* KT = (bf16*)(ws + WS_KT); \
    bf16* V = (bf16*)(ws + WS_V); bf16* O = (bf16*)(ws + WS_O); bf16* SG = (bf16*)(ws + WS_SG); float* YAG = (float*)(ws + WS_YAG); bf16* MG = (bf16*)(ws + WS_MG); \
    unsigned char* RW = ws + ((l & 1) ? WS_R2 : WS_R1); unsigned char* RS = ws + ((l & 1) ? WS_R1 : WS_R2); bf16* ST = (bf16*)RS; \
    (void)cosT; (void)sinT; (void)rstd; (void)ssq; (void)XB; (void)U; (void)BZ; (void)QT; (void)KT; (void)V; (void)O; (void)SG; (void)YAG; (void)MG; (void)RW; (void)RS; (void)ST

    if (IN(0)) {
        const int l = 0; PHASE_PTRS();
        convert_layer(P, 0, ws + WS_R1);
        rotary_tables(P, cosT, sinT);
        rownorm(P, args.in[0], XB, rstd);
    }
    SEAM(0);
#pragma unroll 1
    for (int l = 0; l < DEPTH; ++l) {
        const int pb = 1 + 7 * l;
        if (IN(pb + 0)) REPEAT(0) {
            REPBAR(); PHASE_PTRS();
            pg8::Gemm g{XB, (const bf16*)(RW + RW_IN), M, NA, D}; pg8::StaticOrder S; S.init(M, NA, F.G, (int)blockIdx.x);
            EpiA E{rstd, cosT, sinT, U, BZ, QT, KT, V};
            pg8::gemm_phase<EpiA, pg8::StaticOrder, true, true>(F.lds, g, S, E);
        }
        SEAM(pb + 0);
        if (IN(pb + 1)) REPEAT(1) {
            REPBAR(); PHASE_PTRS();
            const float* cw = args.in[3] + (size_t)l * 3 * D; const float* cb = args.in[4] + (size_t)l * D;
            if (F.G == 256 && nrep == 1) chain_item<true>(P, F.vcu >> 4, F.vcu & 15, KT, V, ST, U, BZ, cw, cb);
            else { for (int it = F.vcu; it < 256; it += F.G) chain_item<false>(P, it >> 4, it & 15, KT, V, ST, U, BZ, cw, cb);
                   if (rep == nrep - 1) conv_pass(P, U, BZ, cw, cb); }
        }
        SEAM(pb + 1);
        if (IN(pb + 2)) REPEAT(2) {
            REPBAR(); PHASE_PTRS();
            for (int pr = F.vcu; pr < 256; pr += F.G) {
                const int bh = pr >> 4, pi = pr & 15, s = pi >> 1;
                const int ra = (pi & 1) ? 4 * s + 1 : 4 * s + 0, rb = (pi & 1) ? 4 * s + 2 : 4 * s + 3;
#pragma unroll 1
                for (int k = 0; k < 2; ++k) apply_item(P, bh, k == 0 ? rb : ra, QT, KT, V, ST, O, ssq);
            }
        }
        SEAM(pb + 2);
        if (IN(pb + 3)) {
            PHASE_PTRS();
            if (l + 1 < DEPTH) { convert_layer(P, l + 1, RS); __syncthreads(); }
            pg8::Gemm g{XB, (const bf16*)(RW + RW_IN) + (size_t)NA * D, M, NB, D}; pg8::StaticOrder S; S.init(M, NB, F.G, (int)blockIdx.x);
            EpiB E{rstd, ssq, O, SG};
            pg8::gemm_phase<EpiB, pg8::StaticOrder, true, true>(F.lds, g, S, E);
        }
        SEAM(pb + 3);
        if (IN(pb + 4)) REPEAT(4) {
            REPBAR(); PHASE_PTRS();
            { pg8::Gemm g{BZ, (const bf16*)(RW + RW_A), M, D, D}; pg8::StaticOrder S; S.init(M, D, F.G, (int)blockIdx.x);
              EpiYA E{SG, YAG}; pg8::gemm_phase<EpiYA, pg8::StaticOrder, false, true>(F.lds, g, S, E); }
            asm volatile("s_waitcnt vmcnt(0)" ::: "memory"); __syncthreads();
            { pg8::Gemm g{O, (const bf16*)(RW + RW_B), M, D, 2 * D}; pg8::StaticOrder S; S.init(M, D, F.G, (int)blockIdx.x);
              EpiMG E{SG, YAG, MG}; pg8::gemm_phase<EpiMG, pg8::StaticOrder, false, true>(F.lds, g, S, E); }
        }
        SEAM(pb + 4);
        if (IN(pb + 5)) REPEAT(5) {
            REPBAR(); PHASE_PTRS();
            pg8::Gemm g{MG, (const bf16*)(RW + RW_O), M, D, D}; pg8::StaticOrder S; S.init(M, D, F.G, (int)blockIdx.x);
            EpiRes E{(l == 0) ? args.in[0] : (const float*)args.out, args.out}; pg8::gemm_phase<EpiRes, pg8::StaticOrder, false, true>(F.lds, g, S, E);
        }
        SEAM(pb + 5);
        if (IN(pb + 6)) REPEAT(6) {
            REPBAR(); PHASE_PTRS();
            if (l + 1 < DEPTH) rownorm(P, args.out, XB, rstd);
            else final_norm(P, args.out, args.in[8]);
        }
        if (l + 1 < DEPTH) SEAM(pb + 6);
    }
#undef IN
#undef SEAM
}

extern "C" void kernel_launch(void* const* d_in, const int* in_sizes, int n_in, void* d_out, int out_size, void* d_ws, size_t ws_size, hipStream_t stream) {
    static int grid = 0;
    if (grid == 0) {
        if (n_in != 9 || in_sizes[0] != M * D || out_size != M * D || ws_size < WS_END) {
            fprintf(stderr, "kernel_launch: unexpected problem (n_in %d, in0 %d, out %d, ws %zu; need ws >= %zu); nothing launched\n", n_in, n_in > 0 ? in_sizes[0] : -1, out_size, ws_size, (size_t)WS_END); grid = -1; return; }
        int dev = 0, cus = 0, per_cu = 0;
        if (hipGetDevice(&dev) != hipSuccess || hipDeviceGetAttribute(&cus, hipDeviceAttributeMultiprocessorCount, dev) != hipSuccess) { grid = -1; return; }
        if (hipFuncSetAttribute((const void*)fwd_kernel, hipFuncAttributeMaxDynamicSharedMemorySize, LDS_BYTES) != hipSuccess) { fprintf(stderr, "kernel_launch: hipFuncSetAttribute failed\n"); grid = -1; return; }
        if (hipOccupancyMaxActiveBlocksPerMultiprocessor(&per_cu, (const void*)fwd_kernel, NWAVES * 64, LDS_BYTES) != hipSuccess || per_cu < 1) { fprintf(stderr, "kernel_launch: occupancy query says %d blocks per CU; nothing launched\n", per_cu); (void)hipGetLastError(); grid = -1; return; }
        grid = cus;
    }
    if (grid < 0) return;
    if (hipMemsetAsync((char*)d_ws + WS_CTL, 0, CTL_ZERO_BYTES, stream) != hipSuccess) return;
    Args a{};
    for (int i = 0; i < 9; ++i) a.in[i] = (const float*)d_in[i];
    a.out = (float*)d_out; a.ws = (unsigned char*)d_ws;
    if (N_LAUNCHES == 1) {
        a.ph_lo = 0; a.ph_hi = NPHASES; a.li = 0;
        hipLaunchKernelGGL(fwd_kernel, dim3(grid), dim3(NWAVES * 64), LDS_BYTES, stream, a);
    } else {
        for (int li = 0; li < NPHASES; ++li) { a.ph_lo = li; a.ph_hi = li + 1; a.li = li; hipLaunchKernelGGL(fwd_kernel, dim3(grid), dim3(NWAVES * 64), LDS_BYTES, stream, a); }
    }
}
```

```cpp
#include <hip/hip_runtime.h>
#include <cstdio>
#include <cstdint>
namespace pg8 {
#define PG8_LAS __attribute__((address_space(3)))
typedef unsigned short bf16_t;
typedef short bf16x8 __attribute__((ext_vector_type(8)));
typedef float f32x4 __attribute__((ext_vector_type(4)));
typedef unsigned u32x4 __attribute__((ext_vector_type(4)));
constexpr int BM = 256, BK = 64, HALF = 128, HTB = HALF * BK * 2  , STAGE_BYTES = 8 * HTB, NXCD = 8, WGM = 8;

__host__ __device__ __forceinline__ int lds_byte(int r, int c) { const int st = (r >> 4) * 2 + (c >> 5), rr = r & 15, cc = c & 31, ob = rr * 64 + cc * 2; return st * 1024 + (ob ^ (((ob >> 9) & 1) << 5)); }
__host__ __device__ __forceinline__ void stage_rc(int b, int& R, int& C) { const int st = b / 1024, sb = b % 1024, swz = sb ^ (((sb >> 9) & 1) << 5); R = (st >> 1) * 16 + swz / 64; C = (st & 1) * 32 + (swz % 64) / 2; }
__host__ __device__ __forceinline__ int perm32(int rho) { const int n = rho >> 4, i = rho & 15; return 8 * (i >> 2) + 4 * n + (i & 3); }

struct Unit { int pm, pn; };
struct Gemm { const bf16_t* A; const bf16_t* Bt; int M, N, K; };

struct StaticOrder {
    int nM, nN, nwg, G, c;
    __host__ __device__ void init(int M, int N, int G_, int c_) { nM = M / BM; nN = N / BM; nwg = nM * nN; G = G_; c = c_; }
    __host__ __device__ bool next(int i, Unit& u) const {
        const long L = (long)i * G + c; if (L >= nwg) return false;
        int wgid = (int)L; { const int q = nwg / NXCD, r = nwg % NXCD, xcd = wgid % NXCD, off = wgid / NXCD; wgid = (xcd < r ? xcd * (q + 1) : r * (q + 1) + (xcd - r) * q) + off; }
        const int nig = WGM * nN, gid = wgid / nig, fm = gid * WGM, gsz = (nM - fm) < WGM ? (nM - fm) : WGM;
        u.pm = fm + ((wgid % nig) % gsz); u.pn = (wgid % nig) / gsz; return true;
    }
    __device__ __forceinline__ void a_ready(const Unit&) const {}
    __device__ __forceinline__ void done(const Unit&) const {}
};
__device__ __forceinline__ unsigned cvt_pk_bf16(float lo, float hi) { unsigned r; asm volatile("v_cvt_pk_bf16_f32 %0, %1, %2" : "=v"(r) : "v"(lo), "v"(hi)); return r; }
template <class Epi, class Sched, bool ALIGN_EPI = false, bool SP2 = false>
__device__ __forceinline__ void gemm_phase(PG8_LAS unsigned char* lds, const Gemm g, const Sched& S, const Epi& E) {
    int tid_ = threadIdx.x; asm volatile("" : "+v"(tid_));
    const int tid = tid_, wid = __builtin_amdgcn_readfirstlane(tid >> 6), lane = tid & 63, wr = wid >> 2, wc = wid & 3, fr = lane & 15, fq = lane >> 4;
    const int K = g.K, nt = K / BK;
    unsigned voffA[2], voffB[2];
#pragma unroll
    for (int i = 0; i < 2; ++i) { int R, C; stage_rc(tid * 16 + i * 8192, R, C); const int Rb = Epi::PERM ? ((R & ~31) + perm32(R & 31)) : R;
        voffA[i] = (unsigned)(R * K + C) * 2u; voffB[i] = (unsigned)(Rb * K + C) * 2u; }
    const size_t kstep = (size_t)(BK * 2);
    const size_t hstep = (size_t)HALF * K * 2;
    const size_t tstep = 2 * hstep;
    const unsigned ldsw = (unsigned)wid * 1024u;
    const int aoff = lds_byte(wr * 64 + fr, fq * 8), boff = lds_byte(wc * 32 + fr, fq * 8);
#define PG8_SA(b, h) (((b) * 2 + (h)) * HTB)
#define PG8_SB(b, h) ((4 + (b) * 2 + (h)) * HTB)
#define PG8_STAGE(bufoff, gbase, voff) do { _Pragma("unroll") for (int _i = 0; _i < 2; ++_i) \
        __builtin_amdgcn_global_load_lds((const unsigned*)((const char*)(gbase) + (voff)[_i]), (PG8_LAS unsigned*)(lds + (bufoff) + ldsw + _i * 8192), 16, 0, 0); } while (0)
#define PG8_LDA(dst, b, h) do { _Pragma("unroll") for (int m = 0; m < 4; ++m) _Pragma("unroll") for (int k = 0; k < 2; ++k) dst[m][k] = *(const PG8_LAS bf16x8*)(lds + PG8_SA(b, h) + aoff + m * 2048 + k * 1024); } while (0)
#define PG8_LDB(dst, b, h) do { _Pragma("unroll") for (int n = 0; n < 2; ++n) _Pragma("unroll") for (int k = 0; k < 2; ++k) dst[n][k] = *(const PG8_LAS bf16x8*)(lds + PG8_SB(b, h) + boff + n * 2048 + k * 1024); } while (0)
#define PG8_MMA(ai, bj, At, Bt) do { __builtin_amdgcn_s_setprio(1); _Pragma("unroll") for (int m = 0; m < 4; ++m) _Pragma("unroll") for (int n = 0; n < 2; ++n) _Pragma("unroll") for (int k = 0; k < 2; ++k) \
        acc[ai][bj][m][n] = __builtin_amdgcn_mfma_f32_16x16x32_bf16(Bt[n][k], At[m][k], acc[ai][bj][m][n], 0, 0, 0); __builtin_amdgcn_s_setprio(0); } while (0)
#define PG8_WAIT_V(n) asm volatile("s_waitcnt vmcnt(" #n ")" ::: "memory")
#define PG8_WAIT_L(n) asm volatile("s_waitcnt lgkmcnt(" #n ")" ::: "memory")
#define PG8_BAR __builtin_amdgcn_s_barrier()
#define PG8_SCHED __builtin_amdgcn_sched_barrier(0)
    Unit cur, nxt; int ui = 0;
    if (!S.next(0, cur)) return;
    f32x4 acc[2][2][4][2];
#pragma unroll
    for (int a = 0; a < 2; ++a)
#pragma unroll
        for (int b = 0; b < 2; ++b)
#pragma unroll
            for (int m = 0; m < 4; ++m)
#pragma unroll
                for (int n = 0; n < 2; ++n) acc[a][b][m][n] = (f32x4){0.f, 0.f, 0.f, 0.f};
    bf16x8 At[4][2], B0[2][2], B1[2][2];
    const char* cA = (const char*)g.A + (size_t)cur.pm * tstep; const char* cB = (const char*)g.Bt + (size_t)cur.pn * tstep;
    S.a_ready(cur);
    if constexpr (SP2) {
        PG8_STAGE(PG8_SB(0, 0), cB, voffB); PG8_STAGE(PG8_SB(0, 1), cB + hstep, voffB); PG8_STAGE(PG8_SA(0, 0), cA, voffA); PG8_STAGE(PG8_SA(0, 1), cA + hstep, voffA);
        if (wr == 1) PG8_BAR;
        PG8_WAIT_V(2); PG8_BAR;
        PG8_STAGE(PG8_SB(1, 0), cB + kstep, voffB); PG8_STAGE(PG8_SA(1, 0), cA + kstep, voffA); PG8_STAGE(PG8_SB(1, 1), cB + hstep + kstep, voffB);
        PG8_WAIT_V(6); PG8_BAR;
    } else {
        PG8_STAGE(PG8_SB(0, 0), cB, voffB); PG8_STAGE(PG8_SA(0, 0), cA, voffA); PG8_STAGE(PG8_SB(0, 1), cB + hstep, voffB); PG8_STAGE(PG8_SA(0, 1), cA + hstep, voffA);
        if (wr == 1) PG8_BAR;
        PG8_WAIT_V(4); PG8_BAR;
        PG8_STAGE(PG8_SB(1, 0), cB + kstep, voffB); PG8_STAGE(PG8_SA(1, 0), cA + kstep, voffA); PG8_STAGE(PG8_SB(1, 1), cB + hstep + kstep, voffB);
        PG8_WAIT_V(6); PG8_BAR;
    }
    for (;;) {
        const bool has_next = S.next(ui + 1, nxt);
        const char* nA = has_next ? (const char*)g.A + (size_t)nxt.pm * tstep : cA; const char* nB = has_next ? (const char*)g.Bt + (size_t)nxt.pn * tstep : cB;
        for (int t = 0; t < nt; t += 2) {
            const bool last = (t == nt - 2);
            const char* a1 = cA + (size_t)(t + 1) * kstep;
            const char* a2 = last ? nA : cA + (size_t)(t + 2) * kstep; const char* b2 = last ? nB : cB + (size_t)(t + 2) * kstep;
            const char* a3 = a2 + kstep; const char* b3 = b2 + kstep;
            if (last && has_next) S.a_ready(nxt);
            if constexpr (SP2) {
            PG8_LDB(B0, 0, 0); PG8_LDB(B1, 0, 1); PG8_SCHED; PG8_LDA(At, 0, 0); PG8_STAGE(PG8_SA(1, 1), a1 + hstep, voffA);
            PG8_WAIT_V(8); PG8_WAIT_L(0); PG8_BAR; PG8_MMA(0, 0, At, B0); PG8_MMA(0, 1, At, B1); PG8_BAR; PG8_SCHED;
            PG8_LDA(At, 0, 1); PG8_STAGE(PG8_SB(0, 0), b2, voffB); PG8_STAGE(PG8_SB(0, 1), b2 + hstep, voffB); PG8_STAGE(PG8_SA(0, 0), a2, voffA);
            PG8_WAIT_V(8); PG8_WAIT_L(0); PG8_BAR; PG8_MMA(1, 0, At, B0); PG8_MMA(1, 1, At, B1); PG8_BAR; PG8_SCHED;
            PG8_LDB(B0, 1, 0); PG8_LDB(B1, 1, 1); PG8_SCHED; PG8_LDA(At, 1, 0); PG8_STAGE(PG8_SA(0, 1), a2 + hstep, voffA);
            PG8_WAIT_V(8); PG8_WAIT_L(0); PG8_BAR; PG8_MMA(0, 0, At, B0); PG8_MMA(0, 1, At, B1); PG8_BAR; PG8_SCHED;
            PG8_LDA(At, 1, 1); PG8_STAGE(PG8_SB(1, 0), b3, voffB); PG8_STAGE(PG8_SB(1, 1), b3 + hstep, voffB); PG8_STAGE(PG8_SA(1, 0), a3, voffA);
            PG8_WAIT_V(8); PG8_WAIT_L(0); PG8_BAR; PG8_MMA(1, 0, At, B0); PG8_MMA(1, 1, At, B1); PG8_BAR; PG8_SCHED;
            } else {
            PG8_LDB(B0, 0, 0); PG8_SCHED; PG8_LDA(At, 0, 0); PG8_STAGE(PG8_SA(1, 1), a1 + hstep, voffA);
            PG8_WAIT_L(8); PG8_BAR; PG8_WAIT_L(0); PG8_MMA(0, 0, At, B0); PG8_BAR; PG8_SCHED;
            PG8_LDB(B1, 0, 1); PG8_STAGE(PG8_SB(0, 0), b2, voffB);
            PG8_BAR; PG8_WAIT_L(0); PG8_MMA(0, 1, At, B1); PG8_BAR;
            PG8_LDA(At, 0, 1); PG8_STAGE(PG8_SA(0, 0), a2, voffA);
            PG8_BAR; PG8_WAIT_L(0); PG8_MMA(1, 0, At, B0); PG8_BAR; PG8_SCHED;
            PG8_STAGE(PG8_SB(0, 1), b2 + hstep, voffB);
            PG8_WAIT_V(6); PG8_BAR; PG8_MMA(1, 1, At, B1); PG8_BAR;
            PG8_LDB(B0, 1, 0); PG8_SCHED; PG8_LDA(At, 1, 0); PG8_STAGE(PG8_SA(0, 1), a2 + hstep, voffA);
            PG8_WAIT_L(8); PG8_BAR; PG8_WAIT_L(0); PG8_MMA(0, 0, At, B0); PG8_BAR; PG8_SCHED;
            PG8_LDB(B1, 1, 1); PG8_STAGE(PG8_SB(1, 0), b3, voffB);
            PG8_BAR; PG8_WAIT_L(0); PG8_MMA(0, 1, At, B1); PG8_BAR;
            PG8_LDA(At, 1, 1); PG8_STAGE(PG8_SA(1, 0), a3, voffA);
            PG8_BAR; PG8_WAIT_L(0); PG8_MMA(1, 0, At, B0); PG8_BAR; PG8_SCHED;
            PG8_STAGE(PG8_SB(1, 1), b3 + hstep, voffB);
            PG8_WAIT_V(6); PG8_BAR; PG8_MMA(1, 1, At, B1); PG8_BAR;
            }
        }
        if constexpr (ALIGN_EPI) { if (wr == 0) PG8_BAR; }
        if constexpr (!Epi::AFTER_DRAIN) { E(acc, cur, wr, wc, fr, fq); S.done(cur); }
        if (!has_next) break;
#pragma unroll
        for (int a = 0; a < 2; ++a)
#pragma unroll
            for (int b = 0; b < 2; ++b)
#pragma unroll
                for (int m = 0; m < 4; ++m)
#pragma unroll
                    for (int n = 0; n < 2; ++n) acc[a][b][m][n] = (f32x4){0.f, 0.f, 0.f, 0.f};
        cur = nxt; cA = nA; cB = nB; ++ui;
        if constexpr (ALIGN_EPI) { if (wr == 1) PG8_BAR; }
    }
    PG8_WAIT_V(0);
    if constexpr (!ALIGN_EPI) { if (wr == 0) PG8_BAR; }
    PG8_BAR;
    if constexpr (Epi::AFTER_DRAIN) { E.fused(acc, cur, wr, wc, fr, fq, lds, wid, lane); S.done(cur); }
#undef PG8_SA
#undef PG8_SB
#undef PG8_STAGE
#undef PG8_LDA
#undef PG8_LDB
#undef PG8_MMA
#undef PG8_WAIT_V
#undef PG8_WAIT_L
#undef PG8_BAR
#undef PG8_SCHED
}
}

constexpr int BATCH = 4, T = 4096, D = 1024, M = BATCH * T, DIN = 12288, DEPTH = 2, NWAVES = 8;
constexpr int NA = 8192, NB = 4096;
constexpr float EPS = 1e-6f;
#ifndef N_LAUNCHES
#define N_LAUNCHES 1
#endif
constexpr int NPHASES = 1 + 7 * DEPTH;

constexpr size_t MiB = 1u << 20;
constexpr size_t WS_CTL = 0, CTL_ZERO_BYTES = 1 * MiB;
constexpr size_t WS_R1 = 1 * MiB, WS_R2 = 326 * MiB;
constexpr size_t RW_IN = 0, RW_A = 24 * MiB, RW_B = 26 * MiB, RW_O = 30 * MiB;
constexpr size_t WS_COS = 33 * MiB, WS_SIN = 35 * MiB;
constexpr size_t WS_RSTD = 37 * MiB, WS_SSQ = 37 * MiB + 65536;
constexpr size_t WS_XB = 38 * MiB;
constexpr size_t WS_U = 70 * MiB, WS_BZ = 102 * MiB;
constexpr size_t WS_QT = 134 * MiB, WS_KT = 166 * MiB;
constexpr size_t WS_V = 198 * MiB;
constexpr size_t WS_O = 262 * MiB;
constexpr size_t WS_SG = WS_QT;
constexpr size_t WS_YAG = WS_V;
constexpr size_t WS_MG = WS_U;
constexpr size_t WS_END = 358 * MiB;
constexpr int CW_BAR = 4096;

constexpr int RING_BYTES = 147456, LDSCTL_OFF = RING_BYTES, MISC_OFF = LDSCTL_OFF + 320, LDS_BYTES = RING_BYTES + 1024;

#define GAS __attribute__((address_space(1)))
#define LAS __attribute__((address_space(3)))
typedef unsigned short bf16;
typedef unsigned v4u __attribute__((ext_vector_type(4)));
typedef unsigned v2u __attribute__((ext_vector_type(2)));
typedef float f32x4 __attribute__((ext_vector_type(4)));
typedef float f32x16 __attribute__((ext_vector_type(16)));
typedef short bf16x8 __attribute__((ext_vector_type(8)));
typedef short s16x4 __attribute__((ext_vector_type(4)));
typedef float f32x2_t __attribute__((ext_vector_type(2)));
typedef __bf16 bf16x2_t __attribute__((ext_vector_type(2)));
typedef GAS unsigned gu32;
#define LDS_WAIT() asm volatile("s_waitcnt lgkmcnt(0)" ::: "memory")
#define MFMA32(a, b, c) __builtin_amdgcn_mfma_f32_32x32x16_bf16((a), (b), (c), 0, 0, 0)

__device__ __forceinline__ unsigned pk2(float lo, float hi) { f32x2_t v = {lo, hi}; bf16x2_t b = __builtin_convertvector(v, bf16x2_t); return __builtin_bit_cast(unsigned, b); }
__device__ __forceinline__ float bf_lo(unsigned u) { return __uint_as_float(u << 16); }
__device__ __forceinline__ float bf_hi(unsigned u) { return __uint_as_float(u & 0xffff0000u); }
__device__ __forceinline__ float sigm(float x) { return __builtin_amdgcn_rcpf(1.0f + __expf(-x)); }
__device__ __forceinline__ int crow(int r, int hi) { return (r & 3) + 8 * (r >> 2) + 4 * hi; }
__device__ __forceinline__ float log2_gamma(int h) { return h == 0 ? -0.04580368961312479f : h == 1 ? -0.02272007650008353f : h == 2 ? -0.011315313227834146f : -0.005646563141142063f; }
typedef short v4i16_t __attribute__((ext_vector_type(4)));
__device__ __forceinline__ s16x4 vtr(const LAS char* p) { return __builtin_bit_cast(s16x4, __builtin_amdgcn_ds_read_tr16_b64_v4i16((LAS v4i16_t*)p)); }
__device__ __forceinline__ bf16x8 trpair(const LAS char* p, int hi_off) { const s16x4 lo = vtr(p), hi = vtr(p + hi_off); return (bf16x8){lo[0], lo[1], lo[2], lo[3], hi[0], hi[1], hi[2], hi[3]}; }

using pg8::Unit;
struct EpiA {
    static constexpr bool PERM = false, AFTER_DRAIN = false;
    const float* rstd; const float* cosT; const float* sinT; bf16* U; bf16* BZ; bf16* QT; bf16* KT; bf16* V;
    __device__ __forceinline__ void operator()(const f32x4 (&acc)[2][2][4][2], const Unit& u, int wr, int wc, int fr, int fq) const {
        const int row0 = u.pm * 256 + wr * 64 + fr;
        if (u.pn < 16) {
            const int ch0 = u.pn * 64 + wc * 16 + fq * 4;
#pragma unroll
            for (int ai = 0; ai < 2; ++ai)
#pragma unroll
                for (int m = 0; m < 4; ++m) {
                    const int row = row0 + ai * 128 + m * 16; const float rs = rstd[row];
                    const f32x4 b = acc[ai][0][m][0] * rs, c = acc[ai][0][m][1] * rs, x = acc[ai][1][m][0] * rs, z = acc[ai][1][m][1] * rs;
                    const f32x4 uu = c * x; f32x4 bz;
#pragma unroll
                    for (int j = 0; j < 4; ++j) bz[j] = b[j] * z[j] * sigm(z[j]);
                    v2u w0, w1; w0.x = pk2(uu[0], uu[1]); w0.y = pk2(uu[2], uu[3]); w1.x = pk2(bz[0], bz[1]); w1.y = pk2(bz[2], bz[3]);
                    *(v2u*)(U + (size_t)row * 1024 + ch0) = w0; *(v2u*)(BZ + (size_t)row * 1024 + ch0) = w1;
                    asm volatile("" ::: "memory");
                }
        } else if (u.pn < 24) {
            const int hd = (u.pn - 16) & 3; const bool isk = u.pn >= 20; bf16* dst = isk ? KT : QT;
            const float lg = log2_gamma(hd); const int f0 = wc * 32 + fq * 8;
#pragma unroll
            for (int ai = 0; ai < 2; ++ai)
#pragma unroll
                for (int m = 0; m < 4; ++m) {
                    const int row = row0 + ai * 128 + m * 16; const int pos = row & (T - 1); const float p = (float)(pos & 511);
                    const float sc = rstd[row] * (isk ? exp2f(-p * lg) * 0.0625f : exp2f(p * lg));
                    const f32x4 c0 = *(const f32x4*)(cosT + (size_t)pos * 128 + f0), c1 = *(const f32x4*)(cosT + (size_t)pos * 128 + f0 + 4);
                    const f32x4 s0 = *(const f32x4*)(sinT + (size_t)pos * 128 + f0), s1 = *(const f32x4*)(sinT + (size_t)pos * 128 + f0 + 4);
                    const f32x4 t1a = acc[ai][0][m][0], t1b = acc[ai][0][m][1], t2a = acc[ai][1][m][0], t2b = acc[ai][1][m][1];
                    const f32x4 o1a = (t1a * c0 - t2a * s0) * sc, o1b = (t1b * c1 - t2b * s1) * sc, o2a = (t1a * s0 + t2a * c0) * sc, o2b = (t1b * s1 + t2b * c1) * sc;
                    v4u w1, w2; w1.x = pk2(o1a[0], o1a[1]); w1.y = pk2(o1a[2], o1a[3]); w1.z = pk2(o1b[0], o1b[1]); w1.w = pk2(o1b[2], o1b[3]);
                    w2.x = pk2(o2a[0], o2a[1]); w2.y = pk2(o2a[2], o2a[3]); w2.z = pk2(o2b[0], o2b[1]); w2.w = pk2(o2b[2], o2b[3]);
                    bf16* rp = dst + (size_t)row * 1024 + hd * 256 + f0;
                    *(v4u*)rp = w1; *(v4u*)(rp + 128) = w2;
                    asm volatile("" ::: "memory");
                }
        } else {
            const int col0 = (u.pn - 24) * 256 + wc * 32 + fq * 8;
#pragma unroll
            for (int ai = 0; ai < 2; ++ai)
#pragma unroll
                for (int m = 0; m < 4; ++m) {
                    const int row = row0 + ai * 128 + m * 16; const float rs = rstd[row];
#pragma unroll
                    for (int bj = 0; bj < 2; ++bj) { const f32x4 a = acc[ai][bj][m][0] * rs, b = acc[ai][bj][m][1] * rs;
                        v4u w; w.x = pk2(a[0], a[1]); w.y = pk2(a[2], a[3]); w.z = pk2(b[0], b[1]); w.w = pk2(b[2], b[3]);
                        *(v4u*)(V + (size_t)row * 2048 + col0 + bj * 128) = w; }
                    asm volatile("" ::: "memory");
                }
        }
    }
};
struct EpiB {
    static constexpr bool PERM = false, AFTER_DRAIN = false;
    const float* rstd; const float* ssq; const bf16* O; bf16* OB; bf16* SG;
    __device__ __forceinline__ void operator()(const f32x4 (&acc)[2][2][4][2], const Unit& u, int wr, int wc, int fr, int fq) const {
        const int row0 = u.pm * 256 + wr * 64 + fr;
        if (u.pn < 8) {
            const int hd = u.pn >> 1, col0 = u.pn * 256 + wc * 32 + fq * 8;
#pragma unroll
            for (int ai = 0; ai < 2; ++ai)
#pragma unroll
                for (int m = 0; m < 4; ++m) {
                    const int row = row0 + ai * 128 + m * 16; const float rs = rstd[row];
                    const float rg = rsqrtf(ssq[(size_t)row * 4 + hd] * (1.0f / 512.0f) + EPS);
#pragma unroll
                    for (int bj = 0; bj < 2; ++bj) {
                        const size_t oo = (size_t)row * 2048 + col0 + bj * 128; const v4u ov = *(const v4u*)(O + oo);
                        const f32x4 za = acc[ai][bj][m][0] * rs, zb = acc[ai][bj][m][1] * rs;
                        float r[8];
                        r[0] = bf_lo(ov.x) * rg * za[0] * sigm(za[0]); r[1] = bf_hi(ov.x) * rg * za[1] * sigm(za[1]);
                        r[2] = bf_lo(ov.y) * rg * za[2] * sigm(za[2]); r[3] = bf_hi(ov.y) * rg * za[3] * sigm(za[3]);
                        r[4] = bf_lo(ov.z) * rg * zb[0] * sigm(zb[0]); r[5] = bf_hi(ov.z) * rg * zb[1] * sigm(zb[1]);
                        r[6] = bf_lo(ov.w) * rg * zb[2] * sigm(zb[2]); r[7] = bf_hi(ov.w) * rg * zb[3] * sigm(zb[3]);
                        v4u w; w.x = pk2(r[0], r[1]); w.y = pk2(r[2], r[3]); w.z = pk2(r[4], r[5]); w.w = pk2(r[6], r[7]);
                        *(v4u*)(OB + oo) = w;
                    }
                    asm volatile("" ::: "memory");
                }
        } else {
            const int col0 = (u.pn - 8) * 256 + wc * 32 + fq * 8;
#pragma unroll
            for (int ai = 0; ai < 2; ++ai)
#pragma unroll
                for (int m = 0; m < 4; ++m) {
                    const int row = row0 + ai * 128 + m * 16; const float rs = rstd[row];
#pragma unroll
                    for (int bj = 0; bj < 2; ++bj) { const f32x4 a = acc[ai][bj][m][0] * rs, b = acc[ai][bj][m][1] * rs;
                        v4u w; w.x = pk2(sigm(a[0]), sigm(a[1])); w.y = pk2(sigm(a[2]), sigm(a[3])); w.z = pk2(sigm(b[0]), sigm(b[1])); w.w = pk2(sigm(b[2]), sigm(b[3]));
                        *(v4u*)(SG + (size_t)row * 2048 + col0 + bj * 128) = w; }
                    asm volatile("" ::: "memory");
                }
        }
    }
};
struct EpiYA {
    static constexpr bool PERM = false, AFTER_DRAIN = false;
    const bf16* SG; float* YAG;
    __device__ __forceinline__ void operator()(const f32x4 (&acc)[2][2][4][2], const Unit& u, int wr, int wc, int fr, int fq) const {
        const int row0 = u.pm * 256 + wr * 64 + fr, col0 = u.pn * 256 + wc * 32 + fq * 8;
#pragma unroll
        for (int ai = 0; ai < 2; ++ai)
#pragma unroll
            for (int m = 0; m < 4; ++m) { const int row = row0 + ai * 128 + m * 16;
#pragma unroll
                for (int bj = 0; bj < 2; ++bj) { const v4u g = *(const v4u*)(SG + (size_t)row * 2048 + col0 + bj * 128);
                    f32x4 a = acc[ai][bj][m][0], b = acc[ai][bj][m][1];
                    a[0] *= bf_lo(g.x); a[1] *= bf_hi(g.x); a[2] *= bf_lo(g.y); a[3] *= bf_hi(g.y); b[0] *= bf_lo(g.z); b[1] *= bf_hi(g.z); b[2] *= bf_lo(g.w); b[3] *= bf_hi(g.w);
                    float* yp = YAG + (size_t)row * 1024 + col0 + bj * 128; *(f32x4*)yp = a; *(f32x4*)(yp + 4) = b; } asm volatile("" ::: "memory"); }
    }
};
struct EpiMG {
    static constexpr bool PERM = false, AFTER_DRAIN = false;
    const bf16* SG; const float* YAG; bf16* MG;
    __device__ __forceinline__ void operator()(const f32x4 (&acc)[2][2][4][2], const Unit& u, int wr, int wc, int fr, int fq) const {
        const int row0 = u.pm * 256 + wr * 64 + fr, col0 = u.pn * 256 + wc * 32 + fq * 8;
#pragma unroll
        for (int ai = 0; ai < 2; ++ai)
#pragma unroll
            for (int m = 0; m < 4; ++m) { const int row = row0 + ai * 128 + m * 16;
#pragma unroll
                for (int bj = 0; bj < 2; ++bj) { const v4u g = *(const v4u*)(SG + (size_t)row * 2048 + 1024 + col0 + bj * 128);
                    const float* yp = YAG + (size_t)row * 1024 + col0 + bj * 128; f32x4 a = *(const f32x4*)yp, b = *(const f32x4*)(yp + 4);
                    const f32x4 ca = acc[ai][bj][m][0], cb = acc[ai][bj][m][1];
                    a[0] += ca[0] * bf_lo(g.x); a[1] += ca[1] * bf_hi(g.x); a[2] += ca[2] * bf_lo(g.y); a[3] += ca[3] * bf_hi(g.y);
                    b[0] += cb[0] * bf_lo(g.z); b[1] += cb[1] * bf_hi(g.z); b[2] += cb[2] * bf_lo(g.w); b[3] += cb[3] * bf_hi(g.w);
                    v4u w; w.x = pk2(a[0], a[1]); w.y = pk2(a[2], a[3]); w.z = pk2(b[0], b[1]); w.w = pk2(b[2], b[3]);
                    *(v4u*)(MG + (size_t)row * 1024 + col0 + bj * 128) = w; } asm volatile("" ::: "memory"); }
    }
};
struct EpiRes {
    static constexpr bool PERM = false, AFTER_DRAIN = false;
    const float* xres; float* xout;
    __device__ __forceinline__ void operator()(const f32x4 (&acc)[2][2][4][2], const Unit& u, int wr, int wc, int fr, int fq) const {
        const int row0 = u.pm * 256 + wr * 64 + fr, col0 = u.pn * 256 + wc * 32 + fq * 4;
#pragma unroll
        for (int ai = 0; ai < 2; ++ai)
#pragma unroll
            for (int m = 0; m < 4; ++m) { const size_t off = (size_t)(row0 + ai * 128 + m * 16) * 1024 + col0;
#pragma unroll
                for (int bj = 0; bj < 2; ++bj)
#pragma unroll
                    for (int n = 0; n < 2; ++n) { const f32x4 r = *(const f32x4*)(xres + off + bj * 128 + n * 16); *(f32x4*)(xout + off + bj * 128 + n * 16) = r + acc[ai][bj][m][n]; } asm volatile("" ::: "memory"); }
    }
};
#define XB_TMO      128
#define XB_XCNT(j)  (256  + 64 * (j))
#define XB_XSUB(j)  (1280 + 64 * (j))
#define XB_XGEN(j)  (2304 + 64 * (j))
#define XB_TOP      3328
#define XB_TOPGEN   3392
#define XCD_BAR_WORDS 3456
#define XB_SPIN_CAP (1u << 18)

__device__ __forceinline__ unsigned xb_ld(unsigned* p)              { return __hip_atomic_load(p, __ATOMIC_RELAXED, __HIP_MEMORY_SCOPE_AGENT); }
__device__ __forceinline__ unsigned xb_add(unsigned* p, unsigned v) { return __hip_atomic_fetch_add(p, v, __ATOMIC_RELAXED, __HIP_MEMORY_SCOPE_AGENT); }
__device__ __forceinline__ unsigned xb_xcc_id() { return (unsigned)__builtin_amdgcn_s_getreg((3 << 11) | 20) & 0xFu; }
#define XB_SPIN(cond, bar) do { unsigned _sp = 0; while (cond) { __builtin_amdgcn_s_sleep(1); \
    if ((++_sp & 255u) == 0u) { if (xb_ld(&(bar)[XB_TMO])) break; if (_sp > XB_SPIN_CAP) { atomicAdd(&(bar)[XB_TMO], 1u); break; } } } } while (0)

struct XcdBarrier {
    unsigned* bar; unsigned x;
    volatile LAS unsigned* st;
};

__device__ __forceinline__ XcdBarrier xcd_barrier_post(unsigned* bar, volatile LAS unsigned* st) {
    XcdBarrier b; b.bar = bar; b.x = xb_xcc_id(); b.st = st;
    if (threadIdx.x == 0) (void)xb_add(&bar[XB_XCNT(b.x)], 1u);
    return b;
}
__device__ __forceinline__ void xcd_barrier_complete(unsigned* bar, unsigned x, unsigned& nloc, unsigned& nx) {
    const unsigned G = gridDim.x * gridDim.y * gridDim.z;
    unsigned sum, cnt, mine, sp = 0u;
    for (;;) {
        sum = 0u; cnt = 0u; mine = 0u;
#pragma unroll
        for (unsigned j = 0; j < 16; ++j) { const unsigned c = xb_ld(&bar[XB_XCNT(j)]); sum += c; cnt += (c > 0u) ? 1u : 0u; mine = (j == x) ? c : mine; }
        if (sum == G) break;
        __builtin_amdgcn_s_sleep(1);
        if ((++sp & 255u) == 0u) { if (xb_ld(&bar[XB_TMO])) break; if (sp > XB_SPIN_CAP) { atomicAdd(&bar[XB_TMO], 1u); break; } }
    }
    nloc = mine > 0u ? mine : 1u; nx = cnt > 0u ? cnt : 1u;
}

__device__ __forceinline__ void xcd_barrier(const XcdBarrier& b) {
    asm volatile("s_waitcnt vmcnt(0)" ::: "memory");
    __syncthreads();
    if (threadIdx.x == 0) {
        unsigned* bar = b.bar;
        __builtin_amdgcn_s_waitcnt(0);
        unsigned nloc = b.st[0], nx = b.st[1];
        if (nloc == 0u) { xcd_barrier_complete(bar, b.x, nloc, nx); b.st[0] = nloc; b.st[1] = nx; }
        const unsigned old = xb_add(&bar[XB_XSUB(b.x)], 1u);
        const unsigned gen = old / nloc;
        if (old + 1u == (gen + 1u) * nloc) {
            __builtin_amdgcn_fence(__ATOMIC_RELEASE, "agent");
            asm volatile("s_waitcnt vmcnt(0)" ::: "memory");
            const unsigned og = xb_add(&bar[XB_TOP], 1u);
            const unsigned tg = og / nx;
            if (og + 1u == (tg + 1u) * nx) xb_add(&bar[XB_TOPGEN], 1u);
            else XB_SPIN(xb_ld(&bar[XB_TOPGEN]) == tg, bar);
            __builtin_amdgcn_fence(__ATOMIC_ACQUIRE, "agent");
            xb_add(&bar[XB_XGEN(b.x)], 1u);
            asm volatile("s_waitcnt vmcnt(0)" ::: "memory");
        } else {
            XB_SPIN(xb_ld(&bar[XB_XGEN(b.x)]) == gen, bar);
            __builtin_amdgcn_fence(__ATOMIC_ACQUIRE, "agent");
            asm volatile("s_waitcnt vmcnt(0)" ::: "memory");
        }
    }
    __syncthreads();
}

struct Frame {
    LAS unsigned char* lds; volatile LAS unsigned* MISC; gu32* ctl;
    int tid, lane, wave, vcu, G;
    const float* in[9]; float* out; unsigned char* ws;
};
__device__ __forceinline__ float wave_sum(float v) {
#pragma unroll
    for (int o = 1; o < 64; o <<= 1) v += __shfl_xor(v, o);
    return v;
}
__device__ __forceinline__ int prow(int mode, int n) {
    if (mode == 0) return n;
    if (mode == 2 && n < 4096) { const int type = n >> 10, chg = n & 1023, pc = chg >> 6, ch = chg & 63;
        return 256 * pc + 128 * (type >> 1) + 32 * (ch >> 4) + 16 * (type & 1) + 4 * ((ch >> 2) & 3) + (ch & 3); }
    const int l32 = n & 31; return (n & ~31) | (16 * ((l32 >> 2) & 1) + 4 * (l32 >> 3) + (l32 & 3));
}
__device__ __forceinline__ void cvt_item(const float* W, int K, int N, bf16* WT, const float* gk, int mode, LAS float* scr, int item, int lane) {
    const int nblk = N / 32, kb = item / nblk, nb = item % nblk, k0 = 64 * kb, n0 = 32 * nb;
    float wv[32];
#pragma unroll
    for (int i = 0; i < 32; ++i) wv[i] = W[(size_t)(k0 + 2 * i + (lane >> 5)) * N + n0 + (lane & 31)];
    if (gk) { const float g0 = gk[k0 + (lane & 63)];
#pragma unroll
        for (int i = 0; i < 32; ++i) wv[i] *= __shfl(g0, 2 * i + (lane >> 5)); }
#pragma unroll
    for (int i = 0; i < 32; ++i) scr[(2 * i + (lane >> 5)) * 33 + (lane & 31)] = wv[i];
    LDS_WAIT(); asm volatile("" ::: "memory");
    const int c = lane & 7;
#pragma unroll
    for (int j = 0; j < 4; ++j) { const int n = (lane >> 3) + 8 * j; const LAS float* s = scr + (8 * c) * 33 + n;
        v4u o; o.x = pk2(s[0 * 33], s[1 * 33]); o.y = pk2(s[2 * 33], s[3 * 33]); o.z = pk2(s[4 * 33], s[5 * 33]); o.w = pk2(s[6 * 33], s[7 * 33]);
        *(GAS v4u*)(WT + (size_t)prow(mode, n0 + n) * K + k0 + 8 * c) = o; }
    LDS_WAIT(); asm volatile("" ::: "memory");
}
__device__ __forceinline__ void convert_layer(Frame& F, int l, unsigned char* region) {
    LAS float* scr = (LAS float*)(F.lds + F.wave * 16384);
    const int gw = F.vcu * NWAVES + F.wave, NGW = F.G * NWAVES;
    constexpr int I_IN = (D / 64) * (DIN / 32), I_A = (D / 64) * (D / 32), I_B = (2 * D / 64) * (D / 32), I_O = I_A;
    const float* w_in = F.in[2] + (size_t)l * D * DIN; const float* ng = F.in[1] + (size_t)l * D;
    const float* w_a = F.in[5] + (size_t)l * D * D; const float* w_b = F.in[6] + (size_t)l * 2 * D * D; const float* w_o = F.in[7] + (size_t)l * D * D;
    for (int it = gw; it < I_IN + I_A + I_B + I_O; it += NGW) {
        int r = it;
        if (r < I_IN) { cvt_item(w_in, D, DIN, (bf16*)(region + RW_IN), ng, 2, scr, r, F.lane); continue; } r -= I_IN;
        if (r < I_A) { cvt_item(w_a, D, D, (bf16*)(region + RW_A), nullptr, 1, scr, r, F.lane); continue; } r -= I_A;
        if (r < I_B) { cvt_item(w_b, 2 * D, D, (bf16*)(region + RW_B), nullptr, 1, scr, r, F.lane); continue; } r -= I_B;
        cvt_item(w_o, D, D, (bf16*)(region + RW_O), nullptr, 0, scr, r, F.lane);
    }
}
__device__ __forceinline__ void rownorm(Frame& F, const float* src, bf16* xb, float* rstd) {
    const int gw = F.vcu * NWAVES + F.wave, NGW = F.G * NWAVES;
    for (int m = gw; m < M; m += NGW) {
        const GAS f32x4* xr = (const GAS f32x4*)(src + (size_t)m * D) + F.lane;
        f32x4 v[4]; float s = 0.f;
#pragma unroll
        for (int j = 0; j < 4; ++j) { v[j] = xr[64 * j]; s += (v[j].x * v[j].x + v[j].y * v[j].y) + (v[j].z * v[j].z + v[j].w * v[j].w); }
        s = wave_sum(s);
        if (F.lane == 0) rstd[m] = rsqrtf(s * (1.f / D) + EPS);
        GAS v2u* o8 = (GAS v2u*)(xb + (size_t)m * D) + F.lane;
#pragma unroll
        for (int j = 0; j < 4; ++j) { v2u w; w.x = pk2(v[j].x, v[j].y); w.y = pk2(v[j].z, v[j].w); o8[64 * j] = w; }
    }
}
__device__ __forceinline__ void final_norm(Frame& F, float* x, const float* g) {
    const int gw = F.vcu * NWAVES + F.wave, NGW = F.G * NWAVES;
    for (int m = gw; m < M; m += NGW) {
        GAS f32x4* xr = (GAS f32x4*)(x + (size_t)m * D) + F.lane; const GAS f32x4* gr = (const GAS f32x4*)g + F.lane;
        f32x4 v[4]; float s = 0.f;
#pragma unroll
        for (int j = 0; j < 4; ++j) { v[j] = xr[64 * j]; s += (v[j].x * v[j].x + v[j].y * v[j].y) + (v[j].z * v[j].z + v[j].w * v[j].w); }
        const float r = rsqrtf(wave_sum(s) * (1.f / D) + EPS);
#pragma unroll
        for (int j = 0; j < 4; ++j) xr[64 * j] = v[j] * r * gr[64 * j];
    }
}
__device__ __forceinline__ void rotary_tables(Frame& F, float* cosT, float* sinT) {
    const int gt = F.vcu * (NWAVES * 64) + F.tid, NT = F.G * NWAVES * 64;
    for (int idx = gt; idx < T * 128; idx += NT) {
        const int pos = idx >> 7, f = idx & 127;
        double inv = 1.0, bq = 0.930572040929699;
#pragma unroll
        for (int bit = 0; bit < 7; ++bit) { if ((f >> bit) & 1) inv *= bq; bq *= bq; }
        const double a = (double)pos * inv;
        const double kd = __builtin_rint(a * 0.6366197723675814);
        const double r = (a - kd * 1.5707963267948966) - kd * 6.123233995736766e-17;
        const double r2 = r * r;
        double sp = -1.0 / 355687428096000.0;
        sp = sp * r2 + 1.0 / 1307674368000.0; sp = sp * r2 - 1.0 / 6227020800.0; sp = sp * r2 + 1.0 / 39916800.0; sp = sp * r2 - 1.0 / 362880.0;
        sp = sp * r2 + 1.0 / 5040.0; sp = sp * r2 - 1.0 / 120.0; sp = sp * r2 + 1.0 / 6.0; const double sn = r - r * r2 * sp;
        double cp = 1.0 / 20922789888000.0;
        cp = cp * r2 - 1.0 / 87178291200.0; cp = cp * r2 + 1.0 / 479001600.0; cp = cp * r2 - 1.0 / 3628800.0; cp = cp * r2 + 1.0 / 40320.0;
        cp = cp * r2 - 1.0 / 720.0; cp = cp * r2 + 1.0 / 24.0; cp = cp * r2 - 0.5; const double cs = 1.0 + r2 * cp;
        const int k = (int)kd & 3;
        const double c = (k == 0) ? cs : (k == 1) ? -sn : (k == 2) ? -cs : sn;
        const double s = (k == 0) ? sn : (k == 1) ? cs : (k == 2) ? -sn : -cs;
        cosT[idx] = (float)c; sinT[idx] = (float)s;
    }
}
__device__ __forceinline__ void conv_pass(Frame& F, const bf16* U, bf16* BZ, const float* cw, const float* cb) {
    const int gt = F.vcu * (NWAVES * 64) + F.tid, NT = F.G * NWAVES * 64;
    for (int v = gt; v < M * 128; v += NT) {
        const int row = v >> 7, c8 = (v & 127) * 8, t = row & (T - 1);
        const v4u z4 = {0u, 0u, 0u, 0u};
        const v4u u0 = *(const v4u*)(U + (size_t)row * 1024 + c8);
        const v4u u1 = t >= 1 ? *(const v4u*)(U + (size_t)(row - 1) * 1024 + c8) : z4;
        const v4u u2 = t >= 2 ? *(const v4u*)(U + (size_t)(row - 2) * 1024 + c8) : z4;
        bf16* bp = BZ + (size_t)row * 1024 + c8; const v4u bz = *(const v4u*)bp;
        float w0[8], w1[8], w2[8], bb[8];
        *(f32x4*)&w0[0] = *(const f32x4*)(cw + c8); *(f32x4*)&w0[4] = *(const f32x4*)(cw + c8 + 4);
        *(f32x4*)&w1[0] = *(const f32x4*)(cw + 1024 + c8); *(f32x4*)&w1[4] = *(const f32x4*)(cw + 1024 + c8 + 4);
        *(f32x4*)&w2[0] = *(const f32x4*)(cw + 2048 + c8); *(f32x4*)&w2[4] = *(const f32x4*)(cw + 2048 + c8 + 4);
        *(f32x4*)&bb[0] = *(const f32x4*)(cb + c8); *(f32x4*)&bb[4] = *(const f32x4*)(cb + c8 + 4);
        float y[8];
#pragma unroll
        for (int i = 0; i < 4; ++i) {
            const unsigned a0 = u0[i], a1 = u1[i], a2 = u2[i], bzz = bz[i];
            y[2 * i]     = bf_lo(bzz) * (w0[2 * i] * bf_lo(a2) + w1[2 * i] * bf_lo(a1) + w2[2 * i] * bf_lo(a0) + bb[2 * i]);
            y[2 * i + 1] = bf_hi(bzz) * (w0[2 * i + 1] * bf_hi(a2) + w1[2 * i + 1] * bf_hi(a1) + w2[2 * i + 1] * bf_hi(a0) + bb[2 * i + 1]);
        }
        v4u w; w.x = pk2(y[0], y[1]); w.y = pk2(y[2], y[3]); w.z = pk2(y[4], y[5]); w.w = pk2(y[6], y[7]);
        *(v4u*)bp = w;
    }
}
constexpr int CH_KSTR = 576, CH_VSTR = 64, CH_VOFF = 128 * CH_KSTR;
__device__ __forceinline__ void conv_one(int v, const bf16* U, bf16* BZ, const float* cw, const float* cb) {
    const int row = v >> 7, c8 = (v & 127) * 8, t = row & (T - 1);
    const v4u z4 = {0u, 0u, 0u, 0u};
    const v4u u0 = *(const v4u*)(U + (size_t)row * 1024 + c8);
    const v4u u1 = t >= 1 ? *(const v4u*)(U + (size_t)(row - 1) * 1024 + c8) : z4;
    const v4u u2 = t >= 2 ? *(const v4u*)(U + (size_t)(row - 2) * 1024 + c8) : z4;
    bf16* bp = BZ + (size_t)row * 1024 + c8; const v4u bz = *(const v4u*)bp;
    float w0[8], w1[8], w2[8], bb[8];
    *(f32x4*)&w0[0] = *(const f32x4*)(cw + c8); *(f32x4*)&w0[4] = *(const f32x4*)(cw + c8 + 4);
    *(f32x4*)&w1[0] = *(const f32x4*)(cw + 1024 + c8); *(f32x4*)&w1[4] = *(const f32x4*)(cw + 1024 + c8 + 4);
    *(f32x4*)&w2[0] = *(const f32x4*)(cw + 2048 + c8); *(f32x4*)&w2[4] = *(const f32x4*)(cw + 2048 + c8 + 4);
    *(f32x4*)&bb[0] = *(const f32x4*)(cb + c8); *(f32x4*)&bb[4] = *(const f32x4*)(cb + c8 + 4);
    float y[8];
#pragma unroll
    for (int i = 0; i < 4; ++i) {
        const unsigned a0 = u0[i], a1 = u1[i], a2 = u2[i], bzz = bz[i];
        y[2 * i]     = bf_lo(bzz) * (w0[2 * i] * bf_lo(a2) + w1[2 * i] * bf_lo(a1) + w2[2 * i] * bf_lo(a0) + bb[2 * i]);
        y[2 * i + 1] = bf_hi(bzz) * (w0[2 * i + 1] * bf_hi(a2) + w1[2 * i + 1] * bf_hi(a1) + w2[2 * i + 1] * bf_hi(a0) + bb[2 * i + 1]);
    }
    v4u w; w.x = pk2(y[0], y[1]); w.y = pk2(y[2], y[3]); w.z = pk2(y[4], y[5]); w.w = pk2(y[6], y[7]);
    *(v4u*)bp = w;
}
template <bool CONV>
__device__ __forceinline__ void chain_item(Frame& F, int bh, int sl, const bf16* KT, const bf16* V, bf16* ST, const bf16* U, bf16* BZ, const float* cw, const float* cb) {
    int tid_ = F.tid; asm volatile("" : "+v"(tid_));
    const int b = bh >> 2, h = bh & 3, tid = tid_, lane = tid & 63, w = __builtin_amdgcn_readfirstlane(tid >> 6);
    const int hl = lane >> 5, l31 = lane & 31, q = (lane & 15) >> 2, p = lane & 3, blk = (lane >> 4) & 1;
    LAS char* Kt = (LAS char*)F.lds; LAS char* Vt = Kt + CH_VOFF;
    const float g512 = exp2f(512.0f * log2_gamma(h));
    const int gt = F.vcu * (NWAVES * 64) + tid, NT = F.G * NWAVES * 64;
    f32x16 S;
#pragma unroll
    for (int i = 0; i < 16; ++i) S[i] = 0.f;
    bf16* STb = ST + (size_t)bh * 8 * 512 * 256 + ((size_t)sl * 32 + l31) * 256 + w * 32 + 4 * hl;
    const bf16* kg = KT + ((size_t)b * T + (tid >> 5)) * 1024 + h * 256 + (tid & 31) * 8;
    const bf16* vg = V + ((size_t)b * T + (tid >> 2)) * 2048 + h * 512 + sl * 32 + (tid & 3) * 8;
    LAS char* kl = Kt + (tid >> 5) * CH_KSTR + (tid & 31) * 16;
    LAS char* vl = Vt + (tid >> 2) * CH_VSTR + (tid & 3) * 16;
    v4u kr[8], vr;
#pragma unroll
    for (int i = 0; i < 8; ++i) kr[i] = *(const v4u*)(kg + (size_t)i * 16 * 1024);
    vr = *(const v4u*)vg;
#pragma unroll
    for (int g = 0; g < 4; ++g) { v2u w2; w2.x = 0u; w2.y = 0u; *(v2u*)(STb + 8 * g) = w2; }
    const int crow0 = gt >> 7, c8 = (gt & 127) * 8;
    float w0[8], w1[8], w2c[8], bb[8]; v4u cu0 = {0u, 0u, 0u, 0u}, cu1 = cu0, cu2 = cu0, cbz = cu0;
    if (CONV) {
        *(f32x4*)&w0[0] = *(const f32x4*)(cw + c8); *(f32x4*)&w0[4] = *(const f32x4*)(cw + c8 + 4);
        *(f32x4*)&w1[0] = *(const f32x4*)(cw + 1024 + c8); *(f32x4*)&w1[4] = *(const f32x4*)(cw + 1024 + c8 + 4);
        *(f32x4*)&w2c[0] = *(const f32x4*)(cw + 2048 + c8); *(f32x4*)&w2c[4] = *(const f32x4*)(cw + 2048 + c8 + 4);
        *(f32x4*)&bb[0] = *(const f32x4*)(cb + c8); *(f32x4*)&bb[4] = *(const f32x4*)(cb + c8 + 4);
        const int row = crow0, t = row & (T - 1); const v4u z4 = {0u, 0u, 0u, 0u};
        cu0 = *(const v4u*)(U + (size_t)row * 1024 + c8); cu1 = t >= 1 ? *(const v4u*)(U + (size_t)(row - 1) * 1024 + c8) : z4;
        cu2 = t >= 2 ? *(const v4u*)(U + (size_t)(row - 2) * 1024 + c8) : z4; cbz = *(const v4u*)(BZ + (size_t)row * 1024 + c8);
    }
#pragma unroll 1
    for (int it = 0; it < 28; ++it) {
        __syncthreads();
#pragma unroll
        for (int i = 0; i < 8; ++i) *(LAS v4u*)(kl + i * 16 * CH_KSTR) = kr[i];
        *(LAS v4u*)vl = vr;
        if (it + 1 < 28) {
#pragma unroll
            for (int i = 0; i < 8; ++i) kr[i] = *(const v4u*)(kg + (size_t)(it + 1) * 128 * 1024 + (size_t)i * 16 * 1024);
            vr = *(const v4u*)(vg + (size_t)(it + 1) * 128 * 2048);
        }
        if (CONV && it < 16) {
            float y[8];
#pragma unroll
            for (int i = 0; i < 4; ++i) {
                const unsigned a0 = cu0[i], a1 = cu1[i], a2 = cu2[i], bzz = cbz[i];
                y[2 * i]     = bf_lo(bzz) * (w0[2 * i] * bf_lo(a2) + w1[2 * i] * bf_lo(a1) + w2c[2 * i] * bf_lo(a0) + bb[2 * i]);
                y[2 * i + 1] = bf_hi(bzz) * (w0[2 * i + 1] * bf_hi(a2) + w1[2 * i + 1] * bf_hi(a1) + w2c[2 * i + 1] * bf_hi(a0) + bb[2 * i + 1]);
            }
            v4u wy; wy.x = pk2(y[0], y[1]); wy.y = pk2(y[2], y[3]); wy.z = pk2(y[4], y[5]); wy.w = pk2(y[6], y[7]);
            *(v4u*)(BZ + (size_t)(crow0 + 1024 * it) * 1024 + c8) = wy;
            if (it + 1 < 16) { const int row = crow0 + 1024 * (it + 1), t = row & (T - 1); const v4u z4 = {0u, 0u, 0u, 0u};
                cu0 = *(const v4u*)(U + (size_t)row * 1024 + c8); cu1 = t >= 1 ? *(const v4u*)(U + (size_t)(row - 1) * 1024 + c8) : z4;
                cu2 = t >= 2 ? *(const v4u*)(U + (size_t)(row - 2) * 1024 + c8) : z4; cbz = *(const v4u*)(BZ + (size_t)row * 1024 + c8); }
        }
        __syncthreads();
#pragma unroll
        for (int ks = 0; ks < 8; ++ks) {
            const int kr_ = 16 * ks + 8 * hl + q;
            const bf16x8 A = trpair(Kt + kr_ * CH_KSTR + 2 * (32 * w + 16 * blk + 4 * p), 4 * CH_KSTR);
            const bf16x8 B = trpair(Vt + kr_ * CH_VSTR + 2 * (16 * blk + 4 * p), 4 * CH_VSTR);
            S = MFMA32(A, B, S);
        }
        if ((it & 3) == 3) {
#pragma unroll
            for (int i = 0; i < 16; ++i) S[i] *= g512;
            const int s1 = (it >> 2) + 1;
#pragma unroll
            for (int g = 0; g < 4; ++g) { v2u w2; w2.x = pk2(S[4 * g], S[4 * g + 1]); w2.y = pk2(S[4 * g + 2], S[4 * g + 3]); *(v2u*)(STb + (size_t)s1 * 512 * 256 + 8 * g) = w2; }
        }
    }
}
constexpr int AP_STR = 528, AP_VSTR = 1088, AP_KOFF = 128 * AP_STR, AP_VOFF = AP_KOFF + 32 * AP_STR, AP_SOFF = AP_KOFF, AP_RED = 8 * 32 * AP_STR;
static_assert(AP_VOFF + 32 * AP_VSTR <= RING_BYTES && AP_SOFF + 64 * AP_STR <= RING_BYTES && AP_RED + 1024 <= RING_BYTES, "apply LDS map");
__device__ __forceinline__ void apply_item(Frame& F, int bh, int r, const bf16* QT, const bf16* KT, const bf16* V, const bf16* ST, bf16* O, float* ssq) {
    int tid_ = F.tid; asm volatile("" : "+v"(tid_));
    const int b = bh >> 2, h = bh & 3, tid = tid_, lane = tid & 63, w = __builtin_amdgcn_readfirstlane(tid >> 6);
    const int hl = lane >> 5, l31 = lane & 31, q = (lane & 15) >> 2, p = lane & 3, blk = (lane >> 4) & 1;
    const int ig = w & 3, dh = w >> 2, s = r >> 2, t0 = r * 128;
    LAS char* Qs = (LAS char*)F.lds; LAS char* Ks = Qs + AP_KOFF; LAS char* Vs = Qs + AP_VOFF; LAS char* Ss = Qs + AP_SOFF; LAS float* red = (LAS float*)(Qs + AP_RED);
    f32x16 acc[8];
#pragma unroll
    for (int mt = 0; mt < 8; ++mt)
#pragma unroll
        for (int i = 0; i < 16; ++i) acc[mt][i] = 0.f;
    const int ntile = 4 * (r - 4 * s + 1), dtile0 = 4 * (r - 4 * s);
    const size_t key0 = (size_t)b * T + s * 512;
    const bf16* kg = KT + (key0 + (tid >> 5)) * 1024 + h * 256 + (tid & 31) * 8;
    const bf16* vg = V + (key0 + (tid >> 6)) * 2048 + h * 512 + (tid & 63) * 8;
    LAS char* kl = Ks + (tid >> 5) * AP_STR + (tid & 31) * 16;
    LAS char* vl = Vs + (tid >> 6) * AP_VSTR + (tid & 63) * 16;
    v4u kr[2], vr[4];
#pragma unroll
    for (int i = 0; i < 2; ++i) kr[i] = *(const v4u*)(kg + (size_t)i * 16 * 1024);
#pragma unroll
    for (int i = 0; i < 4; ++i) vr[i] = *(const v4u*)(vg + (size_t)i * 8 * 2048);
    __syncthreads();
    {
        const bf16* qg = QT + ((size_t)b * T + t0 + (tid >> 5)) * 1024 + h * 256 + (tid & 31) * 8;
        v4u qr[8];
#pragma unroll
        for (int i = 0; i < 8; ++i) qr[i] = *(const v4u*)(qg + (size_t)i * 16 * 1024);
#pragma unroll
        for (int i = 0; i < 8; ++i) *(LAS v4u*)(Qs + ((tid >> 5) + 16 * i) * AP_STR + (tid & 31) * 16) = qr[i];
    }
    const LAS char* qb = Qs + (32 * ig + l31) * AP_STR + 16 * hl;
    const LAS char* ka = Ks + l31 * AP_STR + 16 * hl;
    const LAS char* vb = Vs + (4 * hl + q) * AP_VSTR + 2 * (256 * dh + 16 * blk + 4 * p);
#pragma unroll 1
    for (int tl = 0; tl < ntile; ++tl) {
        __syncthreads();
#pragma unroll
        for (int i = 0; i < 2; ++i) *(LAS v4u*)(kl + i * 16 * AP_STR) = kr[i];
#pragma unroll
        for (int i = 0; i < 4; ++i) *(LAS v4u*)(vl + i * 8 * AP_VSTR) = vr[i];
        if (tl + 1 < ntile) {
#pragma unroll
            for (int i = 0; i < 2; ++i) kr[i] = *(const v4u*)(kg + (size_t)(tl + 1) * 32 * 1024 + (size_t)i * 16 * 1024);
#pragma unroll
            for (int i = 0; i < 4; ++i) vr[i] = *(const v4u*)(vg + (size_t)(tl + 1) * 32 * 2048 + (size_t)i * 8 * 2048);
        }
        __syncthreads();
        const int kt = tl - dtile0;
        if (kt > ig) continue;
        f32x16 X;
#pragma unroll
        for (int i = 0; i < 16; ++i) X[i] = 0.f;
#pragma unroll
        for (int ks = 0; ks < 16; ++ks) {
            const bf16x8 A = *(const LAS bf16x8*)(ka + 32 * ks);
            const bf16x8 B = *(const LAS bf16x8*)(qb + 32 * ks);
            X = MFMA32(A, B, X);
        }
        if (kt == ig) {
#pragma unroll
            for (int i = 0; i < 16; ++i) if (crow(i, hl) > l31) X[i] = 0.f;
        }
        v4u p0, p1;
        p0.x = pk2(X[0], X[1]); p0.y = pk2(X[2], X[3]); p0.z = pk2(X[4], X[5]); p0.w = pk2(X[6], X[7]);
        p1.x = pk2(X[8], X[9]); p1.y = pk2(X[10], X[11]); p1.z = pk2(X[12], X[13]); p1.w = pk2(X[14], X[15]);
        const bf16x8 P0 = __builtin_bit_cast(bf16x8, p0), P1 = __builtin_bit_cast(bf16x8, p1);
#pragma unroll
        for (int mt = 0; mt < 8; ++mt) {
            const bf16x8 A0 = trpair(vb + 64 * mt, 8 * AP_VSTR);
            const bf16x8 A1 = trpair(vb + 64 * mt + 16 * AP_VSTR, 8 * AP_VSTR);
            acc[mt] = MFMA32(A0, P0, acc[mt]);
            acc[mt] = MFMA32(A1, P1, acc[mt]);
        }
    }
    {
        const bf16* sg = ST + (size_t)(bh * 8 + s) * 512 * 256;
        const int srow = tid >> 5, sc = tid & 31;
        v4u sr[4];
#pragma unroll
        for (int i = 0; i < 4; ++i) { const int rho = srow + 16 * i; sr[i] = *(const v4u*)(sg + ((size_t)(256 * (rho >> 5) + (rho & 31))) * 256 + sc * 8); }
        const LAS char* sa = Ss + (32 * dh + l31) * AP_STR + 16 * hl;
#pragma unroll
        for (int mt = 0; mt < 8; ++mt) {
            __syncthreads();
#pragma unroll
            for (int i = 0; i < 4; ++i) *(LAS v4u*)(Ss + (srow + 16 * i) * AP_STR + sc * 16) = sr[i];
            if (mt + 1 < 8) {
#pragma unroll
                for (int i = 0; i < 4; ++i) { const int rho = srow + 16 * i; sr[i] = *(const v4u*)(sg + ((size_t)(256 * (rho >> 5) + 32 * (mt + 1) + (rho & 31))) * 256 + sc * 8); }
            }
            __syncthreads();
#pragma unroll
            for (int ks = 0; ks < 16; ++ks) {
                const bf16x8 A = *(const LAS bf16x8*)(sa + 32 * ks);
                const bf16x8 B = *(const LAS bf16x8*)(qb + 32 * ks);
                acc[mt] = MFMA32(A, B, acc[mt]);
            }
        }
    }
    float ss = 0.f;
#pragma unroll
    for (int mt = 0; mt < 8; ++mt)
#pragma unroll
        for (int i = 0; i < 16; ++i) ss += acc[mt][i] * acc[mt][i];
    ss += __shfl_xor(ss, 32);
    __syncthreads();
    if (hl == 0) red[dh * 128 + 32 * ig + l31] = ss;
    LAS char* Tw = Qs + w * (32 * AP_STR);
#pragma unroll
    for (int mt = 0; mt < 8; ++mt)
#pragma unroll
        for (int g = 0; g < 4; ++g) { v2u w2; w2.x = pk2(acc[mt][4 * g], acc[mt][4 * g + 1]); w2.y = pk2(acc[mt][4 * g + 2], acc[mt][4 * g + 3]);
            *(LAS v2u*)(Tw + l31 * AP_STR + (32 * mt + 8 * g + 4 * hl) * 2) = w2; }
    __syncthreads();
    bf16* og = O + ((size_t)b * T + t0 + 32 * ig) * 2048 + h * 512 + 256 * dh;
#pragma unroll
    for (int i = 0; i < 16; ++i) { const int id = lane + 64 * i, row = id >> 5, c = id & 31;
        const v4u x = *(const LAS v4u*)(Tw + row * AP_STR + c * 16); *(v4u*)(og + (size_t)row * 2048 + c * 8) = x; }
    if (tid < 128) ssq[((size_t)b * T + t0 + tid) * 4 + h] = red[tid] + red[128 + tid];
}
#ifndef TS_PH
#define TS_PH -1
#endif
struct Args { const float* in[9]; float* out; unsigned char* ws; int ph_lo, ph_hi, li, pad; };
__global__ void __launch_bounds__(NWAVES * 64, 2) fwd_kernel(Args args) {
    extern __shared__ __attribute__((aligned(16))) unsigned char lds[];
    Frame F;
    F.lds = (LAS unsigned char*)lds; F.MISC = (volatile LAS unsigned*)(F.lds + MISC_OFF);
    F.tid = threadIdx.x; F.lane = F.tid & 63; F.wave = __builtin_amdgcn_readfirstlane(F.tid >> 6);
    F.G = gridDim.x; { const int bx = blockIdx.x; F.vcu = (F.G % 8 == 0) ? (bx % 8) * (F.G / 8) + bx / 8 : bx; }
    F.ws = args.ws; F.ctl = (gu32*)(args.ws + WS_CTL); F.out = args.out;
#pragma unroll
    for (int i = 0; i < 9; ++i) F.in[i] = args.in[i];
    for (int u = F.tid; u < (LDS_BYTES - LDSCTL_OFF) / 4; u += NWAVES * 64) ((LAS unsigned*)(F.lds + LDSCTL_OFF))[u] = 0u;
    __syncthreads();
    XcdBarrier bar; bar.bar = (unsigned*)(F.ctl + CW_BAR); bar.x = 0; bar.st = nullptr;
    if (N_LAUNCHES == 1) bar = xcd_barrier_post((unsigned*)(F.ctl + CW_BAR), F.MISC + 8);
    const int lo = args.ph_lo, hi = args.ph_hi;
    if (TS_PH >= 0 && blockIdx.x == 0 && F.tid == 0) F.MISC[16] = (unsigned)__builtin_amdgcn_s_memrealtime();
#define IN(k) (lo <= (k) && (k) < hi)
#define STAMP(i) do { if (TS_PH >= 0 && blockIdx.x == 0 && F.tid == 0) F.MISC[16 + (i)] = (unsigned)__builtin_amdgcn_s_memrealtime(); } while (0)
#define SEAM(k) do { if (IN(k) && IN((k) + 1)) xcd_barrier(bar); STAMP((k) + 1); } while (0)
#ifndef REP_PH
#define REP_PH -1
#endif
#define REPEAT(k) for (int rep = 0, nrep = (l == 0 && REP_PH == (k)) ? 2 : 1; rep < nrep; ++rep)
#define REPBAR() do { if (rep) xcd_barrier(bar); } while (0)
#define PHASE_PTRS() unsigned long long z0_ = 0ull; asm volatile("" : "+s"(z0_)); unsigned char* ws = args.ws + z0_; \
    Frame P = F; { int t_ = threadIdx.x; asm volatile("" : "+v"(t_)); P.tid = t_; P.lane = t_ & 63; P.wave = __builtin_amdgcn_readfirstlane(t_ >> 6); } \
    float* cosT = (float*)(ws + WS_COS); float* sinT = (float*)(ws + WS_SIN); float* rstd = (float*)(ws + WS_RSTD); float* ssq = (float*)(ws + WS_SSQ); \
    bf16* XB = (bf16*)(ws + WS_XB); bf16* U = (bf16*)(ws + WS_U); bf16* BZ = (bf16*)(ws + WS_BZ); bf16* QT = (bf16*)(ws + WS_QT); bf16* KT = (bf16*)(ws + WS_KT); \
    bf16* V = (bf16*)(ws + WS_V); bf16* O = (bf16*)(ws + WS_O); bf16* SG = (bf16*)(ws + WS_SG); float* YAG = (float*)(ws + WS_YAG); bf16* MG = (bf16*)(ws + WS_MG); \
    unsigned char* RW = ws + ((l & 1) ? WS_R2 : WS_R1); unsigned char* RS = ws + ((l & 1) ? WS_R1 : WS_R2); bf16* ST = (bf16*)RS; \
    (void)cosT; (void)sinT; (void)rstd; (void)ssq; (void)XB; (void)U; (void)BZ; (void)QT; (void)KT; (void)V; (void)O; (void)SG; (void)YAG; (void)MG; (void)RW; (void)RS; (void)ST

    if (IN(0)) { const int l = 0; REPEAT(7) {
        REPBAR(); PHASE_PTRS();
        convert_layer(P, 0, ws + WS_R1);
        rotary_tables(P, cosT, sinT);
        rownorm(P, args.in[0], XB, rstd);
    } }
    SEAM(0);
#if REP_PH == 8
    for (int xb = 0; xb < 20; ++xb) xcd_barrier(bar);
#endif
#pragma unroll 1
    for (int l = 0; l < DEPTH; ++l) {
        const int pb = 1 + 7 * l;
        if (IN(pb + 0)) REPEAT(0) {
            REPBAR(); PHASE_PTRS();
            pg8::Gemm g{XB, (const bf16*)(RW + RW_IN), M, NA, D}; pg8::StaticOrder S; S.init(M, NA, F.G, (int)blockIdx.x);
            EpiA E{rstd, cosT, sinT, U, BZ, QT, KT, V};
            pg8::gemm_phase<EpiA, pg8::StaticOrder, true, true>(F.lds, g, S, E);
        }
        SEAM(pb + 0);
        if (IN(pb + 1)) REPEAT(1) {
            REPBAR(); PHASE_PTRS();
            const float* cw = args.in[3] + (size_t)l * 3 * D; const float* cb = args.in[4] + (size_t)l * D;
            if (F.G == 256 && nrep == 1) chain_item<true>(P, F.vcu >> 4, F.vcu & 15, KT, V, ST, U, BZ, cw, cb);
            else { for (int it = F.vcu; it < 256; it += F.G) chain_item<false>(P, it >> 4, it & 15, KT, V, ST, U, BZ, cw, cb);
                   if (rep == nrep - 1) conv_pass(P, U, BZ, cw, cb); }
        }
        SEAM(pb + 1);
        if (IN(pb + 2)) REPEAT(2) {
            REPBAR(); PHASE_PTRS();
            for (int pr = F.vcu; pr < 256; pr += F.G) {
                const int bh = pr >> 4, pi = pr & 15, s = pi >> 1;
                const int ra = (pi & 1) ? 4 * s + 1 : 4 * s + 0, rb = (pi & 1) ? 4 * s + 2 : 4 * s + 3;
#pragma unroll 1
                for (int k = 0; k < 2; ++k) apply_item(P, bh, k == 0 ? rb : ra, QT, KT, V, ST, O, ssq);
            }
        }
        SEAM(pb + 2);
        if (IN(pb + 3)) REPEAT(3) {
            REPBAR(); PHASE_PTRS();
            if (l + 1 < DEPTH && rep == nrep - 1) { convert_layer(P, l + 1, RS); __syncthreads(); }
            pg8::Gemm g{XB, (const bf16*)(RW + RW_IN) + (size_t)NA * D, M, NB, D}; pg8::StaticOrder S; S.init(M, NB, F.G, (int)blockIdx.x);
            EpiB E{rstd, ssq, O, (rep == nrep - 1) ? O : (bf16*)args.out, SG};
            pg8::gemm_phase<EpiB, pg8::StaticOrder, true, true>(F.lds, g, S, E);
        }
        SEAM(pb + 3);
        if (IN(pb + 4)) REPEAT(4) {
            REPBAR(); PHASE_PTRS();
            { pg8::Gemm g{BZ, (const bf16*)(RW + RW_A), M, D, D}; pg8::StaticOrder S; S.init(M, D, F.G, (int)blockIdx.x);
              EpiYA E{SG, YAG}; pg8::gemm_phase<EpiYA, pg8::StaticOrder, false, true>(F.lds, g, S, E); }
            asm volatile("s_waitcnt vmcnt(0)" ::: "memory"); __syncthreads();
            { pg8::Gemm g{O, (const bf16*)(RW + RW_B), M, D, 2 * D}; pg8::StaticOrder S; S.init(M, D, F.G, (int)blockIdx.x);
              EpiMG E{SG, YAG, MG}; pg8::gemm_phase<EpiMG, pg8::StaticOrder, false, true>(F.lds, g, S, E); }
        }
        SEAM(pb + 4);
        if (IN(pb + 5)) REPEAT(5) {
            REPBAR(); PHASE_PTRS();
            pg8::Gemm g{MG, (const bf16*)(RW + RW_O), M, D, D}; pg8::StaticOrder S; S.init(M, D, F.G, (int)blockIdx.x);
            EpiRes E{(l == 0) ? args.in[0] : (const float*)args.out, args.out}; pg8::gemm_phase<EpiRes, pg8::StaticOrder, false, true>(F.lds, g, S, E);
        }
        SEAM(pb + 5);
        if (IN(pb + 6)) REPEAT(6) {
            REPBAR(); PHASE_PTRS();
            if (l + 1 < DEPTH) rownorm(P, args.out, XB, rstd);
            else final_norm(P, args.out, args.in[8]);
        }
        if (l + 1 < DEPTH) SEAM(pb + 6);
    }
    STAMP(NPHASES);
    if (TS_PH >= 0 && blockIdx.x == 0 && F.tid == 0) { const unsigned d = F.MISC[17 + TS_PH] - F.MISC[16 + TS_PH]; const unsigned long long t0 = __builtin_amdgcn_s_memrealtime();
        while (__builtin_amdgcn_s_memrealtime() - t0 < 4ull * d) __builtin_amdgcn_s_sleep(8); }
#undef IN
#undef SEAM
}

extern "C" void kernel_launch(void* const* d_in, const int* in_sizes, int n_in, void* d_out, int out_size, void* d_ws, size_t ws_size, hipStream_t stream) {
    static int grid = 0;
    if (grid == 0) {
        if (n_in != 9 || in_sizes[0] != M * D || out_size != M * D || ws_size < WS_END) {
            fprintf(stderr, "kernel_launch: unexpected problem (n_in %d, in0 %d, out %d, ws %zu; need ws >= %zu); nothing launched\n", n_in, n_in > 0 ? in_sizes[0] : -1, out_size, ws_size, (size_t)WS_END); grid = -1; return; }
        int dev = 0, cus = 0, per_cu = 0;
        if (hipGetDevice(&dev) != hipSuccess || hipDeviceGetAttribute(&cus, hipDeviceAttributeMultiprocessorCount, dev) != hipSuccess) { grid = -1; return; }
        if (hipFuncSetAttribute((const void*)fwd_kernel, hipFuncAttributeMaxDynamicSharedMemorySize, LDS_BYTES) != hipSuccess) { fprintf(stderr, "kernel_launch: hipFuncSetAttribute failed\n"); grid = -1; return; }
        if (hipOccupancyMaxActiveBlocksPerMultiprocessor(&per_cu, (const void*)fwd_kernel, NWAVES * 64, LDS_BYTES) != hipSuccess || per_cu < 1) { fprintf(stderr, "kernel_launch: occupancy query says %d blocks per CU; nothing launched\n", per_cu); (void)hipGetLastError(); grid = -1; return; }
        grid = cus;
    }
    if (grid < 0) return;
    if (hipMemsetAsync((char*)d_ws + WS_CTL, 0, CTL_ZERO_BYTES, stream) != hipSuccess) return;
    Args a{};
    for (int i = 0; i < 9; ++i) a.in[i] = (const float*)d_in[i];
    a.out = (float*)d_out; a.ws = (unsigned char*)d_ws;
    if (N_LAUNCHES == 1) {
        a.ph_lo = 0; a.ph_hi = NPHASES; a.li = 0;
        hipLaunchKernelGGL(fwd_kernel, dim3(grid), dim3(NWAVES * 64), LDS_BYTES, stream, a);
    } else {
        for (int li = 0; li < NPHASES; ++li) { a.ph_lo = li; a.ph_hi = li + 1; a.li = li; hipLaunchKernelGGL(fwd_kernel, dim3(grid), dim3(NWAVES * 64), LDS_BYTES, stream, a); }
    }
}
```

```cpp
#include <hip/hip_runtime.h>
#include <cstdio>
#include <cstdint>
namespace pg8 {
#define PG8_LAS __attribute__((address_space(3)))
typedef unsigned short bf16_t;
typedef short bf16x8 __attribute__((ext_vector_type(8)));
typedef float f32x4 __attribute__((ext_vector_type(4)));
typedef unsigned u32x4 __attribute__((ext_vector_type(4)));
constexpr int BM = 256, BK = 64, HALF = 128, HTB = HALF * BK * 2  , STAGE_BYTES = 8 * HTB, NXCD = 8, WGM = 8;

__host__ __device__ __forceinline__ int lds_byte(int r, int c) { const int st = (r >> 4) * 2 + (c >> 5), rr = r & 15, cc = c & 31, ob = rr * 64 + cc * 2; return st * 1024 + (ob ^ (((ob >> 9) & 1) << 5)); }
__host__ __device__ __forceinline__ void stage_rc(int b, int& R, int& C) { const int st = b / 1024, sb = b % 1024, swz = sb ^ (((sb >> 9) & 1) << 5); R = (st >> 1) * 16 + swz / 64; C = (st & 1) * 32 + (swz % 64) / 2; }
__host__ __device__ __forceinline__ int perm32(int rho) { const int n = rho >> 4, i = rho & 15; return 8 * (i >> 2) + 4 * n + (i & 3); }

struct Unit { int pm, pn; };
struct Gemm { const bf16_t* A; const bf16_t* Bt; int M, N, K; };

struct StaticOrder {
    int nM, nN, nwg, G, c;
    __host__ __device__ void init(int M, int N, int G_, int c_) { nM = M / BM; nN = N / BM; nwg = nM * nN; G = G_; c = c_; }
    __host__ __device__ bool next(int i, Unit& u) const {
        const long L = (long)i * G + c; if (L >= nwg) return false;
        int wgid = (int)L; { const int q = nwg / NXCD, r = nwg % NXCD, xcd = wgid % NXCD, off = wgid / NXCD; wgid = (xcd < r ? xcd * (q + 1) : r * (q + 1) + (xcd - r) * q) + off; }
        const int nig = WGM * nN, gid = wgid / nig, fm = gid * WGM, gsz = (nM - fm) < WGM ? (nM - fm) : WGM;
        u.pm = fm + ((wgid % nig) % gsz); u.pn = (wgid % nig) / gsz; return true;
    }
    __device__ __forceinline__ void a_ready(const Unit&) const {}
    __device__ __forceinline__ void done(const Unit&) const {}
};
__device__ __forceinline__ unsigned cvt_pk_bf16(float lo, float hi) { unsigned r; asm volatile("v_cvt_pk_bf16_f32 %0, %1, %2" : "=v"(r) : "v"(lo), "v"(hi)); return r; }
template <class Epi, class Sched, bool ALIGN_EPI = false, bool SP2 = false>
__device__ __forceinline__ void gemm_phase(PG8_LAS unsigned char* lds, const Gemm g, const Sched& S, const Epi& E) {
    int tid_ = threadIdx.x; asm volatile("" : "+v"(tid_));
    const int tid = tid_, wid = __builtin_amdgcn_readfirstlane(tid >> 6), lane = tid & 63, wr = wid >> 2, wc = wid & 3, fr = lane & 15, fq = lane >> 4;
    const int K = g.K, nt = K / BK;
    unsigned voffA[2], voffB[2];
#pragma unroll
    for (int i = 0; i < 2; ++i) { int R, C; stage_rc(tid * 16 + i * 8192, R, C); const int Rb = Epi::PERM ? ((R & ~31) + perm32(R & 31)) : R;
        voffA[i] = (unsigned)(R * K + C) * 2u; voffB[i] = (unsigned)(Rb * K + C) * 2u; }
    const size_t kstep = (size_t)(BK * 2);
    const size_t hstep = (size_t)HALF * K * 2;
    const size_t tstep = 2 * hstep;
    const unsigned ldsw = (unsigned)wid * 1024u;
    const int aoff = lds_byte(wr * 64 + fr, fq * 8), boff = lds_byte(wc * 32 + fr, fq * 8);
#define PG8_SA(b, h) (((b) * 2 + (h)) * HTB)
#define PG8_SB(b, h) ((4 + (b) * 2 + (h)) * HTB)
#define PG8_STAGE(bufoff, gbase, voff) do { _Pragma("unroll") for (int _i = 0; _i < 2; ++_i) \
        __builtin_amdgcn_global_load_lds((const unsigned*)((const char*)(gbase) + (voff)[_i]), (PG8_LAS unsigned*)(lds + (bufoff) + ldsw + _i * 8192), 16, 0, 0); } while (0)
#define PG8_LDA(dst, b, h) do { _Pragma("unroll") for (int m = 0; m < 4; ++m) _Pragma("unroll") for (int k = 0; k < 2; ++k) dst[m][k] = *(const PG8_LAS bf16x8*)(lds + PG8_SA(b, h) + aoff + m * 2048 + k * 1024); } while (0)
#define PG8_LDB(dst, b, h) do { _Pragma("unroll") for (int n = 0; n < 2; ++n) _Pragma("unroll") for (int k = 0; k < 2; ++k) dst[n][k] = *(const PG8_LAS bf16x8*)(lds + PG8_SB(b, h) + boff + n * 2048 + k * 1024); } while (0)
#define PG8_MMA(ai, bj, At, Bt) do { __builtin_amdgcn_s_setprio(1); _Pragma("unroll") for (int m = 0; m < 4; ++m) _Pragma("unroll") for (int n = 0; n < 2; ++n) _Pragma("unroll") for (int k = 0; k < 2; ++k) \
        acc[ai][bj][m][n] = __builtin_amdgcn_mfma_f32_16x16x32_bf16(Bt[n][k], At[m][k], acc[ai][bj][m][n], 0, 0, 0); __builtin_amdgcn_s_setprio(0); } while (0)
#define PG8_WAIT_V(n) asm volatile("s_waitcnt vmcnt(" #n ")" ::: "memory")
#define PG8_WAIT_L(n) asm volatile("s_waitcnt lgkmcnt(" #n ")" ::: "memory")
#define PG8_BAR __builtin_amdgcn_s_barrier()
#define PG8_SCHED __builtin_amdgcn_sched_barrier(0)
    Unit cur, nxt; int ui = 0;
    if (!S.next(0, cur)) return;
    f32x4 acc[2][2][4][2];
#pragma unroll
    for (int a = 0; a < 2; ++a)
#pragma unroll
        for (int b = 0; b < 2; ++b)
#pragma unroll
            for (int m = 0; m < 4; ++m)
#pragma unroll
                for (int n = 0; n < 2; ++n) acc[a][b][m][n] = (f32x4){0.f, 0.f, 0.f, 0.f};
    bf16x8 At[4][2], B0[2][2], B1[2][2];
    const char* cA = (const char*)g.A + (size_t)cur.pm * tstep; const char* cB = (const char*)g.Bt + (size_t)cur.pn * tstep;
    S.a_ready(cur);
    if constexpr (SP2) {
        PG8_STAGE(PG8_SB(0, 0), cB, voffB); PG8_STAGE(PG8_SB(0, 1), cB + hstep, voffB); PG8_STAGE(PG8_SA(0, 0), cA, voffA); PG8_STAGE(PG8_SA(0, 1), cA + hstep, voffA);
        if (wr == 1) PG8_BAR;
        PG8_WAIT_V(2); PG8_BAR;
        PG8_STAGE(PG8_SB(1, 0), cB + kstep, voffB); PG8_STAGE(PG8_SA(1, 0), cA + kstep, voffA); PG8_STAGE(PG8_SB(1, 1), cB + hstep + kstep, voffB);
        PG8_WAIT_V(6); PG8_BAR;
    } else {
        PG8_STAGE(PG8_SB(0, 0), cB, voffB); PG8_STAGE(PG8_SA(0, 0), cA, voffA); PG8_STAGE(PG8_SB(0, 1), cB + hstep, voffB); PG8_STAGE(PG8_SA(0, 1), cA + hstep, voffA);
        if (wr == 1) PG8_BAR;
        PG8_WAIT_V(4); PG8_BAR;
        PG8_STAGE(PG8_SB(1, 0), cB + kstep, voffB); PG8_STAGE(PG8_SA(1, 0), cA + kstep, voffA); PG8_STAGE(PG8_SB(1, 1), cB + hstep + kstep, voffB);
        PG8_WAIT_V(6); PG8_BAR;
    }
    for (;;) {
        const bool has_next = S.next(ui + 1, nxt);
        const char* nA = has_next ? (const char*)g.A + (size_t)nxt.pm * tstep : cA; const char* nB = has_next ? (const char*)g.Bt + (size_t)nxt.pn * tstep : cB;
        for (int t = 0; t < nt; t += 2) {
            const bool last = (t == nt - 2);
            const char* a1 = cA + (size_t)(t + 1) * kstep;
            const char* a2 = last ? nA : cA + (size_t)(t + 2) * kstep; const char* b2 = last ? nB : cB + (size_t)(t + 2) * kstep;
            const char* a3 = a2 + kstep; const char* b3 = b2 + kstep;
            if (last && has_next) S.a_ready(nxt);
            if constexpr (SP2) {
            PG8_LDB(B0, 0, 0); PG8_LDB(B1, 0, 1); PG8_SCHED; PG8_LDA(At, 0, 0); PG8_STAGE(PG8_SA(1, 1), a1 + hstep, voffA);
            PG8_WAIT_V(8); PG8_WAIT_L(0); PG8_BAR; PG8_MMA(0, 0, At, B0); PG8_MMA(0, 1, At, B1); PG8_BAR; PG8_SCHED;
            PG8_LDA(At, 0, 1); PG8_STAGE(PG8_SB(0, 0), b2, voffB); PG8_STAGE(PG8_SB(0, 1), b2 + hstep, voffB); PG8_STAGE(PG8_SA(0, 0), a2, voffA);
            PG8_WAIT_V(8); PG8_WAIT_L(0); PG8_BAR; PG8_MMA(1, 0, At, B0); PG8_MMA(1, 1, At, B1); PG8_BAR; PG8_SCHED;
            PG8_LDB(B0, 1, 0); PG8_LDB(B1, 1, 1); PG8_SCHED; PG8_LDA(At, 1, 0); PG8_STAGE(PG8_SA(0, 1), a2 + hstep, voffA);
            PG8_WAIT_V(8); PG8_WAIT_L(0); PG8_BAR; PG8_MMA(0, 0, At, B0); PG8_MMA(0, 1, At, B1); PG8_BAR; PG8_SCHED;
            PG8_LDA(At, 1, 1); PG8_STAGE(PG8_SB(1, 0), b3, voffB); PG8_STAGE(PG8_SB(1, 1), b3 + hstep, voffB); PG8_STAGE(PG8_SA(1, 0), a3, voffA);
            PG8_WAIT_V(8); PG8_WAIT_L(0); PG8_BAR; PG8_MMA(1, 0, At, B0); PG8_MMA(1, 1, At, B1); PG8_BAR; PG8_SCHED;
            } else {
            PG8_LDB(B0, 0, 0); PG8_SCHED; PG8_LDA(At, 0, 0); PG8_STAGE(PG8_SA(1, 1), a1 + hstep, voffA);
            PG8_WAIT_L(8); PG8_BAR; PG8_WAIT_L(0); PG8_MMA(0, 0, At, B0); PG8_BAR; PG8_SCHED;
            PG8_LDB(B1, 0, 1); PG8_STAGE(PG8_SB(0, 0), b2, voffB);
            PG8_BAR; PG8_WAIT_L(0); PG8_MMA(0, 1, At, B1); PG8_BAR;
            PG8_LDA(At, 0, 1); PG8_STAGE(PG8_SA(0, 0), a2, voffA);
            PG8_BAR; PG8_WAIT_L(0); PG8_MMA(1, 0, At, B0); PG8_BAR; PG8_SCHED;
            PG8_STAGE(PG8_SB(0, 1), b2 + hstep, voffB);
            PG8_WAIT_V(6); PG8_BAR; PG8_MMA(1, 1, At, B1); PG8_BAR;
            PG8_LDB(B0, 1, 0); PG8_SCHED; PG8_LDA(At, 1, 0); PG8_STAGE(PG8_SA(0, 1), a2 + hstep, voffA);
            PG8_WAIT_L(8); PG8_BAR; PG8_WAIT_L(0); PG8_MMA(0, 0, At, B0); PG8_BAR; PG8_SCHED;
            PG8_LDB(B1, 1, 1); PG8_STAGE(PG8_SB(1, 0), b3, voffB);
            PG8_BAR; PG8_WAIT_L(0); PG8_MMA(0, 1, At, B1); PG8_BAR;
            PG8_LDA(At, 1, 1); PG8_STAGE(PG8_SA(1, 0), a3, voffA);
            PG8_BAR; PG8_WAIT_L(0); PG8_MMA(1, 0, At, B0); PG8_BAR; PG8_SCHED;
            PG8_STAGE(PG8_SB(1, 1), b3 + hstep, voffB);
            PG8_WAIT_V(6); PG8_BAR; PG8_MMA(1, 1, At, B1); PG8_BAR;
            }
        }
        if constexpr (ALIGN_EPI) { if (wr == 0) PG8_BAR; }
        if constexpr (!Epi::AFTER_DRAIN) { E(acc, cur, wr, wc, fr, fq); S.done(cur); }
        if (!has_next) break;
#pragma unroll
        for (int a = 0; a < 2; ++a)
#pragma unroll
            for (int b = 0; b < 2; ++b)
#pragma unroll
                for (int m = 0; m < 4; ++m)
#pragma unroll
                    for (int n = 0; n < 2; ++n) acc[a][b][m][n] = (f32x4){0.f, 0.f, 0.f, 0.f};
        cur = nxt; cA = nA; cB = nB; ++ui;
        if constexpr (ALIGN_EPI) { if (wr == 1) PG8_BAR; }
    }
    PG8_WAIT_V(0);
    if constexpr (!ALIGN_EPI) { if (wr == 0) PG8_BAR; }
    PG8_BAR;
    if constexpr (Epi::AFTER_DRAIN) { E.fused(acc, cur, wr, wc, fr, fq, lds, wid, lane); S.done(cur); }
#undef PG8_SA
#undef PG8_SB
#undef PG8_STAGE
#undef PG8_LDA
#undef PG8_LDB
#undef PG8_MMA
#undef PG8_WAIT_V
#undef PG8_WAIT_L
#undef PG8_BAR
#undef PG8_SCHED
}
}

constexpr int BATCH = 4, T = 4096, D = 1024, M = BATCH * T, DIN = 12288, DEPTH = 2, NWAVES = 8;
constexpr int NA = 8192, NB = 4096;
constexpr float EPS = 1e-6f;
#ifndef N_LAUNCHES
#define N_LAUNCHES 1
#endif
constexpr int NPHASES = 1 + 7 * DEPTH;

constexpr size_t MiB = 1u << 20;
constexpr size_t WS_CTL = 0, CTL_ZERO_BYTES = 1 * MiB;
constexpr size_t WS_R1 = 1 * MiB, WS_R2 = 326 * MiB;
constexpr size_t RW_IN = 0, RW_A = 24 * MiB, RW_B = 26 * MiB, RW_O = 30 * MiB;
constexpr size_t WS_COS = 33 * MiB, WS_SIN = 35 * MiB;
constexpr size_t WS_RSTD = 37 * MiB, WS_SSQ = 37 * MiB + 65536;
constexpr size_t WS_XB = 38 * MiB;
constexpr size_t WS_U = 70 * MiB, WS_BZ = 102 * MiB;
constexpr size_t WS_QT = 134 * MiB, WS_KT = 166 * MiB;
constexpr size_t WS_V = 198 * MiB;
constexpr size_t WS_O = 262 * MiB;
constexpr size_t WS_SG = WS_QT;
constexpr size_t WS_YAG = WS_V;
constexpr size_t WS_MG = WS_U;
constexpr size_t WS_END = 358 * MiB;
constexpr int CW_BAR = 4096;

constexpr int RING_BYTES = 147456, LDSCTL_OFF = RING_BYTES, MISC_OFF = LDSCTL_OFF + 320, LDS_BYTES = RING_BYTES + 1024;

#define GAS __attribute__((address_space(1)))
#define LAS __attribute__((address_space(3)))
typedef unsigned short bf16;
typedef unsigned v4u __attribute__((ext_vector_type(4)));
typedef unsigned v2u __attribute__((ext_vector_type(2)));
typedef float f32x4 __attribute__((ext_vector_type(4)));
typedef float f32x16 __attribute__((ext_vector_type(16)));
typedef short bf16x8 __attribute__((ext_vector_type(8)));
typedef short s16x4 __attribute__((ext_vector_type(4)));
typedef float f32x2_t __attribute__((ext_vector_type(2)));
typedef __bf16 bf16x2_t __attribute__((ext_vector_type(2)));
typedef GAS unsigned gu32;
#define LDS_WAIT() asm volatile("s_waitcnt lgkmcnt(0)" ::: "memory")
#define MFMA32(a, b, c) __builtin_amdgcn_mfma_f32_32x32x16_bf16((a), (b), (c), 0, 0, 0)

__device__ __forceinline__ unsigned pk2(float lo, float hi) { f32x2_t v = {lo, hi}; bf16x2_t b = __builtin_convertvector(v, bf16x2_t); return __builtin_bit_cast(unsigned, b); }
__device__ __forceinline__ float bf_lo(unsigned u) { return __uint_as_float(u << 16); }
__device__ __forceinline__ float bf_hi(unsigned u) { return __uint_as_float(u & 0xffff0000u); }
__device__ __forceinline__ float sigm(float x) { return __builtin_amdgcn_rcpf(1.0f + __expf(-x)); }
__device__ __forceinline__ int crow(int r, int hi) { return (r & 3) + 8 * (r >> 2) + 4 * hi; }
__device__ __forceinline__ float log2_gamma(int h) { return h == 0 ? -0.04580368961312479f : h == 1 ? -0.02272007650008353f : h == 2 ? -0.011315313227834146f : -0.005646563141142063f; }
typedef short v4i16_t __attribute__((ext_vector_type(4)));
__device__ __forceinline__ s16x4 vtr(const LAS char* p) { return __builtin_bit_cast(s16x4, __builtin_amdgcn_ds_read_tr16_b64_v4i16((LAS v4i16_t*)p)); }
__device__ __forceinline__ bf16x8 trpair(const LAS char* p, int hi_off) { const s16x4 lo = vtr(p), hi = vtr(p + hi_off); return (bf16x8){lo[0], lo[1], lo[2], lo[3], hi[0], hi[1], hi[2], hi[3]}; }

using pg8::Unit;
struct EpiA {
    static constexpr bool PERM = false, AFTER_DRAIN = false;
    const float* rstd; const float* cosT; const float* sinT; bf16* U; bf16* BZ; bf16* QT; bf16* KT; bf16* V;
    __device__ __forceinline__ void operator()(const f32x4 (&acc)[2][2][4][2], const Unit& u, int wr, int wc, int fr, int fq) const {
        const int row0 = u.pm * 256 + wr * 64 + fr;
        if (u.pn < 16) {
            const int ch0 = u.pn * 64 + wc * 16 + fq * 4;
#pragma unroll
            for (int ai = 0; ai < 2; ++ai)
#pragma unroll
                for (int m = 0; m < 4; ++m) {
                    const int row = row0 + ai * 128 + m * 16; const float rs = rstd[row];
                    const f32x4 b = acc[ai][0][m][0] * rs, c = acc[ai][0][m][1] * rs, x = acc[ai][1][m][0] * rs, z = acc[ai][1][m][1] * rs;
                    const f32x4 uu = c * x; f32x4 bz;
#pragma unroll
                    for (int j = 0; j < 4; ++j) bz[j] = b[j] * z[j] * sigm(z[j]);
                    v2u w0, w1; w0.x = pk2(uu[0], uu[1]); w0.y = pk2(uu[2], uu[3]); w1.x = pk2(bz[0], bz[1]); w1.y = pk2(bz[2], bz[3]);
                    *(v2u*)(U + (size_t)row * 1024 + ch0) = w0; *(v2u*)(BZ + (size_t)row * 1024 + ch0) = w1;
                    asm volatile("" ::: "memory");
                }
        } else if (u.pn < 24) {
            const int hd = (u.pn - 16) & 3; const bool isk = u.pn >= 20; bf16* dst = isk ? KT : QT;
            const float lg = log2_gamma(hd); const int f0 = wc * 32 + fq * 8;
#pragma unroll
            for (int ai = 0; ai < 2; ++ai)
#pragma unroll
                for (int m = 0; m < 4; ++m) {
                    const int row = row0 + ai * 128 + m * 16; const int pos = row & (T - 1); const float p = (float)(pos & 511);
                    const float sc = rstd[row] * (isk ? exp2f(-p * lg) * 0.0625f : exp2f(p * lg));
                    const f32x4 c0 = *(const f32x4*)(cosT + (size_t)pos * 128 + f0), c1 = *(const f32x4*)(cosT + (size_t)pos * 128 + f0 + 4);
                    const f32x4 s0 = *(const f32x4*)(sinT + (size_t)pos * 128 + f0), s1 = *(const f32x4*)(sinT + (size_t)pos * 128 + f0 + 4);
                    const f32x4 t1a = acc[ai][0][m][0], t1b = acc[ai][0][m][1], t2a = acc[ai][1][m][0], t2b = acc[ai][1][m][1];
                    const f32x4 o1a = (t1a * c0 - t2a * s0) * sc, o1b = (t1b * c1 - t2b * s1) * sc, o2a = (t1a * s0 + t2a * c0) * sc, o2b = (t1b * s1 + t2b * c1) * sc;
                    v4u w1, w2; w1.x = pk2(o1a[0], o1a[1]); w1.y = pk2(o1a[2], o1a[3]); w1.z = pk2(o1b[0], o1b[1]); w1.w = pk2(o1b[2], o1b[3]);
                    w2.x = pk2(o2a[0], o2a[1]); w2.y = pk2(o2a[2], o2a[3]); w2.z = pk2(o2b[0], o2b[1]); w2.w = pk2(o2b[2], o2b[3]);
                    bf16* rp = dst + (size_t)row * 1024 + hd * 256 + f0;
                    *(v4u*)rp = w1; *(v4u*)(rp + 128) = w2;
                    asm volatile("" ::: "memory");
                }
        } else {
            const int col0 = (u.pn - 24) * 256 + wc * 32 + fq * 8;
#pragma unroll
            for (int ai = 0; ai < 2; ++ai)
#pragma unroll
                for (int m = 0; m < 4; ++m) {
                    const int row = row0 + ai * 128 + m * 16; const float rs = rstd[row];
#pragma unroll
                    for (int bj = 0; bj < 2; ++bj) { const f32x4 a = acc[ai][bj][m][0] * rs, b = acc[ai][bj][m][1] * rs;
                        v4u w; w.x = pk2(a[0], a[1]); w.y = pk2(a[2], a[3]); w.z = pk2(b[0], b[1]); w.w = pk2(b[2], b[3]);
                        *(v4u*)(V + (size_t)row * 2048 + col0 + bj * 128) = w; }
                    asm volatile("" ::: "memory");
                }
        }
    }
};
struct EpiB {
    static constexpr bool PERM = false, AFTER_DRAIN = false;
    const float* rstd; const float* ssq; const bf16* O; bf16* OB; bf16* SG;
    __device__ __forceinline__ void operator()(const f32x4 (&acc)[2][2][4][2], const Unit& u, int wr, int wc, int fr, int fq) const {
        const int row0 = u.pm * 256 + wr * 64 + fr;
        if (u.pn < 8) {
            const int hd = u.pn >> 1, col0 = u.pn * 256 + wc * 32 + fq * 8;
#pragma unroll
            for (int ai = 0; ai < 2; ++ai)
#pragma unroll
                for (int m = 0; m < 4; ++m) {
                    const int row = row0 + ai * 128 + m * 16; const float rs = rstd[row];
                    const float rg = rsqrtf(ssq[(size_t)row * 4 + hd] * (1.0f / 512.0f) + EPS);
#pragma unroll
                    for (int bj = 0; bj < 2; ++bj) {
                        const size_t oo = (size_t)row * 2048 + col0 + bj * 128; const v4u ov = *(const v4u*)(O + oo);
                        const f32x4 za = acc[ai][bj][m][0] * rs, zb = acc[ai][bj][m][1] * rs;
                        float r[8];
                        r[0] = bf_lo(ov.x) * rg * za[0] * sigm(za[0]); r[1] = bf_hi(ov.x) * rg * za[1] * sigm(za[1]);
                        r[2] = bf_lo(ov.y) * rg * za[2] * sigm(za[2]); r[3] = bf_hi(ov.y) * rg * za[3] * sigm(za[3]);
                        r[4] = bf_lo(ov.z) * rg * zb[0] * sigm(zb[0]); r[5] = bf_hi(ov.z) * rg * zb[1] * sigm(zb[1]);
                        r[6] = bf_lo(ov.w) * rg * zb[2] * sigm(zb[2]); r[7] = bf_hi(ov.w) * rg * zb[3] * sigm(zb[3]);
                        v4u w; w.x = pk2(r[0], r[1]); w.y = pk2(r[2], r[3]); w.z = pk2(r[4], r[5]); w.w = pk2(r[6], r[7]);
                        *(v4u*)(OB + oo) = w;
                    }
                    asm volatile("" ::: "memory");
                }
        } else {
            const int col0 = (u.pn - 8) * 256 + wc * 32 + fq * 8;
#pragma unroll
            for (int ai = 0; ai < 2; ++ai)
#pragma unroll
                for (int m = 0; m < 4; ++m) {
                    const int row = row0 + ai * 128 + m * 16; const float rs = rstd[row];
#pragma unroll
                    for (int bj = 0; bj < 2; ++bj) { const f32x4 a = acc[ai][bj][m][0] * rs, b = acc[ai][bj][m][1] * rs;
                        v4u w; w.x = pk2(sigm(a[0]), sigm(a[1])); w.y = pk2(sigm(a[2]), sigm(a[3])); w.z = pk2(sigm(b[0]), sigm(b[1])); w.w = pk2(sigm(b[2]), sigm(b[3]));
                        *(v4u*)(SG + (size_t)row * 2048 + col0 + bj * 128) = w; }
                    asm volatile("" ::: "memory");
                }
        }
    }
};
struct EpiYA {
    static constexpr bool PERM = false, AFTER_DRAIN = false;
    const bf16* SG; float* YAG;
    __device__ __forceinline__ void operator()(const f32x4 (&acc)[2][2][4][2], const Unit& u, int wr, int wc, int fr, int fq) const {
        const int row0 = u.pm * 256 + wr * 64 + fr, col0 = u.pn * 256 + wc * 32 + fq * 8;
#pragma unroll
        for (int ai = 0; ai < 2; ++ai)
#pragma unroll
            for (int m = 0; m < 4; ++m) { const int row = row0 + ai * 128 + m * 16;
#pragma unroll
                for (int bj = 0; bj < 2; ++bj) { const v4u g = *(const v4u*)(SG + (size_t)row * 2048 + col0 + bj * 128);
                    f32x4 a = acc[ai][bj][m][0], b = acc[ai][bj][m][1];
                    a[0] *= bf_lo(g.x); a[1] *= bf_hi(g.x); a[2] *= bf_lo(g.y); a[3] *= bf_hi(g.y); b[0] *= bf_lo(g.z); b[1] *= bf_hi(g.z); b[2] *= bf_lo(g.w); b[3] *= bf_hi(g.w);
                    float* yp = YAG + (size_t)row * 1024 + col0 + bj * 128; *(f32x4*)yp = a; *(f32x4*)(yp + 4) = b; } asm volatile("" ::: "memory"); }
    }
};
struct EpiMG {
    static constexpr bool PERM = false, AFTER_DRAIN = false;
    const bf16* SG; const float* YAG; bf16* MG;
    __device__ __forceinline__ void operator()(const f32x4 (&acc)[2][2][4][2], const Unit& u, int wr, int wc, int fr, int fq) const {
        const int row0 = u.pm * 256 + wr * 64 + fr, col0 = u.pn * 256 + wc * 32 + fq * 8;
#pragma unroll
        for (int ai = 0; ai < 2; ++ai)
#pragma unroll
            for (int m = 0; m < 4; ++m) { const int row = row0 + ai * 128 + m * 16;
#pragma unroll
                for (int bj = 0; bj < 2; ++bj) { const v4u g = *(const v4u*)(SG + (size_t)row * 2048 + 1024 + col0 + bj * 128);
                    const float* yp = YAG + (size_t)row * 1024 + col0 + bj * 128; f32x4 a = *(const f32x4*)yp, b = *(const f32x4*)(yp + 4);
                    const f32x4 ca = acc[ai][bj][m][0], cb = acc[ai][bj][m][1];
                    a[0] += ca[0] * bf_lo(g.x); a[1] += ca[1] * bf_hi(g.x); a[2] += ca[2] * bf_lo(g.y); a[3] += ca[3] * bf_hi(g.y);
                    b[0] += cb[0] * bf_lo(g.z); b[1] += cb[1] * bf_hi(g.z); b[2] += cb[2] * bf_lo(g.w); b[3] += cb[3] * bf_hi(g.w);
                    v4u w; w.x = pk2(a[0], a[1]); w.y = pk2(a[2], a[3]); w.z = pk2(b[0], b[1]); w.w = pk2(b[2], b[3]);
                    *(v4u*)(MG + (size_t)row * 1024 + col0 + bj * 128) = w; } asm volatile("" ::: "memory"); }
    }
};
struct EpiRes {
    static constexpr bool PERM = false, AFTER_DRAIN = false;
    const float* xres; float* xout;
    __device__ __forceinline__ void operator()(const f32x4 (&acc)[2][2][4][2], const Unit& u, int wr, int wc, int fr, int fq) const {
        const int row0 = u.pm * 256 + wr * 64 + fr, col0 = u.pn * 256 + wc * 32 + fq * 4;
#pragma unroll
        for (int ai = 0; ai < 2; ++ai)
#pragma unroll
            for (int m = 0; m < 4; ++m) { const size_t off = (size_t)(row0 + ai * 128 + m * 16) * 1024 + col0;
#pragma unroll
                for (int bj = 0; bj < 2; ++bj)
#pragma unroll
                    for (int n = 0; n < 2; ++n) { const f32x4 r = *(const f32x4*)(xres + off + bj * 128 + n * 16); *(f32x4*)(xout + off + bj * 128 + n * 16) = r + acc[ai][bj][m][n]; } asm volatile("" ::: "memory"); }
    }
};
#define XB_TMO      128
#define XB_XCNT(j)  (256  + 64 * (j))
#define XB_XSUB(j)  (1280 + 64 * (j))
#define XB_XGEN(j)  (2304 + 64 * (j))
#define XB_TOP      3328
#define XB_TOPGEN   3392
#define XCD_BAR_WORDS 3456
#define XB_SPIN_CAP (1u << 18)

__device__ __forceinline__ unsigned xb_ld(unsigned* p)              { return __hip_atomic_load(p, __ATOMIC_RELAXED, __HIP_MEMORY_SCOPE_AGENT); }
__device__ __forceinline__ unsigned xb_add(unsigned* p, unsigned v) { return __hip_atomic_fetch_add(p, v, __ATOMIC_RELAXED, __HIP_MEMORY_SCOPE_AGENT); }
__device__ __forceinline__ unsigned xb_xcc_id() { return (unsigned)__builtin_amdgcn_s_getreg((3 << 11) | 20) & 0xFu; }
#define XB_SPIN(cond, bar) do { unsigned _sp = 0; while (cond) { __builtin_amdgcn_s_sleep(1); \
    if ((++_sp & 255u) == 0u) { if (xb_ld(&(bar)[XB_TMO])) break; if (_sp > XB_SPIN_CAP) { atomicAdd(&(bar)[XB_TMO], 1u); break; } } } } while (0)

struct XcdBarrier {
    unsigned* bar; unsigned x;
    volatile LAS unsigned* st;
};

__device__ __forceinline__ XcdBarrier xcd_barrier_post(unsigned* bar, volatile LAS unsigned* st) {
    XcdBarrier b; b.bar = bar; b.x = xb_xcc_id(); b.st = st;
    if (threadIdx.x == 0) (void)xb_add(&bar[XB_XCNT(b.x)], 1u);
    return b;
}
__device__ __forceinline__ void xcd_barrier_complete(unsigned* bar, unsigned x, unsigned& nloc, unsigned& nx) {
    const unsigned G = gridDim.x * gridDim.y * gridDim.z;
    unsigned sum, cnt, mine, sp = 0u;
    for (;;) {
        sum = 0u; cnt = 0u; mine = 0u;
#pragma unroll
        for (unsigned j = 0; j < 16; ++j) { const unsigned c = xb_ld(&bar[XB_XCNT(j)]); sum += c; cnt += (c > 0u) ? 1u : 0u; mine = (j == x) ? c : mine; }
        if (sum == G) break;
        __builtin_amdgcn_s_sleep(1);
        if ((++sp & 255u) == 0u) { if (xb_ld(&bar[XB_TMO])) break; if (sp > XB_SPIN_CAP) { atomicAdd(&bar[XB_TMO], 1u); break; } }
    }
    nloc = mine > 0u ? mine : 1u; nx = cnt > 0u ? cnt : 1u;
}

__device__ __forceinline__ void xcd_barrier(const XcdBarrier& b) {
    asm volatile("s_waitcnt vmcnt(0)" ::: "memory");
    __syncthreads();
    if (threadIdx.x == 0) {
        unsigned* bar = b.bar;
        __builtin_amdgcn_s_waitcnt(0);
        unsigned nloc = b.st[0], nx = b.st[1];
        if (nloc == 0u) { xcd_barrier_complete(bar, b.x, nloc, nx); b.st[0] = nloc; b.st[1] = nx; }
        const unsigned old = xb_add(&bar[XB_XSUB(b.x)], 1u);
        const unsigned gen = old / nloc;
        if (old + 1u == (gen + 1u) * nloc) {
            __builtin_amdgcn_fence(__ATOMIC_RELEASE, "agent");
            asm volatile("s_waitcnt vmcnt(0)" ::: "memory");
            const unsigned og = xb_add(&bar[XB_TOP], 1u);
            const unsigned tg = og / nx;
            if (og + 1u == (tg + 1u) * nx) xb_add(&bar[XB_TOPGEN], 1u);
            else XB_SPIN(xb_ld(&bar[XB_TOPGEN]) == tg, bar);
            __builtin_amdgcn_fence(__ATOMIC_ACQUIRE, "agent");
            xb_add(&bar[XB_XGEN(b.x)], 1u);
            asm volatile("s_waitcnt vmcnt(0)" ::: "memory");
        } else {
            XB_SPIN(xb_ld(&bar[XB_XGEN(b.x)]) == gen, bar);
            __builtin_amdgcn_fence(__ATOMIC_ACQUIRE, "agent");
            asm volatile("s_waitcnt vmcnt(0)" ::: "memory");
        }
    }
    __syncthreads();
}

struct Frame {
    LAS unsigned char* lds; volatile LAS unsigned* MISC; gu32* ctl;
    int tid, lane, wave, vcu, G;
    const float* in[9]; float* out; unsigned char* ws;
};
__device__ __forceinline__ float wave_sum(float v) {
#pragma unroll
    for (int o = 1; o < 64; o <<= 1) v += __shfl_xor(v, o);
    return v;
}
__device__ __forceinline__ int prow(int mode, int n) {
    if (mode == 0) return n;
    if (mode == 2 && n < 4096) { const int type = n >> 10, chg = n & 1023, pc = chg >> 6, ch = chg & 63;
        return 256 * pc + 128 * (type >> 1) + 32 * (ch >> 4) + 16 * (type & 1) + 4 * ((ch >> 2) & 3) + (ch & 3); }
    const int l32 = n & 31; return (n & ~31) | (16 * ((l32 >> 2) & 1) + 4 * (l32 >> 3) + (l32 & 3));
}
__device__ __forceinline__ void cvt_item(const float* W, int K, int N, bf16* WT, const float* gk, int mode, LAS float* scr, int item, int lane) {
    const int nblk = N / 32, kb = item / nblk, nb = item % nblk, k0 = 64 * kb, n0 = 32 * nb;
    float wv[32];
#pragma unroll
    for (int i = 0; i < 32; ++i) wv[i] = W[(size_t)(k0 + 2 * i + (lane >> 5)) * N + n0 + (lane & 31)];
    if (gk) { const float g0 = gk[k0 + (lane & 63)];
#pragma unroll
        for (int i = 0; i < 32; ++i) wv[i] *= __shfl(g0, 2 * i + (lane >> 5)); }
#pragma unroll
    for (int i = 0; i < 32; ++i) scr[(2 * i + (lane >> 5)) * 33 + (lane & 31)] = wv[i];
    LDS_WAIT(); asm volatile("" ::: "memory");
    const int c = lane & 7;
#pragma unroll
    for (int j = 0; j < 4; ++j) { const int n = (lane >> 3) + 8 * j; const LAS float* s = scr + (8 * c) * 33 + n;
        v4u o; o.x = pk2(s[0 * 33], s[1 * 33]); o.y = pk2(s[2 * 33], s[3 * 33]); o.z = pk2(s[4 * 33], s[5 * 33]); o.w = pk2(s[6 * 33], s[7 * 33]);
        *(GAS v4u*)(WT + (size_t)prow(mode, n0 + n) * K + k0 + 8 * c) = o; }
    LDS_WAIT(); asm volatile("" ::: "memory");
}
__device__ __forceinline__ void convert_layer(Frame& F, int l, unsigned char* region) {
    LAS float* scr = (LAS float*)(F.lds + F.wave * 16384);
    const int gw = F.vcu * NWAVES + F.wave, NGW = F.G * NWAVES;
    constexpr int I_IN = (D / 64) * (DIN / 32), I_A = (D / 64) * (D / 32), I_B = (2 * D / 64) * (D / 32), I_O = I_A;
    const float* w_in = F.in[2] + (size_t)l * D * DIN; const float* ng = F.in[1] + (size_t)l * D;
    const float* w_a = F.in[5] + (size_t)l * D * D; const float* w_b = F.in[6] + (size_t)l * 2 * D * D; const float* w_o = F.in[7] + (size_t)l * D * D;
    for (int it = gw; it < I_IN + I_A + I_B + I_O; it += NGW) {
        int r = it;
        if (r < I_IN) { cvt_item(w_in, D, DIN, (bf16*)(region + RW_IN), ng, 2, scr, r, F.lane); continue; } r -= I_IN;
        if (r < I_A) { cvt_item(w_a, D, D, (bf16*)(region + RW_A), nullptr, 1, scr, r, F.lane); continue; } r -= I_A;
        if (r < I_B) { cvt_item(w_b, 2 * D, D, (bf16*)(region + RW_B), nullptr, 1, scr, r, F.lane); continue; } r -= I_B;
        cvt_item(w_o, D, D, (bf16*)(region + RW_O), nullptr, 0, scr, r, F.lane);
    }
}
__device__ __forceinline__ void rownorm(Frame& F, const float* src, bf16* xb, float* rstd) {
    const int gw = F.vcu * NWAVES + F.wave, NGW = F.G * NWAVES;
    for (int m = gw; m < M; m += NGW) {
        const GAS f32x4* xr = (const GAS f32x4*)(src + (size_t)m * D) + F.lane;
        f32x4 v[4]; float s = 0.f;
#pragma unroll
        for (int j = 0; j < 4; ++j) { v[j] = xr[64 * j]; s += (v[j].x * v[j].x + v[j].y * v[j].y) + (v[j].z * v[j].z + v[j].w * v[j].w); }
        s = wave_sum(s);
        if (F.lane == 0) rstd[m] = rsqrtf(s * (1.f / D) + EPS);
        GAS v2u* o8 = (GAS v2u*)(xb + (size_t)m * D) + F.lane;
#pragma unroll
        for (int j = 0; j < 4; ++j) { v2u w; w.x = pk2(v[j].x, v[j].y); w.y = pk2(v[j].z, v[j].w); o8[64 * j] = w; }
    }
}
__device__ __forceinline__ void final_norm(Frame& F, float* x, const float* g) {
    const int gw = F.vcu * NWAVES + F.wave, NGW = F.G * NWAVES;
    for (int m = gw; m < M; m += NGW) {
        GAS f32x4* xr = (GAS f32x4*)(x + (size_t)m * D) + F.lane; const GAS f32x4* gr = (const GAS f32x4*)g + F.lane;
        f32x4 v[4]; float s = 0.f;
#pragma unroll
        for (int j = 0; j < 4; ++j) { v[j] = xr[64 * j]; s += (v[j].x * v[j].x + v[j].y * v[j].y) + (v[j].z * v[j].z + v[j].w * v[j].w); }
        const float r = rsqrtf(wave_sum(s) * (1.f / D) + EPS);
#pragma unroll
        for (int j = 0; j < 4; ++j) xr[64 * j] = v[j] * r * gr[64 * j];
    }
}
__device__ __forceinline__ void rotary_tables(Frame& F, float* cosT, float* sinT) {
    const int gt = F.vcu * (NWAVES * 64) + F.tid, NT = F.G * NWAVES * 64;
    for (int idx = gt; idx < T * 128; idx += NT) {
        const int pos = idx >> 7, f = idx & 127;
        double inv = 1.0, bq = 0.930572040929699;
#pragma unroll
        for (int bit = 0; bit < 7; ++bit) { if ((f >> bit) & 1) inv *= bq; bq *= bq; }
        const double a = (double)pos * inv;
        const double kd = __builtin_rint(a * 0.6366197723675814);
        const double r = (a - kd * 1.5707963267948966) - kd * 6.123233995736766e-17;
        const double r2 = r * r;
        double sp = -1.0 / 355687428096000.0;
        sp = sp * r2 + 1.0 / 1307674368000.0; sp = sp * r2 - 1.0 / 6227020800.0; sp = sp * r2 + 1.0 / 39916800.0; sp = sp * r2 - 1.0 / 362880.0;
        sp = sp * r2 + 1.0 / 5040.0; sp = sp * r2 - 1.0 / 120.0; sp = sp * r2 + 1.0 / 6.0; const double sn = r - r * r2 * sp;
        double cp = 1.0 / 20922789888000.0;
        cp = cp * r2 - 1.0 / 87178291200.0; cp = cp * r2 + 1.0 / 479001600.0; cp = cp * r2 - 1.0 / 3628800.0; cp = cp * r2 + 1.0 / 40320.0;
        cp = cp * r2 - 1.0 / 720.0; cp = cp * r2 + 1.0 / 24.0; cp = cp * r2 - 0.5; const double cs = 1.0 + r2 * cp;
        const int k = (int)kd & 3;
        const double c = (k == 0) ? cs : (k == 1) ? -sn : (k == 2) ? -cs : sn;
        const double s = (k == 0) ? sn : (k == 1) ? cs : (k == 2) ? -sn : -cs;
        cosT[idx] = (float)c; sinT[idx] = (float)s;
    }
}
__device__ __forceinline__ void conv_pass(Frame& F, const bf16* U, bf16* BZ, const float* cw, const float* cb) {
    const int gt = F.vcu * (NWAVES * 64) + F.tid, NT = F.G * NWAVES * 64;
    for (int v = gt; v < M * 128; v += NT) {
        const int row = v >> 7, c8 = (v & 127) * 8, t = row & (T - 1);
        const v4u z4 = {0u, 0u, 0u, 0u};
        const v4u u0 = *(const v4u*)(U + (size_t)row * 1024 + c8);
        const v4u u1 = t >= 1 ? *(const v4u*)(U + (size_t)(row - 1) * 1024 + c8) : z4;
        const v4u u2 = t >= 2 ? *(const v4u*)(U + (size_t)(row - 2) * 1024 + c8) : z4;
        bf16* bp = BZ + (size_t)row * 1024 + c8; const v4u bz = *(const v4u*)bp;
        float w0[8], w1[8], w2[8], bb[8];
        *(f32x4*)&w0[0] = *(const f32x4*)(cw + c8); *(f32x4*)&w0[4] = *(const f32x4*)(cw + c8 + 4);
        *(f32x4*)&w1[0] = *(const f32x4*)(cw + 1024 + c8); *(f32x4*)&w1[4] = *(const f32x4*)(cw + 1024 + c8 + 4);
        *(f32x4*)&w2[0] = *(const f32x4*)(cw + 2048 + c8); *(f32x4*)&w2[4] = *(const f32x4*)(cw + 2048 + c8 + 4);
        *(f32x4*)&bb[0] = *(const f32x4*)(cb + c8); *(f32x4*)&bb[4] = *(const f32x4*)(cb + c8 + 4);
        float y[8];
#pragma unroll
        for (int i = 0; i < 4; ++i) {
            const unsigned a0 = u0[i], a1 = u1[i], a2 = u2[i], bzz = bz[i];
            y[2 * i]     = bf_lo(bzz) * (w0[2 * i] * bf_lo(a2) + w1[2 * i] * bf_lo(a1) + w2[2 * i] * bf_lo(a0) + bb[2 * i]);
            y[2 * i + 1] = bf_hi(bzz) * (w0[2 * i + 1] * bf_hi(a2) + w1[2 * i + 1] * bf_hi(a1) + w2[2 * i + 1] * bf_hi(a0) + bb[2 * i + 1]);
        }
        v4u w; w.x = pk2(y[0], y[1]); w.y = pk2(y[2], y[3]); w.z = pk2(y[4], y[5]); w.w = pk2(y[6], y[7]);
        *(v4u*)bp = w;
    }
}
constexpr int CH_KSTR = 576, CH_VSTR = 64, CH_VOFF = 128 * CH_KSTR;
__device__ __forceinline__ void conv_one(int v, const bf16* U, bf16* BZ, const float* cw, const float* cb) {
    const int row = v >> 7, c8 = (v & 127) * 8, t = row & (T - 1);
    const v4u z4 = {0u, 0u, 0u, 0u};
    const v4u u0 = *(const v4u*)(U + (size_t)row * 1024 + c8);
    const v4u u1 = t >= 1 ? *(const v4u*)(U + (size_t)(row - 1) * 1024 + c8) : z4;
    const v4u u2 = t >= 2 ? *(const v4u*)(U + (size_t)(row - 2) * 1024 + c8) : z4;
    bf16* bp = BZ + (size_t)row * 1024 + c8; const v4u bz = *(const v4u*)bp;
    float w0[8], w1[8], w2[8], bb[8];
    *(f32x4*)&w0[0] = *(const f32x4*)(cw + c8); *(f32x4*)&w0[4] = *(const f32x4*)(cw + c8 + 4);
    *(f32x4*)&w1[0] = *(const f32x4*)(cw + 1024 + c8); *(f32x4*)&w1[4] = *(const f32x4*)(cw + 1024 + c8 + 4);
    *(f32x4*)&w2[0] = *(const f32x4*)(cw + 2048 + c8); *(f32x4*)&w2[4] = *(const f32x4*)(cw + 2048 + c8 + 4);
    *(f32x4*)&bb[0] = *(const f32x4*)(cb + c8); *(f32x4*)&bb[4] = *(const f32x4*)(cb + c8 + 4);
    float y[8];
#pragma unroll
    for (int i = 0; i < 4; ++i) {
        const unsigned a0 = u0[i], a1 = u1[i], a2 = u2[i], bzz = bz[i];
        y[2 * i]     = bf_lo(bzz) * (w0[2 * i] * bf_lo(a2) + w1[2 * i] * bf_lo(a1) + w2[2 * i] * bf_lo(a0) + bb[2 * i]);
        y[2 * i + 1] = bf_hi(bzz) * (w0[2 * i + 1] * bf_hi(a2) + w1[2 * i + 1] * bf_hi(a1) + w2[2 * i + 1] * bf_hi(a0) + bb[2 * i + 1]);
    }
    v4u w; w.x = pk2(y[0], y[1]); w.y = pk2(y[2], y[3]); w.z = pk2(y[4], y[5]); w.w = pk2(y[6], y[7]);
    *(v4u*)bp = w;
}
template <bool CONV>
__device__ __forceinline__ void chain_item(Frame& F, int bh, int sl, const bf16* KT, const bf16* V, bf16* ST, const bf16* U, bf16* BZ, const float* cw, const float* cb) {
    int tid_ = F.tid; asm volatile("" : "+v"(tid_));
    const int b = bh >> 2, h = bh & 3, tid = tid_, lane = tid & 63, w = __builtin_amdgcn_readfirstlane(tid >> 6);
    const int hl = lane >> 5, l31 = lane & 31, q = (lane & 15) >> 2, p = lane & 3, blk = (lane >> 4) & 1;
    LAS char* Kt = (LAS char*)F.lds; LAS char* Vt = Kt + CH_VOFF;
    const float g512 = exp2f(512.0f * log2_gamma(h));
    const int gt = F.vcu * (NWAVES * 64) + tid, NT = F.G * NWAVES * 64;
    f32x16 S;
#pragma unroll
    for (int i = 0; i < 16; ++i) S[i] = 0.f;
    bf16* STb = ST + (size_t)bh * 8 * 512 * 256 + ((size_t)sl * 32 + l31) * 256 + w * 32 + 4 * hl;
    const bf16* kg = KT + ((size_t)b * T + (tid >> 5)) * 1024 + h * 256 + (tid & 31) * 8;
    const bf16* vg = V + ((size_t)b * T + (tid >> 2)) * 2048 + h * 512 + sl * 32 + (tid & 3) * 8;
    LAS char* kl = Kt + (tid >> 5) * CH_KSTR + (tid & 31) * 16;
    LAS char* vl = Vt + (tid >> 2) * CH_VSTR + (tid & 3) * 16;
    v4u kra[8], vra, krb[8], vrb;
#pragma unroll
    for (int i = 0; i < 8; ++i) kra[i] = *(const v4u*)(kg + (size_t)i * 16 * 1024);
    vra = *(const v4u*)vg;
#pragma unroll
    for (int i = 0; i < 8; ++i) krb[i] = *(const v4u*)(kg + (size_t)128 * 1024 + (size_t)i * 16 * 1024);
    vrb = *(const v4u*)(vg + (size_t)128 * 2048);
#pragma unroll
    for (int g = 0; g < 4; ++g) { v2u w2; w2.x = 0u; w2.y = 0u; *(v2u*)(STb + 8 * g) = w2; }
    const int crow0 = gt >> 7, c8 = (gt & 127) * 8;
    float w0[8], w1[8], w2c[8], bb[8]; v4u cu0 = {0u, 0u, 0u, 0u}, cu1 = cu0, cu2 = cu0, cbz = cu0;
    if (CONV) {
        *(f32x4*)&w0[0] = *(const f32x4*)(cw + c8); *(f32x4*)&w0[4] = *(const f32x4*)(cw + c8 + 4);
        *(f32x4*)&w1[0] = *(const f32x4*)(cw + 1024 + c8); *(f32x4*)&w1[4] = *(const f32x4*)(cw + 1024 + c8 + 4);
        *(f32x4*)&w2c[0] = *(const f32x4*)(cw + 2048 + c8); *(f32x4*)&w2c[4] = *(const f32x4*)(cw + 2048 + c8 + 4);
        *(f32x4*)&bb[0] = *(const f32x4*)(cb + c8); *(f32x4*)&bb[4] = *(const f32x4*)(cb + c8 + 4);
        const int row = crow0, t = row & (T - 1); const v4u z4 = {0u, 0u, 0u, 0u};
        cu0 = *(const v4u*)(U + (size_t)row * 1024 + c8); cu1 = t >= 1 ? *(const v4u*)(U + (size_t)(row - 1) * 1024 + c8) : z4;
        cu2 = t >= 2 ? *(const v4u*)(U + (size_t)(row - 2) * 1024 + c8) : z4; cbz = *(const v4u*)(BZ + (size_t)row * 1024 + c8);
    }
#define CHAIN_STEP(KR, VR, IT) do { const int it = (IT); \
        __syncthreads(); \
        _Pragma("unroll") for (int i = 0; i < 8; ++i) *(LAS v4u*)(kl + i * 16 * CH_KSTR) = KR[i]; \
        *(LAS v4u*)vl = VR; \
        if (it + 2 < 28) { _Pragma("unroll") for (int i = 0; i < 8; ++i) KR[i] = *(const v4u*)(kg + (size_t)(it + 2) * 128 * 1024 + (size_t)i * 16 * 1024); \
            VR = *(const v4u*)(vg + (size_t)(it + 2) * 128 * 2048); } \
        CHAIN_CONV(it); \
        __syncthreads(); \
        _Pragma("unroll") for (int ks = 0; ks < 8; ++ks) { const int kr_ = 16 * ks + 8 * hl + q; \
            const bf16x8 A = trpair(Kt + kr_ * CH_KSTR + 2 * (32 * w + 16 * blk + 4 * p), 4 * CH_KSTR); \
            const bf16x8 B = trpair(Vt + kr_ * CH_VSTR + 2 * (16 * blk + 4 * p), 4 * CH_VSTR); \
            S = MFMA32(A, B, S); } \
        if ((it & 3) == 3) { _Pragma("unroll") for (int i = 0; i < 16; ++i) S[i] *= g512; \
            const int s1 = (it >> 2) + 1; \
            _Pragma("unroll") for (int g = 0; g < 4; ++g) { v2u w2; w2.x = pk2(S[4 * g], S[4 * g + 1]); w2.y = pk2(S[4 * g + 2], S[4 * g + 3]); *(v2u*)(STb + (size_t)s1 * 512 * 256 + 8 * g) = w2; } } \
    } while (0)
    auto chain_conv = [&](int it) {
        if (CONV && it < 16) {
            float y[8];
#pragma unroll
            for (int i = 0; i < 4; ++i) {
                const unsigned a0 = cu0[i], a1 = cu1[i], a2 = cu2[i], bzz = cbz[i];
                y[2 * i]     = bf_lo(bzz) * (w0[2 * i] * bf_lo(a2) + w1[2 * i] * bf_lo(a1) + w2c[2 * i] * bf_lo(a0) + bb[2 * i]);
                y[2 * i + 1] = bf_hi(bzz) * (w0[2 * i + 1] * bf_hi(a2) + w1[2 * i + 1] * bf_hi(a1) + w2c[2 * i + 1] * bf_hi(a0) + bb[2 * i + 1]);
            }
            v4u wy; wy.x = pk2(y[0], y[1]); wy.y = pk2(y[2], y[3]); wy.z = pk2(y[4], y[5]); wy.w = pk2(y[6], y[7]);
            *(v4u*)(BZ + (size_t)(crow0 + 1024 * it) * 1024 + c8) = wy;
            if (it + 1 < 16) { const int row = crow0 + 1024 * (it + 1), t = row & (T - 1); const v4u z4 = {0u, 0u, 0u, 0u};
                cu0 = *(const v4u*)(U + (size_t)row * 1024 + c8); cu1 = t >= 1 ? *(const v4u*)(U + (size_t)(row - 1) * 1024 + c8) : z4;
                cu2 = t >= 2 ? *(const v4u*)(U + (size_t)(row - 2) * 1024 + c8) : z4; cbz = *(const v4u*)(BZ + (size_t)row * 1024 + c8); }
        }
    };
#define CHAIN_CONV(it) chain_conv(it)
#pragma unroll 1
    for (int it2 = 0; it2 < 28; it2 += 2) { CHAIN_STEP(kra, vra, it2); CHAIN_STEP(krb, vrb, it2 + 1); }
#undef CHAIN_STEP
#undef CHAIN_CONV
}
constexpr int AP_STR = 528, AP_VSTR = 1088, AP_KOFF = 128 * AP_STR, AP_VOFF = AP_KOFF + 32 * AP_STR, AP_SOFF = AP_KOFF, AP_RED = 8 * 32 * AP_STR;
static_assert(AP_VOFF + 32 * AP_VSTR <= RING_BYTES && AP_SOFF + 64 * AP_STR <= RING_BYTES && AP_RED + 1024 <= RING_BYTES, "apply LDS map");
__device__ __forceinline__ void apply_item(Frame& F, int bh, int r, const bf16* QT, const bf16* KT, const bf16* V, const bf16* ST, bf16* O, float* ssq) {
    int tid_ = F.tid; asm volatile("" : "+v"(tid_));
    const int b = bh >> 2, h = bh & 3, tid = tid_, lane = tid & 63, w = __builtin_amdgcn_readfirstlane(tid >> 6);
    const int hl = lane >> 5, l31 = lane & 31, q = (lane & 15) >> 2, p = lane & 3, blk = (lane >> 4) & 1;
    const int ig = w & 3, dh = w >> 2, s = r >> 2, t0 = r * 128;
    LAS char* Qs = (LAS char*)F.lds; LAS char* Ks = Qs + AP_KOFF; LAS char* Vs = Qs + AP_VOFF; LAS char* Ss = Qs + AP_SOFF; LAS float* red = (LAS float*)(Qs + AP_RED);
    f32x16 acc[8];
#pragma unroll
    for (int mt = 0; mt < 8; ++mt)
#pragma unroll
        for (int i = 0; i < 16; ++i) acc[mt][i] = 0.f;
    const int ntile = 4 * (r - 4 * s + 1), dtile0 = 4 * (r - 4 * s);
    const size_t key0 = (size_t)b * T + s * 512;
    const bf16* kg = KT + (key0 + (tid >> 5)) * 1024 + h * 256 + (tid & 31) * 8;
    const bf16* vg = V + (key0 + (tid >> 6)) * 2048 + h * 512 + (tid & 63) * 8;
    LAS char* kl = Ks + (tid >> 5) * AP_STR + (tid & 31) * 16;
    LAS char* vl = Vs + (tid >> 6) * AP_VSTR + (tid & 63) * 16;
    v4u kr[2], vr[4];
#pragma unroll
    for (int i = 0; i < 2; ++i) kr[i] = *(const v4u*)(kg + (size_t)i * 16 * 1024);
#pragma unroll
    for (int i = 0; i < 4; ++i) vr[i] = *(const v4u*)(vg + (size_t)i * 8 * 2048);
    __syncthreads();
    {
        const bf16* qg = QT + ((size_t)b * T + t0 + (tid >> 5)) * 1024 + h * 256 + (tid & 31) * 8;
        v4u qr[8];
#pragma unroll
        for (int i = 0; i < 8; ++i) qr[i] = *(const v4u*)(qg + (size_t)i * 16 * 1024);
#pragma unroll
        for (int i = 0; i < 8; ++i) *(LAS v4u*)(Qs + ((tid >> 5) + 16 * i) * AP_STR + (tid & 31) * 16) = qr[i];
    }
    const LAS char* qb = Qs + (32 * ig + l31) * AP_STR + 16 * hl;
    const LAS char* ka = Ks + l31 * AP_STR + 16 * hl;
    const LAS char* vb = Vs + (4 * hl + q) * AP_VSTR + 2 * (256 * dh + 16 * blk + 4 * p);
#pragma unroll 1
    for (int tl = 0; tl < ntile; ++tl) {
        __syncthreads();
#pragma unroll
        for (int i = 0; i < 2; ++i) *(LAS v4u*)(kl + i * 16 * AP_STR) = kr[i];
#pragma unroll
        for (int i = 0; i < 4; ++i) *(LAS v4u*)(vl + i * 8 * AP_VSTR) = vr[i];
        if (tl + 1 < ntile) {
#pragma unroll
            for (int i = 0; i < 2; ++i) kr[i] = *(const v4u*)(kg + (size_t)(tl + 1) * 32 * 1024 + (size_t)i * 16 * 1024);
#pragma unroll
            for (int i = 0; i < 4; ++i) vr[i] = *(const v4u*)(vg + (size_t)(tl + 1) * 32 * 2048 + (size_t)i * 8 * 2048);
        }
        __syncthreads();
        const int kt = tl - dtile0;
        if (kt > ig) continue;
        f32x16 X;
#pragma unroll
        for (int i = 0; i < 16; ++i) X[i] = 0.f;
#pragma unroll
        for (int ks = 0; ks < 16; ++ks) {
            const bf16x8 A = *(const LAS bf16x8*)(ka + 32 * ks);
            const bf16x8 B = *(const LAS bf16x8*)(qb + 32 * ks);
            X = MFMA32(A, B, X);
        }
        if (kt == ig) {
#pragma unroll
            for (int i = 0; i < 16; ++i) if (crow(i, hl) > l31) X[i] = 0.f;
        }
        v4u p0, p1;
        p0.x = pk2(X[0], X[1]); p0.y = pk2(X[2], X[3]); p0.z = pk2(X[4], X[5]); p0.w = pk2(X[6], X[7]);
        p1.x = pk2(X[8], X[9]); p1.y = pk2(X[10], X[11]); p1.z = pk2(X[12], X[13]); p1.w = pk2(X[14], X[15]);
        const bf16x8 P0 = __builtin_bit_cast(bf16x8, p0), P1 = __builtin_bit_cast(bf16x8, p1);
#pragma unroll
        for (int mt = 0; mt < 8; ++mt) {
            const bf16x8 A0 = trpair(vb + 64 * mt, 8 * AP_VSTR);
            const bf16x8 A1 = trpair(vb + 64 * mt + 16 * AP_VSTR, 8 * AP_VSTR);
            acc[mt] = MFMA32(A0, P0, acc[mt]);
            acc[mt] = MFMA32(A1, P1, acc[mt]);
        }
    }
    {
        const bf16* sg = ST + (size_t)(bh * 8 + s) * 512 * 256;
        const int srow = tid >> 5, sc = tid & 31;
        v4u sr[4];
#pragma unroll
        for (int i = 0; i < 4; ++i) { const int rho = srow + 16 * i; sr[i] = *(const v4u*)(sg + ((size_t)(256 * (rho >> 5) + (rho & 31))) * 256 + sc * 8); }
        const LAS char* sa = Ss + (32 * dh + l31) * AP_STR + 16 * hl;
#pragma unroll
        for (int mt = 0; mt < 8; ++mt) {
            __syncthreads();
#pragma unroll
            for (int i = 0; i < 4; ++i) *(LAS v4u*)(Ss + (srow + 16 * i) * AP_STR + sc * 16) = sr[i];
            if (mt + 1 < 8) {
#pragma unroll
                for (int i = 0; i < 4; ++i) { const int rho = srow + 16 * i; sr[i] = *(const v4u*)(sg + ((size_t)(256 * (rho >> 5) + 32 * (mt + 1) + (rho & 31))) * 256 + sc * 8); }
            }
            __syncthreads();
#pragma unroll
            for (int ks = 0; ks < 16; ++ks) {
                const bf16x8 A = *(const LAS bf16x8*)(sa + 32 * ks);
                const bf16x8 B = *(const LAS bf16x8*)(qb + 32 * ks);
                acc[mt] = MFMA32(A, B, acc[mt]);
            }
        }
    }
    float ss = 0.f;
#pragma unroll
    for (int mt = 0; mt < 8; ++mt)
#pragma unroll
        for (int i = 0; i < 16; ++i) ss += acc[mt][i] * acc[mt][i];
    ss += __shfl_xor(ss, 32);
    __syncthreads();
    if (hl == 0) red[dh * 128 + 32 * ig + l31] = ss;
    LAS char* Tw = Qs + w * (32 * AP_STR);
#pragma unroll
    for (int mt = 0; mt < 8; ++mt)
#pragma unroll
        for (int g = 0; g < 4; ++g) { v2u w2; w2.x = pk2(acc[mt][4 * g], acc[mt][4 * g + 1]); w2.y = pk2(acc[mt][4 * g + 2], acc[mt][4 * g + 3]);
            *(LAS v2u*)(Tw + l31 * AP_STR + (32 * mt + 8 * g + 4 * hl) * 2) = w2; }
    __syncthreads();
    bf16* og = O + ((size_t)b * T + t0 + 32 * ig) * 2048 + h * 512 + 256 * dh;
#pragma unroll
    for (int i = 0; i < 16; ++i) { const int id = lane + 64 * i, row = id >> 5, c = id & 31;
        const v4u x = *(const LAS v4u*)(Tw + row * AP_STR + c * 16); *(v4u*)(og + (size_t)row * 2048 + c * 8) = x; }
    if (tid < 128) ssq[((size_t)b * T + t0 + tid) * 4 + h] = red[tid] + red[128 + tid];
}
#ifndef TS_PH
#define TS_PH -1
#endif
struct Args { const float* in[9]; float* out; unsigned char* ws; int ph_lo, ph_hi, li, pad; };
__global__ void __launch_bounds__(NWAVES * 64, 2) fwd_kernel(Args args) {
    extern __shared__ __attribute__((aligned(16))) unsigned char lds[];
    Frame F;
    F.lds = (LAS unsigned char*)lds; F.MISC = (volatile LAS unsigned*)(F.lds + MISC_OFF);
    F.tid = threadIdx.x; F.lane = F.tid & 63; F.wave = __builtin_amdgcn_readfirstlane(F.tid >> 6);
    F.G = gridDim.x; { const int bx = blockIdx.x; F.vcu = (F.G % 8 == 0) ? (bx % 8) * (F.G / 8) + bx / 8 : bx; }
    F.ws = args.ws; F.ctl = (gu32*)(args.ws + WS_CTL); F.out = args.out;
#pragma unroll
    for (int i = 0; i < 9; ++i) F.in[i] = args.in[i];
    for (int u = F.tid; u < (LDS_BYTES - LDSCTL_OFF) / 4; u += NWAVES * 64) ((LAS unsigned*)(F.lds + LDSCTL_OFF))[u] = 0u;
    __syncthreads();
    XcdBarrier bar; bar.bar = (unsigned*)(F.ctl + CW_BAR); bar.x = 0; bar.st = nullptr;
    if (N_LAUNCHES == 1) bar = xcd_barrier_post((unsigned*)(F.ctl + CW_BAR), F.MISC + 8);
    const int lo = args.ph_lo, hi = args.ph_hi;
    if (TS_PH >= 0 && blockIdx.x == 0 && F.tid == 0) F.MISC[16] = (unsigned)__builtin_amdgcn_s_memrealtime();
#define IN(k) (lo <= (k) && (k) < hi)
#define STAMP(i) do { if (TS_PH >= 0 && blockIdx.x == 0 && F.tid == 0) F.MISC[16 + (i)] = (unsigned)__builtin_amdgcn_s_memrealtime(); } while (0)
#define SEAM(k) do { if (IN(k) && IN((k) + 1)) xcd_barrier(bar); STAMP((k) + 1); } while (0)
#ifndef REP_PH
#define REP_PH -1
#endif
#define REPEAT(k) for (int rep = 0, nrep = (l == 0 && REP_PH == (k)) ? 2 : 1; rep < nrep; ++rep)
#define REPBAR() do { if (rep) xcd_barrier(bar); } while (0)
#define PHASE_PTRS() unsigned long long z0_ = 0ull; asm volatile("" : "+s"(z0_)); unsigned char* ws = args.ws + z0_; \
    Frame P = F; { int t_ = threadIdx.x; asm volatile("" : "+v"(t_)); P.tid = t_; P.lane = t_ & 63; P.wave = __builtin_amdgcn_readfirstlane(t_ >> 6); } \
    float* cosT = (float*)(ws + WS_COS); float* sinT = (float*)(ws + WS_SIN); float* rstd = (float*)(ws + WS_RSTD); float* ssq = (float*)(ws + WS_SSQ); \
    bf16* XB = (bf16*)(ws + WS_XB); bf16* U = (bf16*)(ws + WS_U); bf16* BZ = (bf16*)(ws + WS_BZ); bf16* QT = (bf16*)(ws + WS_QT); bf16* KT = (bf16*)(ws + WS_KT); \
    bf16* V = (bf16*)(ws + WS_V); bf16* O = (bf16*)(ws + WS_O); bf16* SG = (bf16*)(ws + WS_SG); float* YAG = (float*)(ws + WS_YAG); bf16* MG = (bf16*)(ws + WS_MG); \
    unsigned char* RW = ws + ((l & 1) ? WS_R2 : WS_R1); unsigned char* RS = ws + ((l & 1) ? WS_R1 : WS_R2); bf16* ST = (bf16*)RS; \
    (void)cosT; (void)sinT; (void)rstd; (void)ssq; (void)XB; (void)U; (void)BZ; (void)QT; (void)KT; (void)V; (void)O; (void)SG; (void)YAG; (void)MG; (void)RW; (void)RS; (void)ST

    if (IN(0)) { const int l = 0; REPEAT(7) {
        REPBAR(); PHASE_PTRS();
        convert_layer(P, 0, ws + WS_R1);
        rotary_tables(P, cosT, sinT);
        rownorm(P, args.in[0], XB, rstd);
    } }
    SEAM(0);
#if REP_PH == 8
    for (int xb = 0; xb < 20; ++xb) xcd_barrier(bar);
#endif
#pragma unroll 1
    for (int l = 0; l < DEPTH; ++l) {
        const int pb = 1 + 7 * l;
        if (IN(pb + 0)) REPEAT(0) {
            REPBAR(); PHASE_PTRS();
            pg8::Gemm g{XB, (const bf16*)(RW + RW_IN), M, NA, D}; pg8::StaticOrder S; S.init(M, NA, F.G, (int)blockIdx.x);
            EpiA E{rstd, cosT, sinT, U, BZ, QT, KT, V};
            pg8::gemm_phase<EpiA, pg8::StaticOrder, true, true>(F.lds, g, S, E);
        }
        SEAM(pb + 0);
        if (IN(pb + 1)) REPEAT(1) {
            REPBAR(); PHASE_PTRS();
            const float* cw = args.in[3] + (size_t)l * 3 * D; const float* cb = args.in[4] + (size_t)l * D;
            if (F.G == 256 && nrep == 1) chain_item<true>(P, F.vcu >> 4, F.vcu & 15, KT, V, ST, U, BZ, cw, cb);
            else { for (int it = F.vcu; it < 256; it += F.G) chain_item<false>(P, it >> 4, it & 15, KT, V, ST, U, BZ, cw, cb);
                   if (rep == nrep - 1) conv_pass(P, U, BZ, cw, cb); }
        }
        SEAM(pb + 1);
        if (IN(pb + 2)) REPEAT(2) {
            REPBAR(); PHASE_PTRS();
            for (int pr = F.vcu; pr < 256; pr += F.G) {
                const int bh = pr >> 4, pi = pr & 15, s = pi >> 1;
                const int ra = (pi & 1) ? 4 * s + 1 : 4 * s + 0, rb = (pi & 1) ? 4 * s + 2 : 4 * s + 3;
#pragma unroll 1
                for (int k = 0; k < 2; ++k) apply_item(P, bh, k == 0 ? rb : ra, QT, KT, V, ST, O, ssq);
            }
        }
        SEAM(pb + 2);
        if (IN(pb + 3)) REPEAT(3) {
            REPBAR(); PHASE_PTRS();
            if (l + 1 < DEPTH && rep == nrep - 1) { convert_layer(P, l + 1, RS); __syncthreads(); }
            pg8::Gemm g{XB, (const bf16*)(RW + RW_IN) + (size_t)NA * D, M, NB, D}; pg8::StaticOrder S; S.init(M, NB, F.G, (int)blockIdx.x);
            EpiB E{rstd, ssq, O, (rep == nrep - 1) ? O : (bf16*)args.out, SG};
            pg8::gemm_phase<EpiB, pg8::StaticOrder, true, true>(F.lds, g, S, E);
        }
        SEAM(pb + 3);
        if (IN(pb + 4)) REPEAT(4) {
            REPBAR(); PHASE_PTRS();
            { pg8::Gemm g{BZ, (const bf16*)(RW + RW_A), M, D, D}; pg8::StaticOrder S; S.init(M, D, F.G, (int)blockIdx.x);
              EpiYA E{SG, YAG}; pg8::gemm_phase<EpiYA, pg8::StaticOrder, false, true>(F.lds, g, S, E); }
            asm volatile("s_waitcnt vmcnt(0)" ::: "memory"); __syncthreads();
            { pg8::Gemm g{O, (const bf16*)(RW + RW_B), M, D, 2 * D}; pg8::StaticOrder S; S.init(M, D, F.G, (int)blockIdx.x);
              EpiMG E{SG, YAG, MG}; pg8::gemm_phase<EpiMG, pg8::StaticOrder, false, true>(F.lds, g, S, E); }
        }
        SEAM(pb + 4);
        if (IN(pb + 5)) REPEAT(5) {
            REPBAR(); PHASE_PTRS();
            pg8::Gemm g{MG, (const bf16*)(RW + RW_O), M, D, D}; pg8::StaticOrder S; S.init(M, D, F.G, (int)blockIdx.x);
            EpiRes E{(l == 0) ? args.in[0] : (const float*)args.out, args.out}; pg8::gemm_phase<EpiRes, pg8::StaticOrder, false, true>(F.lds, g, S, E);
        }
        SEAM(pb + 5);
        if (IN(pb + 6)) REPEAT(6) {
            REPBAR(); PHASE_PTRS();
            if (l + 1 < DEPTH) rownorm(P, args.out, XB, rstd);
            else final_norm(P, args.out, args.in[8]);
        }
        if (l + 1 < DEPTH) SEAM(pb + 6);
    }
    STAMP(NPHASES);
    if (TS_PH >= 0 && blockIdx.x == 0 && F.tid == 0) { const unsigned d = F.MISC[17 + TS_PH] - F.MISC[16 + TS_PH]; const unsigned long long t0 = __builtin_amdgcn_s_memrealtime();
        while (__builtin_amdgcn_s_memrealtime() - t0 < 4ull * d) __builtin_amdgcn_s_sleep(8); }
#undef IN
#undef SEAM
}

extern "C" void kernel_launch(void* const* d_in, const int* in_sizes, int n_in, void* d_out, int out_size, void* d_ws, size_t ws_size, hipStream_t stream) {
    static int grid = 0;
    if (grid == 0) {
        if (n_in != 9 || in_sizes[0] != M * D || out_size != M * D || ws_size < WS_END) {
            fprintf(stderr, "kernel_launch: unexpected problem (n_in %d, in0 %d, out %d, ws %zu; need ws >= %zu); nothing launched\n", n_in, n_in > 0 ? in_sizes[0] : -1, out_size, ws_size, (size_t)WS_END); grid = -1; return; }
        int dev = 0, cus = 0, per_cu = 0;
        if (hipGetDevice(&dev) != hipSuccess || hipDeviceGetAttribute(&cus, hipDeviceAttributeMultiprocessorCount, dev) != hipSuccess) { grid = -1; return; }
        if (hipFuncSetAttribute((const void*)fwd_kernel, hipFuncAttributeMaxDynamicSharedMemorySize, LDS_BYTES) != hipSuccess) { fprintf(stderr, "kernel_launch: hipFuncSetAttribute failed\n"); grid = -1; return; }
        if (hipOccupancyMaxActiveBlocksPerMultiprocessor(&per_cu, (const void*)fwd_kernel, NWAVES * 64, LDS_BYTES) != hipSuccess || per_cu < 1) { fprintf(stderr, "kernel_launch: occupancy query says %d blocks per CU; nothing launched\n", per_cu); (void)hipGetLastError(); grid = -1; return; }
        grid = cus;
    }
    if (grid < 0) return;
    if (hipMemsetAsync((char*)d_ws + WS_CTL, 0, CTL_ZERO_BYTES, stream) != hipSuccess) return;
    Args a{};
    for (int i = 0; i < 9; ++i) a.in[i] = (const float*)d_in[i];
    a.out = (float*)d_out; a.ws = (unsigned char*)d_ws;
    if (N_LAUNCHES == 1) {
        a.ph_lo = 0; a.ph_hi = NPHASES; a.li = 0;
        hipLaunchKernelGGL(fwd_kernel, dim3(grid), dim3(NWAVES * 64), LDS_BYTES, stream, a);
    } else {
        for (int li = 0; li < NPHASES; ++li) { a.ph_lo = li; a.ph_hi = li + 1; a.li = li; hipLaunchKernelGGL(fwd_kernel, dim3(grid), dim3(NWAVES * 64), LDS_BYTES, stream, a); }
    }
}
```

```cpp
#include <hip/hip_runtime.h>
#include <cstdio>
#include <cstdint>
namespace pg8 {
#define PG8_LAS __attribute__((address_space(3)))
typedef unsigned short bf16_t;
typedef short bf16x8 __attribute__((ext_vector_type(8)));
typedef float f32x4 __attribute__((ext_vector_type(4)));
typedef unsigned u32x4 __attribute__((ext_vector_type(4)));
constexpr int BM = 256, BK = 64, HALF = 128, HTB = HALF * BK * 2  , STAGE_BYTES = 8 * HTB, NXCD = 8, WGM = 8;

__host__ __device__ __forceinline__ int lds_byte(int r, int c) { const int st = (r >> 4) * 2 + (c >> 5), rr = r & 15, cc = c & 31, ob = rr * 64 + cc * 2; return st * 1024 + (ob ^ (((ob >> 9) & 1) << 5)); }
__host__ __device__ __forceinline__ void stage_rc(int b, int& R, int& C) { const int st = b / 1024, sb = b % 1024, swz = sb ^ (((sb >> 9) & 1) << 5); R = (st >> 1) * 16 + swz / 64; C = (st & 1) * 32 + (swz % 64) / 2; }
__host__ __device__ __forceinline__ int perm32(int rho) { const int n = rho >> 4, i = rho & 15; return 8 * (i >> 2) + 4 * n + (i & 3); }

struct Unit { int pm, pn; };
struct Gemm { const bf16_t* A; const bf16_t* Bt; int M, N, K; };

struct StaticOrder {
    int nM, nN, nwg, G, c;
    __host__ __device__ void init(int M, int N, int G_, int c_) { nM = M / BM; nN = N / BM; nwg = nM * nN; G = G_; c = c_; }
    __host__ __device__ bool next(int i, Unit& u) const {
        const long L = (long)i * G + c; if (L >= nwg) return false;
        int wgid = (int)L; { const int q = nwg / NXCD, r = nwg % NXCD, xcd = wgid % NXCD, off = wgid / NXCD; wgid = (xcd < r ? xcd * (q + 1) : r * (q + 1) + (xcd - r) * q) + off; }
        const int nig = WGM * nN, gid = wgid / nig, fm = gid * WGM, gsz = (nM - fm) < WGM ? (nM - fm) : WGM;
        u.pm = fm + ((wgid % nig) % gsz); u.pn = (wgid % nig) / gsz; return true;
    }
    __device__ __forceinline__ void a_ready(const Unit&) const {}
    __device__ __forceinline__ void done(const Unit&) const {}
};
__device__ __forceinline__ unsigned cvt_pk_bf16(float lo, float hi) { unsigned r; asm volatile("v_cvt_pk_bf16_f32 %0, %1, %2" : "=v"(r) : "v"(lo), "v"(hi)); return r; }
template <class Epi, class Sched, bool ALIGN_EPI = false, bool SP2 = false>
__device__ __forceinline__ void gemm_phase(PG8_LAS unsigned char* lds, const Gemm g, const Sched& S, const Epi& E) {
    int tid_ = threadIdx.x; asm volatile("" : "+v"(tid_));
    const int tid = tid_, wid = __builtin_amdgcn_readfirstlane(tid >> 6), lane = tid & 63, wr = wid >> 2, wc = wid & 3, fr = lane & 15, fq = lane >> 4;
    const int K = g.K, nt = K / BK;
    unsigned voffA[2], voffB[2];
#pragma unroll
    for (int i = 0; i < 2; ++i) { int R, C; stage_rc(tid * 16 + i * 8192, R, C); const int Rb = Epi::PERM ? ((R & ~31) + perm32(R & 31)) : R;
        voffA[i] = (unsigned)(R * K + C) * 2u; voffB[i] = (unsigned)(Rb * K + C) * 2u; }
    const size_t kstep = (size_t)(BK * 2);
    const size_t hstep = (size_t)HALF * K * 2;
    const size_t tstep = 2 * hstep;
    const unsigned ldsw = (unsigned)wid * 1024u;
    const int aoff = lds_byte(wr * 64 + fr, fq * 8), boff = lds_byte(wc * 32 + fr, fq * 8);
#define PG8_SA(b, h) (((b) * 2 + (h)) * HTB)
#define PG8_SB(b, h) ((4 + (b) * 2 + (h)) * HTB)
#define PG8_STAGE(bufoff, gbase, voff) do { _Pragma("unroll") for (int _i = 0; _i < 2; ++_i) \
        __builtin_amdgcn_global_load_lds((const unsigned*)((const char*)(gbase) + (voff)[_i]), (PG8_LAS unsigned*)(lds + (bufoff) + ldsw + _i * 8192), 16, 0, 0); } while (0)
#define PG8_LDA(dst, b, h) do { _Pragma("unroll") for (int m = 0; m < 4; ++m) _Pragma("unroll") for (int k = 0; k < 2; ++k) dst[m][k] = *(const PG8_LAS bf16x8*)(lds + PG8_SA(b, h) + aoff + m * 2048 + k * 1024); } while (0)
#define PG8_LDB(dst, b, h) do { _Pragma("unroll") for (int n = 0; n < 2; ++n) _Pragma("unroll") for (int k = 0; k < 2; ++k) dst[n][k] = *(const PG8_LAS bf16x8*)(lds + PG8_SB(b, h) + boff + n * 2048 + k * 1024); } while (0)
#define PG8_MMA(ai, bj, At, Bt) do { __builtin_amdgcn_s_setprio(1); _Pragma("unroll") for (int m = 0; m < 4; ++m) _Pragma("unroll") for (int n = 0; n < 2; ++n) _Pragma("unroll") for (int k = 0; k < 2; ++k) \
        acc[ai][bj][m][n] = __builtin_amdgcn_mfma_f32_16x16x32_bf16(Bt[n][k], At[m][k], acc[ai][bj][m][n], 0, 0, 0); __builtin_amdgcn_s_setprio(0); } while (0)
#define PG8_WAIT_V(n) asm volatile("s_waitcnt vmcnt(" #n ")" ::: "memory")
#define PG8_WAIT_L(n) asm volatile("s_waitcnt lgkmcnt(" #n ")" ::: "memory")
#define PG8_BAR __builtin_amdgcn_s_barrier()
#define PG8_SCHED __builtin_amdgcn_sched_barrier(0)
    Unit cur, nxt; int ui = 0;
    if (!S.next(0, cur)) return;
    f32x4 acc[2][2][4][2];
#pragma unroll
    for (int a = 0; a < 2; ++a)
#pragma unroll
        for (int b = 0; b < 2; ++b)
#pragma unroll
            for (int m = 0; m < 4; ++m)
#pragma unroll
                for (int n = 0; n < 2; ++n) acc[a][b][m][n] = (f32x4){0.f, 0.f, 0.f, 0.f};
    bf16x8 At[4][2], B0[2][2], B1[2][2];
    const char* cA = (const char*)g.A + (size_t)cur.pm * tstep; const char* cB = (const char*)g.Bt + (size_t)cur.pn * tstep;
    S.a_ready(cur);
    if constexpr (SP2) {
        PG8_STAGE(PG8_SB(0, 0), cB, voffB); PG8_STAGE(PG8_SB(0, 1), cB + hstep, voffB); PG8_STAGE(PG8_SA(0, 0), cA, voffA); PG8_STAGE(PG8_SA(0, 1), cA + hstep, voffA);
        if (wr == 1) PG8_BAR;
        PG8_WAIT_V(2); PG8_BAR;
        PG8_STAGE(PG8_SB(1, 0), cB + kstep, voffB); PG8_STAGE(PG8_SA(1, 0), cA + kstep, voffA); PG8_STAGE(PG8_SB(1, 1), cB + hstep + kstep, voffB);
        PG8_WAIT_V(6); PG8_BAR;
    } else {
        PG8_STAGE(PG8_SB(0, 0), cB, voffB); PG8_STAGE(PG8_SA(0, 0), cA, voffA); PG8_STAGE(PG8_SB(0, 1), cB + hstep, voffB); PG8_STAGE(PG8_SA(0, 1), cA + hstep, voffA);
        if (wr == 1) PG8_BAR;
        PG8_WAIT_V(4); PG8_BAR;
        PG8_STAGE(PG8_SB(1, 0), cB + kstep, voffB); PG8_STAGE(PG8_SA(1, 0), cA + kstep, voffA); PG8_STAGE(PG8_SB(1, 1), cB + hstep + kstep, voffB);
        PG8_WAIT_V(6); PG8_BAR;
    }
    for (;;) {
        const bool has_next = S.next(ui + 1, nxt);
        const char* nA = has_next ? (const char*)g.A + (size_t)nxt.pm * tstep : cA; const char* nB = has_next ? (const char*)g.Bt + (size_t)nxt.pn * tstep : cB;
        for (int t = 0; t < nt; t += 2) {
            const bool last = (t == nt - 2);
            const char* a1 = cA + (size_t)(t + 1) * kstep;
            const char* a2 = last ? nA : cA + (size_t)(t + 2) * kstep; const char* b2 = last ? nB : cB + (size_t)(t + 2) * kstep;
            const char* a3 = a2 + kstep; const char* b3 = b2 + kstep;
            if (last && has_next) S.a_ready(nxt);
            if constexpr (Epi::MID_T >= 0) { if (t == Epi::MID_T) E.mid(acc, cur, wr, wc, fr, fq); }
            if constexpr (SP2) {
            PG8_LDB(B0, 0, 0); PG8_LDB(B1, 0, 1); PG8_SCHED; PG8_LDA(At, 0, 0); PG8_STAGE(PG8_SA(1, 1), a1 + hstep, voffA);
            PG8_WAIT_V(8); PG8_WAIT_L(0); PG8_BAR; PG8_MMA(0, 0, At, B0); PG8_MMA(0, 1, At, B1); PG8_BAR; PG8_SCHED;
            PG8_LDA(At, 0, 1); PG8_STAGE(PG8_SB(0, 0), b2, voffB); PG8_STAGE(PG8_SB(0, 1), b2 + hstep, voffB); PG8_STAGE(PG8_SA(0, 0), a2, voffA);
            PG8_WAIT_V(8); PG8_WAIT_L(0); PG8_BAR; PG8_MMA(1, 0, At, B0); PG8_MMA(1, 1, At, B1); PG8_BAR; PG8_SCHED;
            PG8_LDB(B0, 1, 0); PG8_LDB(B1, 1, 1); PG8_SCHED; PG8_LDA(At, 1, 0); PG8_STAGE(PG8_SA(0, 1), a2 + hstep, voffA);
            PG8_WAIT_V(8); PG8_WAIT_L(0); PG8_BAR; PG8_MMA(0, 0, At, B0); PG8_MMA(0, 1, At, B1); PG8_BAR; PG8_SCHED;
            PG8_LDA(At, 1, 1); PG8_STAGE(PG8_SB(1, 0), b3, voffB); PG8_STAGE(PG8_SB(1, 1), b3 + hstep, voffB); PG8_STAGE(PG8_SA(1, 0), a3, voffA);
            PG8_WAIT_V(8); PG8_WAIT_L(0); PG8_BAR; PG8_MMA(1, 0, At, B0); PG8_MMA(1, 1, At, B1); PG8_BAR; PG8_SCHED;
            } else {
            PG8_LDB(B0, 0, 0); PG8_SCHED; PG8_LDA(At, 0, 0); PG8_STAGE(PG8_SA(1, 1), a1 + hstep, voffA);
            PG8_WAIT_L(8); PG8_BAR; PG8_WAIT_L(0); PG8_MMA(0, 0, At, B0); PG8_BAR; PG8_SCHED;
            PG8_LDB(B1, 0, 1); PG8_STAGE(PG8_SB(0, 0), b2, voffB);
            PG8_BAR; PG8_WAIT_L(0); PG8_MMA(0, 1, At, B1); PG8_BAR;
            PG8_LDA(At, 0, 1); PG8_STAGE(PG8_SA(0, 0), a2, voffA);
            PG8_BAR; PG8_WAIT_L(0); PG8_MMA(1, 0, At, B0); PG8_BAR; PG8_SCHED;
            PG8_STAGE(PG8_SB(0, 1), b2 + hstep, voffB);
            PG8_WAIT_V(6); PG8_BAR; PG8_MMA(1, 1, At, B1); PG8_BAR;
            PG8_LDB(B0, 1, 0); PG8_SCHED; PG8_LDA(At, 1, 0); PG8_STAGE(PG8_SA(0, 1), a2 + hstep, voffA);
            PG8_WAIT_L(8); PG8_BAR; PG8_WAIT_L(0); PG8_MMA(0, 0, At, B0); PG8_BAR; PG8_SCHED;
            PG8_LDB(B1, 1, 1); PG8_STAGE(PG8_SB(1, 0), b3, voffB);
            PG8_BAR; PG8_WAIT_L(0); PG8_MMA(0, 1, At, B1); PG8_BAR;
            PG8_LDA(At, 1, 1); PG8_STAGE(PG8_SA(1, 0), a3, voffA);
            PG8_BAR; PG8_WAIT_L(0); PG8_MMA(1, 0, At, B0); PG8_BAR; PG8_SCHED;
            PG8_STAGE(PG8_SB(1, 1), b3 + hstep, voffB);
            PG8_WAIT_V(6); PG8_BAR; PG8_MMA(1, 1, At, B1); PG8_BAR;
            }
        }
        if constexpr (ALIGN_EPI) { if (wr == 0) PG8_BAR; }
        if constexpr (!Epi::AFTER_DRAIN) { E(acc, cur, wr, wc, fr, fq); S.done(cur); }
        if (!has_next) break;
#pragma unroll
        for (int a = 0; a < 2; ++a)
#pragma unroll
            for (int b = 0; b < 2; ++b)
#pragma unroll
                for (int m = 0; m < 4; ++m)
#pragma unroll
                    for (int n = 0; n < 2; ++n) acc[a][b][m][n] = (f32x4){0.f, 0.f, 0.f, 0.f};
        cur = nxt; cA = nA; cB = nB; ++ui;
        if constexpr (ALIGN_EPI) { if (wr == 1) PG8_BAR; }
    }
    PG8_WAIT_V(0);
    if constexpr (!ALIGN_EPI) { if (wr == 0) PG8_BAR; }
    PG8_BAR;
    if constexpr (Epi::AFTER_DRAIN) { E.fused(acc, cur, wr, wc, fr, fq, lds, wid, lane); S.done(cur); }
#undef PG8_SA
#undef PG8_SB
#undef PG8_STAGE
#undef PG8_LDA
#undef PG8_LDB
#undef PG8_MMA
#undef PG8_WAIT_V
#undef PG8_WAIT_L
#undef PG8_BAR
#undef PG8_SCHED
}
}

constexpr int BATCH = 4, T = 4096, D = 1024, M = BATCH * T, DIN = 12288, DEPTH = 2, NWAVES = 8;
constexpr int NA = 8192, NB = 4096;
constexpr float EPS = 1e-6f;
#ifndef N_LAUNCHES
#define N_LAUNCHES 1
#endif
constexpr int NPHASES = 1 + 7 * DEPTH;

constexpr size_t MiB = 1u << 20;
constexpr size_t WS_CTL = 0, CTL_ZERO_BYTES = 1 * MiB;
constexpr size_t WS_R1 = 1 * MiB, WS_R2 = 326 * MiB;
constexpr size_t RW_IN = 0, RW_AB = 24 * MiB, RW_O = 30 * MiB;
constexpr size_t WS_COS = 33 * MiB, WS_SIN = 35 * MiB;
constexpr size_t WS_RSTD = 37 * MiB, WS_SSQ = 37 * MiB + 65536;
constexpr size_t WS_XB = 38 * MiB;
constexpr size_t WS_U = 70 * MiB;
constexpr size_t WS_AB = 102 * MiB;
constexpr int LDAB = 3072;
constexpr size_t WS_QT = 198 * MiB, WS_KT = 230 * MiB;
constexpr size_t WS_V = 262 * MiB;
constexpr size_t WS_SG = WS_QT;
constexpr size_t WS_MG = WS_U;
constexpr size_t WS_END = 358 * MiB;
constexpr int CW_BAR = 4096;

constexpr int RING_BYTES = 147456, LDSCTL_OFF = RING_BYTES, MISC_OFF = LDSCTL_OFF + 320, LDS_BYTES = RING_BYTES + 1024;

#define GAS __attribute__((address_space(1)))
#define LAS __attribute__((address_space(3)))
typedef unsigned short bf16;
typedef unsigned v4u __attribute__((ext_vector_type(4)));
typedef unsigned v2u __attribute__((ext_vector_type(2)));
typedef float f32x4 __attribute__((ext_vector_type(4)));
typedef float f32x16 __attribute__((ext_vector_type(16)));
typedef short bf16x8 __attribute__((ext_vector_type(8)));
typedef short s16x4 __attribute__((ext_vector_type(4)));
typedef float f32x2_t __attribute__((ext_vector_type(2)));
typedef __bf16 bf16x2_t __attribute__((ext_vector_type(2)));
typedef GAS unsigned gu32;
#define LDS_WAIT() asm volatile("s_waitcnt lgkmcnt(0)" ::: "memory")
#define MFMA32(a, b, c) __builtin_amdgcn_mfma_f32_32x32x16_bf16((a), (b), (c), 0, 0, 0)

__device__ __forceinline__ unsigned pk2(float lo, float hi) { f32x2_t v = {lo, hi}; bf16x2_t b = __builtin_convertvector(v, bf16x2_t); return __builtin_bit_cast(unsigned, b); }
__device__ __forceinline__ float bf_lo(unsigned u) { return __uint_as_float(u << 16); }
__device__ __forceinline__ float bf_hi(unsigned u) { return __uint_as_float(u & 0xffff0000u); }
__device__ __forceinline__ float sigm(float x) { return __builtin_amdgcn_rcpf(1.0f + __expf(-x)); }
__device__ __forceinline__ int crow(int r, int hi) { return (r & 3) + 8 * (r >> 2) + 4 * hi; }
__device__ __forceinline__ float log2_gamma(int h) { return h == 0 ? -0.04580368961312479f : h == 1 ? -0.02272007650008353f : h == 2 ? -0.011315313227834146f : -0.005646563141142063f; }
typedef short v4i16_t __attribute__((ext_vector_type(4)));
__device__ __forceinline__ s16x4 vtr(const LAS char* p) { return __builtin_bit_cast(s16x4, __builtin_amdgcn_ds_read_tr16_b64_v4i16((LAS v4i16_t*)p)); }
__device__ __forceinline__ bf16x8 trpair(const LAS char* p, int hi_off) { const s16x4 lo = vtr(p), hi = vtr(p + hi_off); return (bf16x8){lo[0], lo[1], lo[2], lo[3], hi[0], hi[1], hi[2], hi[3]}; }

using pg8::Unit;
#define EPI_FENCE() asm volatile("" ::: "memory")
struct EpiA {
    static constexpr bool PERM = false, AFTER_DRAIN = false; static constexpr int MID_T = -1;
    const float* rstd; const float* cosT; const float* sinT; bf16* U; bf16* BZ; bf16* QT; bf16* KT; bf16* V;
    __device__ __forceinline__ void mid(f32x4 (&)[2][2][4][2], const Unit&, int, int, int, int) const {}
    __device__ __forceinline__ void operator()(const f32x4 (&acc)[2][2][4][2], const Unit& u, int wr, int wc, int fr_, int fq_) const {
        int fr = fr_, fq = fq_; asm volatile("" : "+v"(fr), "+v"(fq));
        const int row0 = u.pm * 256 + wr * 64 + fr;
        float rs[2][4];
#pragma unroll
        for (int ai = 0; ai < 2; ++ai)
#pragma unroll
            for (int m = 0; m < 4; ++m) rs[ai][m] = rstd[row0 + ai * 128 + m * 16];
        if (u.pn < 16) {
            const int ch0 = u.pn * 64 + wc * 16 + fq * 4;
#pragma unroll
            for (int ai = 0; ai < 2; ++ai)
#pragma unroll
                for (int m = 0; m < 4; ++m) {
                    const int row = row0 + ai * 128 + m * 16; const float r_ = rs[ai][m];
                    const f32x4 b = acc[ai][0][m][0] * r_, c = acc[ai][0][m][1] * r_, x = acc[ai][1][m][0] * r_, z = acc[ai][1][m][1] * r_;
                    const f32x4 uu = c * x; f32x4 bz;
#pragma unroll
                    for (int j = 0; j < 4; ++j) bz[j] = b[j] * z[j] * sigm(z[j]);
                    v2u w0, w1; w0.x = pk2(uu[0], uu[1]); w0.y = pk2(uu[2], uu[3]); w1.x = pk2(bz[0], bz[1]); w1.y = pk2(bz[2], bz[3]);
                    *(v2u*)(U + (size_t)row * 1024 + ch0) = w0; *(v2u*)(BZ + (size_t)row * LDAB + ch0) = w1;
                }
        } else if (u.pn < 24) {
            const int hd = (u.pn - 16) & 3; const bool isk = u.pn >= 20; bf16* dst = isk ? KT : QT;
            const float lg = log2_gamma(hd); const int f0 = wc * 32 + fq * 8;
#pragma unroll
            for (int ai = 0; ai < 2; ++ai)
#pragma unroll
                for (int mp = 0; mp < 2; ++mp) {
                    f32x4 cs[2][4];
#pragma unroll
                    for (int mm = 0; mm < 2; ++mm) { const int pos = (row0 + ai * 128 + (2 * mp + mm) * 16) & (T - 1);
                        cs[mm][0] = *(const f32x4*)(cosT + (size_t)pos * 128 + f0); cs[mm][1] = *(const f32x4*)(cosT + (size_t)pos * 128 + f0 + 4);
                        cs[mm][2] = *(const f32x4*)(sinT + (size_t)pos * 128 + f0); cs[mm][3] = *(const f32x4*)(sinT + (size_t)pos * 128 + f0 + 4); }
#pragma unroll
                    for (int mm = 0; mm < 2; ++mm) { const int m = 2 * mp + mm;
                        const int row = row0 + ai * 128 + m * 16; const int pos = row & (T - 1); const float p = (float)(pos & 511);
                        const float sc = rs[ai][m] * (isk ? exp2f(-p * lg) * 0.0625f : exp2f(p * lg));
                        const f32x4 c0 = cs[mm][0], c1 = cs[mm][1], s0 = cs[mm][2], s1 = cs[mm][3];
                        const f32x4 t1a = acc[ai][0][m][0], t1b = acc[ai][0][m][1], t2a = acc[ai][1][m][0], t2b = acc[ai][1][m][1];
                        const f32x4 o1a = (t1a * c0 - t2a * s0) * sc, o1b = (t1b * c1 - t2b * s1) * sc, o2a = (t1a * s0 + t2a * c0) * sc, o2b = (t1b * s1 + t2b * c1) * sc;
                        v4u w1, w2; w1.x = pk2(o1a[0], o1a[1]); w1.y = pk2(o1a[2], o1a[3]); w1.z = pk2(o1b[0], o1b[1]); w1.w = pk2(o1b[2], o1b[3]);
                        w2.x = pk2(o2a[0], o2a[1]); w2.y = pk2(o2a[2], o2a[3]); w2.z = pk2(o2b[0], o2b[1]); w2.w = pk2(o2b[2], o2b[3]);
                        bf16* rp = dst + (size_t)row * 1024 + hd * 256 + f0;
                        *(v4u*)rp = w1; *(v4u*)(rp + 128) = w2; }
                    EPI_FENCE();
                }
        } else {
            const int col0 = (u.pn - 24) * 256 + wc * 32 + fq * 8;
#pragma unroll
            for (int ai = 0; ai < 2; ++ai)
#pragma unroll
                for (int m = 0; m < 4; ++m) {
                    const int row = row0 + ai * 128 + m * 16; const float r_ = rs[ai][m];
#pragma unroll
                    for (int bj = 0; bj < 2; ++bj) { const f32x4 a = acc[ai][bj][m][0] * r_, b = acc[ai][bj][m][1] * r_;
                        v4u w; w.x = pk2(a[0], a[1]); w.y = pk2(a[2], a[3]); w.z = pk2(b[0], b[1]); w.w = pk2(b[2], b[3]);
                        *(v4u*)(V + (size_t)row * 2048 + col0 + bj * 128) = w; }
                }
        }
    }
};
struct EpiB {
    static constexpr bool PERM = false, AFTER_DRAIN = false; static constexpr int MID_T = -1;
    const float* rstd; const float* ssq; const bf16* O; bf16* OB; bf16* SG;
    __device__ __forceinline__ void mid(f32x4 (&)[2][2][4][2], const Unit&, int, int, int, int) const {}
    __device__ __forceinline__ void operator()(const f32x4 (&acc)[2][2][4][2], const Unit& u, int wr, int wc, int fr_, int fq_) const {
        int fr = fr_, fq = fq_; asm volatile("" : "+v"(fr), "+v"(fq));
        const int row0 = u.pm * 256 + wr * 64 + fr;
        float rs[2][4];
#pragma unroll
        for (int ai = 0; ai < 2; ++ai)
#pragma unroll
            for (int m = 0; m < 4; ++m) rs[ai][m] = rstd[row0 + ai * 128 + m * 16];
        if (u.pn < 8) {
            const int hd = u.pn >> 1, col0 = u.pn * 256 + wc * 32 + fq * 8;
            float rg[2][4];
#pragma unroll
            for (int ai = 0; ai < 2; ++ai)
#pragma unroll
                for (int m = 0; m < 4; ++m) rg[ai][m] = ssq[(size_t)(row0 + ai * 128 + m * 16) * 4 + hd];
#pragma unroll
            for (int ai = 0; ai < 2; ++ai) {
                v4u ov[4][2];
#pragma unroll
                for (int m = 0; m < 4; ++m)
#pragma unroll
                    for (int bj = 0; bj < 2; ++bj) ov[m][bj] = *(const v4u*)(O + (size_t)(row0 + ai * 128 + m * 16) * LDAB + col0 + bj * 128);
#pragma unroll
                for (int m = 0; m < 4; ++m) {
                    const int row = row0 + ai * 128 + m * 16; const float r_ = rs[ai][m];
                    const float g_ = rsqrtf(rg[ai][m] * (1.0f / 512.0f) + EPS);
#pragma unroll
                    for (int bj = 0; bj < 2; ++bj) {
                        const v4u o_ = ov[m][bj];
                        const f32x4 za = acc[ai][bj][m][0] * r_, zb = acc[ai][bj][m][1] * r_;
                        float r[8];
                        r[0] = bf_lo(o_.x) * g_ * za[0] * sigm(za[0]); r[1] = bf_hi(o_.x) * g_ * za[1] * sigm(za[1]);
                        r[2] = bf_lo(o_.y) * g_ * za[2] * sigm(za[2]); r[3] = bf_hi(o_.y) * g_ * za[3] * sigm(za[3]);
                        r[4] = bf_lo(o_.z) * g_ * zb[0] * sigm(zb[0]); r[5] = bf_hi(o_.z) * g_ * zb[1] * sigm(zb[1]);
                        r[6] = bf_lo(o_.w) * g_ * zb[2] * sigm(zb[2]); r[7] = bf_hi(o_.w) * g_ * zb[3] * sigm(zb[3]);
                        v4u w; w.x = pk2(r[0], r[1]); w.y = pk2(r[2], r[3]); w.z = pk2(r[4], r[5]); w.w = pk2(r[6], r[7]);
                        *(v4u*)(OB + (size_t)row * LDAB + col0 + bj * 128) = w;
                    }
                }
                EPI_FENCE();
            }
        } else {
            const int col0 = (u.pn - 8) * 256 + wc * 32 + fq * 8;
#pragma unroll
            for (int ai = 0; ai < 2; ++ai)
#pragma unroll
                for (int m = 0; m < 4; ++m) {
                    const int row = row0 + ai * 128 + m * 16; const float r_ = rs[ai][m];
#pragma unroll
                    for (int bj = 0; bj < 2; ++bj) { const f32x4 a = acc[ai][bj][m][0] * r_, b = acc[ai][bj][m][1] * r_;
                        v4u w; w.x = pk2(sigm(a[0]), sigm(a[1])); w.y = pk2(sigm(a[2]), sigm(a[3])); w.z = pk2(sigm(b[0]), sigm(b[1])); w.w = pk2(sigm(b[2]), sigm(b[3]));
                        *(v4u*)(SG + (size_t)row * 2048 + col0 + bj * 128) = w; }
                }
        }
    }
};
struct EpiMG {
    static constexpr bool PERM = false, AFTER_DRAIN = false; static constexpr int MID_T = 16;
    const bf16* SG; bf16* MG;
    __device__ __forceinline__ void mid(f32x4 (&acc)[2][2][4][2], const Unit& u, int wr, int wc, int fr_, int fq_) const {
        int fr = fr_, fq = fq_; asm volatile("" : "+v"(fr), "+v"(fq));
        const int row0 = u.pm * 256 + wr * 64 + fr, col0 = u.pn * 256 + wc * 32 + fq * 8;
#pragma unroll
        for (int ai = 0; ai < 2; ++ai)
#pragma unroll
            for (int mp = 0; mp < 2; ++mp) {
                v4u ga[2][2], gb[2][2];
#pragma unroll
                for (int mm = 0; mm < 2; ++mm)
#pragma unroll
                    for (int bj = 0; bj < 2; ++bj) { const bf16* gp = SG + (size_t)(row0 + ai * 128 + (2 * mp + mm) * 16) * 2048 + col0 + bj * 128; ga[mm][bj] = *(const v4u*)gp; gb[mm][bj] = *(const v4u*)(gp + 1024); }
#pragma unroll
                for (int mm = 0; mm < 2; ++mm)
#pragma unroll
                    for (int bj = 0; bj < 2; ++bj) { const int m = 2 * mp + mm; const v4u a_ = ga[mm][bj], b_ = gb[mm][bj];
                        f32x4& c0 = acc[ai][bj][m][0]; f32x4& c1 = acc[ai][bj][m][1];
                        c0[0] *= bf_lo(a_.x) * __builtin_amdgcn_rcpf(fmaxf(bf_lo(b_.x), 1e-30f)); c0[1] *= bf_hi(a_.x) * __builtin_amdgcn_rcpf(fmaxf(bf_hi(b_.x), 1e-30f));
                        c0[2] *= bf_lo(a_.y) * __builtin_amdgcn_rcpf(fmaxf(bf_lo(b_.y), 1e-30f)); c0[3] *= bf_hi(a_.y) * __builtin_amdgcn_rcpf(fmaxf(bf_hi(b_.y), 1e-30f));
                        c1[0] *= bf_lo(a_.z) * __builtin_amdgcn_rcpf(fmaxf(bf_lo(b_.z), 1e-30f)); c1[1] *= bf_hi(a_.z) * __builtin_amdgcn_rcpf(fmaxf(bf_hi(b_.z), 1e-30f));
                        c1[2] *= bf_lo(a_.w) * __builtin_amdgcn_rcpf(fmaxf(bf_lo(b_.w), 1e-30f)); c1[3] *= bf_hi(a_.w) * __builtin_amdgcn_rcpf(fmaxf(bf_hi(b_.w), 1e-30f)); }
                EPI_FENCE();
            }
    }
    __device__ __forceinline__ void operator()(const f32x4 (&acc)[2][2][4][2], const Unit& u, int wr, int wc, int fr_, int fq_) const {
        int fr = fr_, fq = fq_; asm volatile("" : "+v"(fr), "+v"(fq));
        const int row0 = u.pm * 256 + wr * 64 + fr, col0 = u.pn * 256 + wc * 32 + fq * 8;
#pragma unroll
        for (int ai = 0; ai < 2; ++ai) {
            v4u gb[4][2];
#pragma unroll
            for (int m = 0; m < 4; ++m)
#pragma unroll
                for (int bj = 0; bj < 2; ++bj) gb[m][bj] = *(const v4u*)(SG + (size_t)(row0 + ai * 128 + m * 16) * 2048 + 1024 + col0 + bj * 128);
#pragma unroll
            for (int m = 0; m < 4; ++m)
#pragma unroll
                for (int bj = 0; bj < 2; ++bj) { const v4u b_ = gb[m][bj]; const f32x4 c0 = acc[ai][bj][m][0], c1 = acc[ai][bj][m][1];
                    v4u w; w.x = pk2(c0[0] * fmaxf(bf_lo(b_.x), 1e-30f), c0[1] * fmaxf(bf_hi(b_.x), 1e-30f)); w.y = pk2(c0[2] * fmaxf(bf_lo(b_.y), 1e-30f), c0[3] * fmaxf(bf_hi(b_.y), 1e-30f));
                    w.z = pk2(c1[0] * fmaxf(bf_lo(b_.z), 1e-30f), c1[1] * fmaxf(bf_hi(b_.z), 1e-30f)); w.w = pk2(c1[2] * fmaxf(bf_lo(b_.w), 1e-30f), c1[3] * fmaxf(bf_hi(b_.w), 1e-30f));
                    *(v4u*)(MG + (size_t)(row0 + ai * 128 + m * 16) * 1024 + col0 + bj * 128) = w; }
            EPI_FENCE();
        }
    }
};
struct EpiRes {
    static constexpr bool PERM = false, AFTER_DRAIN = false; static constexpr int MID_T = -1;
    const float* xres; float* xout;
    __device__ __forceinline__ void mid(f32x4 (&)[2][2][4][2], const Unit&, int, int, int, int) const {}
    __device__ __forceinline__ void operator()(const f32x4 (&acc)[2][2][4][2], const Unit& u, int wr, int wc, int fr_, int fq_) const {
        int fr = fr_, fq = fq_; asm volatile("" : "+v"(fr), "+v"(fq));
        const int row0 = u.pm * 256 + wr * 64 + fr, col0 = u.pn * 256 + wc * 32 + fq * 4;
#pragma unroll
        for (int ai = 0; ai < 2; ++ai) {
            f32x4 r[4][2][2];
#pragma unroll
            for (int m = 0; m < 4; ++m)
#pragma unroll
                for (int bj = 0; bj < 2; ++bj)
#pragma unroll
                    for (int n = 0; n < 2; ++n) r[m][bj][n] = *(const f32x4*)(xres + (size_t)(row0 + ai * 128 + m * 16) * 1024 + col0 + bj * 128 + n * 16);
#pragma unroll
            for (int m = 0; m < 4; ++m)
#pragma unroll
                for (int bj = 0; bj < 2; ++bj)
#pragma unroll
                    for (int n = 0; n < 2; ++n) *(f32x4*)(xout + (size_t)(row0 + ai * 128 + m * 16) * 1024 + col0 + bj * 128 + n * 16) = r[m][bj][n] + acc[ai][bj][m][n];
            EPI_FENCE();
        }
    }
};
#define XB_TMO      128
#define XB_XCNT(j)  (256  + 64 * (j))
#define XB_XSUB(j)  (1280 + 64 * (j))
#define XB_XGEN(j)  (2304 + 64 * (j))
#define XB_TOP      3328
#define XB_TOPGEN   3392
#define XCD_BAR_WORDS 3456
#define XB_SPIN_CAP (1u << 18)

__device__ __forceinline__ unsigned xb_ld(unsigned* p)              { return __hip_atomic_load(p, __ATOMIC_RELAXED, __HIP_MEMORY_SCOPE_AGENT); }
__device__ __forceinline__ unsigned xb_add(unsigned* p, unsigned v) { return __hip_atomic_fetch_add(p, v, __ATOMIC_RELAXED, __HIP_MEMORY_SCOPE_AGENT); }
__device__ __forceinline__ unsigned xb_xcc_id() { return (unsigned)__builtin_amdgcn_s_getreg((3 << 11) | 20) & 0xFu; }
#define XB_SPIN(cond, bar) do { unsigned _sp = 0; while (cond) { __builtin_amdgcn_s_sleep(1); \
    if ((++_sp & 255u) == 0u) { if (xb_ld(&(bar)[XB_TMO])) break; if (_sp > XB_SPIN_CAP) { atomicAdd(&(bar)[XB_TMO], 1u); break; } } } } while (0)

struct XcdBarrier {
    unsigned* bar; unsigned x;
    volatile LAS unsigned* st;
};

__device__ __forceinline__ XcdBarrier xcd_barrier_post(unsigned* bar, volatile LAS unsigned* st) {
    XcdBarrier b; b.bar = bar; b.x = xb_xcc_id(); b.st = st;
    if (threadIdx.x == 0) (void)xb_add(&bar[XB_XCNT(b.x)], 1u);
    return b;
}
__device__ __forceinline__ void xcd_barrier_complete(unsigned* bar, unsigned x, unsigned& nloc, unsigned& nx) {
    const unsigned G = gridDim.x * gridDim.y * gridDim.z;
    unsigned sum, cnt, mine, sp = 0u;
    for (;;) {
        sum = 0u; cnt = 0u; mine = 0u;
#pragma unroll
        for (unsigned j = 0; j < 16; ++j) { const unsigned c = xb_ld(&bar[XB_XCNT(j)]); sum += c; cnt += (c > 0u) ? 1u : 0u; mine = (j == x) ? c : mine; }
        if (sum == G) break;
        __builtin_amdgcn_s_sleep(1);
        if ((++sp & 255u) == 0u) { if (xb_ld(&bar[XB_TMO])) break; if (sp > XB_SPIN_CAP) { atomicAdd(&bar[XB_TMO], 1u); break; } }
    }
    nloc = mine > 0u ? mine : 1u; nx = cnt > 0u ? cnt : 1u;
}

__device__ __forceinline__ void xcd_barrier(const XcdBarrier& b) {
    asm volatile("s_waitcnt vmcnt(0)" ::: "memory");
    __syncthreads();
    if (threadIdx.x == 0) {
        unsigned* bar = b.bar;
        __builtin_amdgcn_s_waitcnt(0);
        unsigned nloc = b.st[0], nx = b.st[1];
        if (nloc == 0u) { xcd_barrier_complete(bar, b.x, nloc, nx); b.st[0] = nloc; b.st[1] = nx; }
        const unsigned old = xb_add(&bar[XB_XSUB(b.x)], 1u);
        const unsigned gen = old / nloc;
        if (old + 1u == (gen + 1u) * nloc) {
            __builtin_amdgcn_fence(__ATOMIC_RELEASE, "agent");
            asm volatile("s_waitcnt vmcnt(0)" ::: "memory");
            const unsigned og = xb_add(&bar[XB_TOP], 1u);
            const unsigned tg = og / nx;
            if (og + 1u == (tg + 1u) * nx) xb_add(&bar[XB_TOPGEN], 1u);
            else XB_SPIN(xb_ld(&bar[XB_TOPGEN]) == tg, bar);
            __builtin_amdgcn_fence(__ATOMIC_ACQUIRE, "agent");
            xb_add(&bar[XB_XGEN(b.x)], 1u);
            asm volatile("s_waitcnt vmcnt(0)" ::: "memory");
        } else {
            XB_SPIN(xb_ld(&bar[XB_XGEN(b.x)]) == gen, bar);
            __builtin_amdgcn_fence(__ATOMIC_ACQUIRE, "agent");
            asm volatile("s_waitcnt vmcnt(0)" ::: "memory");
        }
    }
    __syncthreads();
}

struct Frame {
    LAS unsigned char* lds; volatile LAS unsigned* MISC; gu32* ctl;
    int tid, lane, wave, vcu, G;
    const float* in[9]; float* out; unsigned char* ws;
};
__device__ __forceinline__ float wave_sum(float v) {
#pragma unroll
    for (int o = 1; o < 64; o <<= 1) v += __shfl_xor(v, o);
    return v;
}
__device__ __forceinline__ int prow(int mode, int n) {
    if (mode == 0) return n;
    if (mode == 2 && n < 4096) { const int type = n >> 10, chg = n & 1023, pc = chg >> 6, ch = chg & 63;
        return 256 * pc + 128 * (type >> 1) + 32 * (ch >> 4) + 16 * (type & 1) + 4 * ((ch >> 2) & 3) + (ch & 3); }
    const int l32 = n & 31; return (n & ~31) | (16 * ((l32 >> 2) & 1) + 4 * (l32 >> 3) + (l32 & 3));
}
__device__ __forceinline__ void cvt_item(const float* W, int N, bf16* WT, int ldk, const float* gk, int mode, LAS float* scr, int item, int lane) {
    const int nblk = N / 32, kb = item / nblk, nb = item % nblk, k0 = 64 * kb, n0 = 32 * nb;
    float wv[32];
#pragma unroll
    for (int i = 0; i < 32; ++i) wv[i] = W[(size_t)(k0 + 2 * i + (lane >> 5)) * N + n0 + (lane & 31)];
    if (gk) { const float g0 = gk[k0 + (lane & 63)];
#pragma unroll
        for (int i = 0; i < 32; ++i) wv[i] *= __shfl(g0, 2 * i + (lane >> 5)); }
#pragma unroll
    for (int i = 0; i < 32; ++i) scr[(2 * i + (lane >> 5)) * 33 + (lane & 31)] = wv[i];
    LDS_WAIT(); asm volatile("" ::: "memory");
    const int c = lane & 7;
#pragma unroll
    for (int j = 0; j < 4; ++j) { const int n = (lane >> 3) + 8 * j; const LAS float* s = scr + (8 * c) * 33 + n;
        v4u o; o.x = pk2(s[0 * 33], s[1 * 33]); o.y = pk2(s[2 * 33], s[3 * 33]); o.z = pk2(s[4 * 33], s[5 * 33]); o.w = pk2(s[6 * 33], s[7 * 33]);
        *(GAS v4u*)(WT + (size_t)prow(mode, n0 + n) * ldk + k0 + 8 * c) = o; }
    LDS_WAIT(); asm volatile("" ::: "memory");
}
__device__ __forceinline__ void convert_layer(Frame& F, int l, unsigned char* region) {
    LAS float* scr = (LAS float*)(F.lds + F.wave * 16384);
    const int gw = F.vcu * NWAVES + F.wave, NGW = F.G * NWAVES;
    constexpr int I_IN = (D / 64) * (DIN / 32), I_A = (D / 64) * (D / 32), I_B = (2 * D / 64) * (D / 32), I_O = I_A;
    const float* w_in = F.in[2] + (size_t)l * D * DIN; const float* ng = F.in[1] + (size_t)l * D;
    const float* w_a = F.in[5] + (size_t)l * D * D; const float* w_b = F.in[6] + (size_t)l * 2 * D * D; const float* w_o = F.in[7] + (size_t)l * D * D;
    for (int it = gw; it < I_IN + I_A + I_B + I_O; it += NGW) {
        int r = it;
        if (r < I_IN) { cvt_item(w_in, DIN, (bf16*)(region + RW_IN), D, ng, 2, scr, r, F.lane); continue; } r -= I_IN;
        if (r < I_A) { cvt_item(w_a, D, (bf16*)(region + RW_AB), LDAB, nullptr, 1, scr, r, F.lane); continue; } r -= I_A;
        if (r < I_B) { cvt_item(w_b, D, (bf16*)(region + RW_AB) + D, LDAB, nullptr, 1, scr, r, F.lane); continue; } r -= I_B;
        cvt_item(w_o, D, (bf16*)(region + RW_O), D, nullptr, 0, scr, r, F.lane);
    }
}
__device__ __forceinline__ void rownorm(Frame& F, const float* src, bf16* xb, float* rstd) {
    const int gw = F.vcu * NWAVES + F.wave, NGW = F.G * NWAVES;
    for (int m = gw; m < M; m += NGW) {
        const GAS f32x4* xr = (const GAS f32x4*)(src + (size_t)m * D) + F.lane;
        f32x4 v[4]; float s = 0.f;
#pragma unroll
        for (int j = 0; j < 4; ++j) { v[j] = xr[64 * j]; s += (v[j].x * v[j].x + v[j].y * v[j].y) + (v[j].z * v[j].z + v[j].w * v[j].w); }
        s = wave_sum(s);
        if (F.lane == 0) rstd[m] = rsqrtf(s * (1.f / D) + EPS);
        GAS v2u* o8 = (GAS v2u*)(xb + (size_t)m * D) + F.lane;
#pragma unroll
        for (int j = 0; j < 4; ++j) { v2u w; w.x = pk2(v[j].x, v[j].y); w.y = pk2(v[j].z, v[j].w); o8[64 * j] = w; }
    }
}
__device__ __forceinline__ void final_norm(Frame& F, float* x, const float* g) {
    const int gw = F.vcu * NWAVES + F.wave, NGW = F.G * NWAVES;
    for (int m = gw; m < M; m += NGW) {
        GAS f32x4* xr = (GAS f32x4*)(x + (size_t)m * D) + F.lane; const GAS f32x4* gr = (const GAS f32x4*)g + F.lane;
        f32x4 v[4]; float s = 0.f;
#pragma unroll
        for (int j = 0; j < 4; ++j) { v[j] = xr[64 * j]; s += (v[j].x * v[j].x + v[j].y * v[j].y) + (v[j].z * v[j].z + v[j].w * v[j].w); }
        const float r = rsqrtf(wave_sum(s) * (1.f / D) + EPS);
#pragma unroll
        for (int j = 0; j < 4; ++j) xr[64 * j] = v[j] * r * gr[64 * j];
    }
}
__device__ __forceinline__ void rotary_tables(Frame& F, float* cosT, float* sinT) {
    const int gt = F.vcu * (NWAVES * 64) + F.tid, NT = F.G * NWAVES * 64;
    for (int idx = gt; idx < T * 128; idx += NT) {
        const int pos = idx >> 7, f = idx & 127;
        double inv = 1.0, bq = 0.930572040929699;
#pragma unroll
        for (int bit = 0; bit < 7; ++bit) { if ((f >> bit) & 1) inv *= bq; bq *= bq; }
        const double a = (double)pos * inv;
        const double kd = __builtin_rint(a * 0.6366197723675814);
        const double r = (a - kd * 1.5707963267948966) - kd * 6.123233995736766e-17;
        const double r2 = r * r;
        double sp = -1.0 / 355687428096000.0;
        sp = sp * r2 + 1.0 / 1307674368000.0; sp = sp * r2 - 1.0 / 6227020800.0; sp = sp * r2 + 1.0 / 39916800.0; sp = sp * r2 - 1.0 / 362880.0;
        sp = sp * r2 + 1.0 / 5040.0; sp = sp * r2 - 1.0 / 120.0; sp = sp * r2 + 1.0 / 6.0; const double sn = r - r * r2 * sp;
        double cp = 1.0 / 20922789888000.0;
        cp = cp * r2 - 1.0 / 87178291200.0; cp = cp * r2 + 1.0 / 479001600.0; cp = cp * r2 - 1.0 / 3628800.0; cp = cp * r2 + 1.0 / 40320.0;
        cp = cp * r2 - 1.0 / 720.0; cp = cp * r2 + 1.0 / 24.0; cp = cp * r2 - 0.5; const double cs = 1.0 + r2 * cp;
        const int k = (int)kd & 3;
        const double c = (k == 0) ? cs : (k == 1) ? -sn : (k == 2) ? -cs : sn;
        const double s = (k == 0) ? sn : (k == 1) ? cs : (k == 2) ? -sn : -cs;
        cosT[idx] = (float)c; sinT[idx] = (float)s;
    }
}
__device__ __forceinline__ void conv_pass(Frame& F, const bf16* U, bf16* BZ, const float* cw, const float* cb) {
    const int gt = F.vcu * (NWAVES * 64) + F.tid, NT = F.G * NWAVES * 64;
    for (int v = gt; v < M * 128; v += NT) {
        const int row = v >> 7, c8 = (v & 127) * 8, t = row & (T - 1);
        const v4u z4 = {0u, 0u, 0u, 0u};
        const v4u u0 = *(const v4u*)(U + (size_t)row * 1024 + c8);
        const v4u u1 = t >= 1 ? *(const v4u*)(U + (size_t)(row - 1) * 1024 + c8) : z4;
        const v4u u2 = t >= 2 ? *(const v4u*)(U + (size_t)(row - 2) * 1024 + c8) : z4;
        bf16* bp = BZ + (size_t)row * LDAB + c8; const v4u bz = *(const v4u*)bp;
        float w0[8], w1[8], w2[8], bb[8];
        *(f32x4*)&w0[0] = *(const f32x4*)(cw + c8); *(f32x4*)&w0[4] = *(const f32x4*)(cw + c8 + 4);
        *(f32x4*)&w1[0] = *(const f32x4*)(cw + 1024 + c8); *(f32x4*)&w1[4] = *(const f32x4*)(cw + 1024 + c8 + 4);
        *(f32x4*)&w2[0] = *(const f32x4*)(cw + 2048 + c8); *(f32x4*)&w2[4] = *(const f32x4*)(cw + 2048 + c8 + 4);
        *(f32x4*)&bb[0] = *(const f32x4*)(cb + c8); *(f32x4*)&bb[4] = *(const f32x4*)(cb + c8 + 4);
        float y[8];
#pragma unroll
        for (int i = 0; i < 4; ++i) {
            const unsigned a0 = u0[i], a1 = u1[i], a2 = u2[i], bzz = bz[i];
            y[2 * i]     = bf_lo(bzz) * (w0[2 * i] * bf_lo(a2) + w1[2 * i] * bf_lo(a1) + w2[2 * i] * bf_lo(a0) + bb[2 * i]);
            y[2 * i + 1] = bf_hi(bzz) * (w0[2 * i + 1] * bf_hi(a2) + w1[2 * i + 1] * bf_hi(a1) + w2[2 * i + 1] * bf_hi(a0) + bb[2 * i + 1]);
        }
        v4u w; w.x = pk2(y[0], y[1]); w.y = pk2(y[2], y[3]); w.z = pk2(y[4], y[5]); w.w = pk2(y[6], y[7]);
        *(v4u*)bp = w;
    }
}
constexpr int CH_KSTR = 576, CH_VSTR = 64, CH_VOFF = 128 * CH_KSTR;
__device__ __forceinline__ void conv_one(int v, const bf16* U, bf16* BZ, const float* cw, const float* cb) {
    const int row = v >> 7, c8 = (v & 127) * 8, t = row & (T - 1);
    const v4u z4 = {0u, 0u, 0u, 0u};
    const v4u u0 = *(const v4u*)(U + (size_t)row * 1024 + c8);
    const v4u u1 = t >= 1 ? *(const v4u*)(U + (size_t)(row - 1) * 1024 + c8) : z4;
    const v4u u2 = t >= 2 ? *(const v4u*)(U + (size_t)(row - 2) * 1024 + c8) : z4;
    bf16* bp = BZ + (size_t)row * LDAB + c8; const v4u bz = *(const v4u*)bp;
    float w0[8], w1[8], w2[8], bb[8];
    *(f32x4*)&w0[0] = *(const f32x4*)(cw + c8); *(f32x4*)&w0[4] = *(const f32x4*)(cw + c8 + 4);
    *(f32x4*)&w1[0] = *(const f32x4*)(cw + 1024 + c8); *(f32x4*)&w1[4] = *(const f32x4*)(cw + 1024 + c8 + 4);
    *(f32x4*)&w2[0] = *(const f32x4*)(cw + 2048 + c8); *(f32x4*)&w2[4] = *(const f32x4*)(cw + 2048 + c8 + 4);
    *(f32x4*)&bb[0] = *(const f32x4*)(cb + c8); *(f32x4*)&bb[4] = *(const f32x4*)(cb + c8 + 4);
    float y[8];
#pragma unroll
    for (int i = 0; i < 4; ++i) {
        const unsigned a0 = u0[i], a1 = u1[i], a2 = u2[i], bzz = bz[i];
        y[2 * i]     = bf_lo(bzz) * (w0[2 * i] * bf_lo(a2) + w1[2 * i] * bf_lo(a1) + w2[2 * i] * bf_lo(a0) + bb[2 * i]);
        y[2 * i + 1] = bf_hi(bzz) * (w0[2 * i + 1] * bf_hi(a2) + w1[2 * i + 1] * bf_hi(a1) + w2[2 * i + 1] * bf_hi(a0) + bb[2 * i + 1]);
    }
    v4u w; w.x = pk2(y[0], y[1]); w.y = pk2(y[2], y[3]); w.z = pk2(y[4], y[5]); w.w = pk2(y[6], y[7]);
    *(v4u*)bp = w;
}
template <bool CONV>
__device__ __forceinline__ void chain_item(Frame& F, int bh, int sl, const bf16* KT, const bf16* V, bf16* ST, const bf16* U, bf16* BZ, const float* cw, const float* cb) {
    int tid_ = F.tid; asm volatile("" : "+v"(tid_));
    const int b = bh >> 2, h = bh & 3, tid = tid_, lane = tid & 63, w = __builtin_amdgcn_readfirstlane(tid >> 6);
    const int hl = lane >> 5, l31 = lane & 31, q = (lane & 15) >> 2, p = lane & 3, blk = (lane >> 4) & 1;
    LAS char* Kt = (LAS char*)F.lds; LAS char* Vt = Kt + CH_VOFF;
    const float g512 = exp2f(512.0f * log2_gamma(h));
    const int gt = F.vcu * (NWAVES * 64) + tid, NT = F.G * NWAVES * 64;
    f32x16 S;
#pragma unroll
    for (int i = 0; i < 16; ++i) S[i] = 0.f;
    bf16* STb = ST + (size_t)bh * 8 * 512 * 256 + ((size_t)sl * 32 + l31) * 256 + w * 32 + 4 * hl;
    const bf16* kg = KT + ((size_t)b * T + (tid >> 5)) * 1024 + h * 256 + (tid & 31) * 8;
    const bf16* vg = V + ((size_t)b * T + (tid >> 2)) * 2048 + h * 512 + sl * 32 + (tid & 3) * 8;
    LAS char* kl = Kt + (tid >> 5) * CH_KSTR + (tid & 31) * 16;
    LAS char* vl = Vt + (tid >> 2) * CH_VSTR + (tid & 3) * 16;
    v4u kra[8], vra, krb[8], vrb;
#pragma unroll
    for (int i = 0; i < 8; ++i) kra[i] = *(const v4u*)(kg + (size_t)i * 16 * 1024);
    vra = *(const v4u*)vg;
#pragma unroll
    for (int i = 0; i < 8; ++i) krb[i] = *(const v4u*)(kg + (size_t)128 * 1024 + (size_t)i * 16 * 1024);
    vrb = *(const v4u*)(vg + (size_t)128 * 2048);
#pragma unroll
    for (int g = 0; g < 4; ++g) { v2u w2; w2.x = 0u; w2.y = 0u; *(v2u*)(STb + 8 * g) = w2; }
    const int crow0 = gt >> 7, c8 = (gt & 127) * 8;
    float w0[8], w1[8], w2c[8], bb[8]; v4u cu0 = {0u, 0u, 0u, 0u}, cu1 = cu0, cu2 = cu0, cbz = cu0;
    if (CONV) {
        *(f32x4*)&w0[0] = *(const f32x4*)(cw + c8); *(f32x4*)&w0[4] = *(const f32x4*)(cw + c8 + 4);
        *(f32x4*)&w1[0] = *(const f32x4*)(cw + 1024 + c8); *(f32x4*)&w1[4] = *(const f32x4*)(cw + 1024 + c8 + 4);
        *(f32x4*)&w2c[0] = *(const f32x4*)(cw + 2048 + c8); *(f32x4*)&w2c[4] = *(const f32x4*)(cw + 2048 + c8 + 4);
        *(f32x4*)&bb[0] = *(const f32x4*)(cb + c8); *(f32x4*)&bb[4] = *(const f32x4*)(cb + c8 + 4);
        const int row = crow0, t = row & (T - 1); const v4u z4 = {0u, 0u, 0u, 0u};
        cu0 = *(const v4u*)(U + (size_t)row * 1024 + c8); cu1 = t >= 1 ? *(const v4u*)(U + (size_t)(row - 1) * 1024 + c8) : z4;
        cu2 = t >= 2 ? *(const v4u*)(U + (size_t)(row - 2) * 1024 + c8) : z4; cbz = *(const v4u*)(BZ + (size_t)row * LDAB + c8);
    }
#define CHAIN_STEP(KR, VR, IT) do { const int it = (IT); \
        __syncthreads(); \
        _Pragma("unroll") for (int i = 0; i < 8; ++i) *(LAS v4u*)(kl + i * 16 * CH_KSTR) = KR[i]; \
        *(LAS v4u*)vl = VR; \
        if (it + 2 < 28) { _Pragma("unroll") for (int i = 0; i < 8; ++i) KR[i] = *(const v4u*)(kg + (size_t)(it + 2) * 128 * 1024 + (size_t)i * 16 * 1024); \
            VR = *(const v4u*)(vg + (size_t)(it + 2) * 128 * 2048); } \
        CHAIN_CONV(it); \
        __syncthreads(); \
        _Pragma("unroll") for (int ks = 0; ks < 8; ++ks) { const int kr_ = 16 * ks + 8 * hl + q; \
            const bf16x8 A = trpair(Kt + kr_ * CH_KSTR + 2 * (32 * w + 16 * blk + 4 * p), 4 * CH_KSTR); \
            const bf16x8 B = trpair(Vt + kr_ * CH_VSTR + 2 * (16 * blk + 4 * p), 4 * CH_VSTR); \
            S = MFMA32(A, B, S); } \
        if ((it & 3) == 3) { _Pragma("unroll") for (int i = 0; i < 16; ++i) S[i] *= g512; \
            const int s1 = (it >> 2) + 1; \
            _Pragma("unroll") for (int g = 0; g < 4; ++g) { v2u w2; w2.x = pk2(S[4 * g], S[4 * g + 1]); w2.y = pk2(S[4 * g + 2], S[4 * g + 3]); *(v2u*)(STb + (size_t)s1 * 512 * 256 + 8 * g) = w2; } } \
    } while (0)
    auto chain_conv = [&](int it) {
        if (CONV && it < 16) {
            float y[8];
#pragma unroll
            for (int i = 0; i < 4; ++i) {
                const unsigned a0 = cu0[i], a1 = cu1[i], a2 = cu2[i], bzz = cbz[i];
                y[2 * i]     = bf_lo(bzz) * (w0[2 * i] * bf_lo(a2) + w1[2 * i] * bf_lo(a1) + w2c[2 * i] * bf_lo(a0) + bb[2 * i]);
                y[2 * i + 1] = bf_hi(bzz) * (w0[2 * i + 1] * bf_hi(a2) + w1[2 * i + 1] * bf_hi(a1) + w2c[2 * i + 1] * bf_hi(a0) + bb[2 * i + 1]);
            }
            v4u wy; wy.x = pk2(y[0], y[1]); wy.y = pk2(y[2], y[3]); wy.z = pk2(y[4], y[5]); wy.w = pk2(y[6], y[7]);
            *(v4u*)(BZ + (size_t)(crow0 + 1024 * it) * LDAB + c8) = wy;
            if (it + 1 < 16) { const int row = crow0 + 1024 * (it + 1), t = row & (T - 1); const v4u z4 = {0u, 0u, 0u, 0u};
                cu0 = *(const v4u*)(U + (size_t)row * 1024 + c8); cu1 = t >= 1 ? *(const v4u*)(U + (size_t)(row - 1) * 1024 + c8) : z4;
                cu2 = t >= 2 ? *(const v4u*)(U + (size_t)(row - 2) * 1024 + c8) : z4; cbz = *(const v4u*)(BZ + (size_t)row * LDAB + c8); }
        }
    };
#define CHAIN_CONV(it) chain_conv(it)
#pragma unroll 1
    for (int it2 = 0; it2 < 28; it2 += 2) { CHAIN_STEP(kra, vra, it2); CHAIN_STEP(krb, vrb, it2 + 1); }
#undef CHAIN_STEP
#undef CHAIN_CONV
}
constexpr int AP_STR = 528, AP_VSTR = 1088, AP_KOFF = 128 * AP_STR, AP_VOFF = AP_KOFF + 32 * AP_STR, AP_SOFF = AP_KOFF, AP_RED = 8 * 32 * AP_STR;
static_assert(AP_VOFF + 32 * AP_VSTR <= RING_BYTES && AP_SOFF + 64 * AP_STR <= RING_BYTES && AP_RED + 1024 <= RING_BYTES, "apply LDS map");
__device__ __forceinline__ void apply_item(Frame& F, int bh, int r, const bf16* QT, const bf16* KT, const bf16* V, const bf16* ST, bf16* O, float* ssq) {
    int tid_ = F.tid; asm volatile("" : "+v"(tid_));
    const int b = bh >> 2, h = bh & 3, tid = tid_, lane = tid & 63, w = __builtin_amdgcn_readfirstlane(tid >> 6);
    const int hl = lane >> 5, l31 = lane & 31, q = (lane & 15) >> 2, p = lane & 3, blk = (lane >> 4) & 1;
    const int ig = w & 3, dh = w >> 2, s = r >> 2, t0 = r * 128;
    LAS char* Qs = (LAS char*)F.lds; LAS char* Ks = Qs + AP_KOFF; LAS char* Vs = Qs + AP_VOFF; LAS char* Ss = Qs + AP_SOFF; LAS float* red = (LAS float*)(Qs + AP_RED);
    f32x16 acc[8];
#pragma unroll
    for (int mt = 0; mt < 8; ++mt)
#pragma unroll
        for (int i = 0; i < 16; ++i) acc[mt][i] = 0.f;
    const int ntile = 4 * (r - 4 * s + 1), dtile0 = 4 * (r - 4 * s);
    const size_t key0 = (size_t)b * T + s * 512;
    const bf16* kg = KT + (key0 + (tid >> 5)) * 1024 + h * 256 + (tid & 31) * 8;
    const bf16* vg = V + (key0 + (tid >> 6)) * 2048 + h * 512 + (tid & 63) * 8;
    LAS char* kl = Ks + (tid >> 5) * AP_STR + (tid & 31) * 16;
    LAS char* vl = Vs + (tid >> 6) * AP_VSTR + (tid & 63) * 16;
    v4u kr[2], vr[4];
#pragma unroll
    for (int i = 0; i < 2; ++i) kr[i] = *(const v4u*)(kg + (size_t)i * 16 * 1024);
#pragma unroll
    for (int i = 0; i < 4; ++i) vr[i] = *(const v4u*)(vg + (size_t)i * 8 * 2048);
    __syncthreads();
    {
        const bf16* qg = QT + ((size_t)b * T + t0 + (tid >> 5)) * 1024 + h * 256 + (tid & 31) * 8;
        v4u qr[8];
#pragma unroll
        for (int i = 0; i < 8; ++i) qr[i] = *(const v4u*)(qg + (size_t)i * 16 * 1024);
#pragma unroll
        for (int i = 0; i < 8; ++i) *(LAS v4u*)(Qs + ((tid >> 5) + 16 * i) * AP_STR + (tid & 31) * 16) = qr[i];
    }
    const LAS char* qb = Qs + (32 * ig + l31) * AP_STR + 16 * hl;
    const LAS char* ka = Ks + l31 * AP_STR + 16 * hl;
    const LAS char* vb = Vs + (4 * hl + q) * AP_VSTR + 2 * (256 * dh + 16 * blk + 4 * p);
#pragma unroll 1
    for (int tl = 0; tl < ntile; ++tl) {
        __syncthreads();
#pragma unroll
        for (int i = 0; i < 2; ++i) *(LAS v4u*)(kl + i * 16 * AP_STR) = kr[i];
#pragma unroll
        for (int i = 0; i < 4; ++i) *(LAS v4u*)(vl + i * 8 * AP_VSTR) = vr[i];
        if (tl + 1 < ntile) {
#pragma unroll
            for (int i = 0; i < 2; ++i) kr[i] = *(const v4u*)(kg + (size_t)(tl + 1) * 32 * 1024 + (size_t)i * 16 * 1024);
#pragma unroll
            for (int i = 0; i < 4; ++i) vr[i] = *(const v4u*)(vg + (size_t)(tl + 1) * 32 * 2048 + (size_t)i * 8 * 2048);
        }
        __syncthreads();
        const int kt = tl - dtile0;
        if (kt > ig) continue;
        f32x16 X;
#pragma unroll
        for (int i = 0; i < 16; ++i) X[i] = 0.f;
#pragma unroll
        for (int ks = 0; ks < 16; ++ks) {
            const bf16x8 A = *(const LAS bf16x8*)(ka + 32 * ks);
            const bf16x8 B = *(const LAS bf16x8*)(qb + 32 * ks);
            X = MFMA32(A, B, X);
        }
        if (kt == ig) {
#pragma unroll
            for (int i = 0; i < 16; ++i) if (crow(i, hl) > l31) X[i] = 0.f;
        }
        v4u p0, p1;
        p0.x = pk2(X[0], X[1]); p0.y = pk2(X[2], X[3]); p0.z = pk2(X[4], X[5]); p0.w = pk2(X[6], X[7]);
        p1.x = pk2(X[8], X[9]); p1.y = pk2(X[10], X[11]); p1.z = pk2(X[12], X[13]); p1.w = pk2(X[14], X[15]);
        const bf16x8 P0 = __builtin_bit_cast(bf16x8, p0), P1 = __builtin_bit_cast(bf16x8, p1);
#pragma unroll
        for (int mt = 0; mt < 8; ++mt) {
            const bf16x8 A0 = trpair(vb + 64 * mt, 8 * AP_VSTR);
            const bf16x8 A1 = trpair(vb + 64 * mt + 16 * AP_VSTR, 8 * AP_VSTR);
            acc[mt] = MFMA32(A0, P0, acc[mt]);
            acc[mt] = MFMA32(A1, P1, acc[mt]);
        }
    }
    {
        const bf16* sg = ST + (size_t)(bh * 8 + s) * 512 * 256;
        const int srow = tid >> 5, sc = tid & 31;
        v4u sr[4];
#pragma unroll
        for (int i = 0; i < 4; ++i) { const int rho = srow + 16 * i; sr[i] = *(const v4u*)(sg + ((size_t)(256 * (rho >> 5) + (rho & 31))) * 256 + sc * 8); }
        const LAS char* sa = Ss + (32 * dh + l31) * AP_STR + 16 * hl;
#pragma unroll
        for (int mt = 0; mt < 8; ++mt) {
            __syncthreads();
#pragma unroll
            for (int i = 0; i < 4; ++i) *(LAS v4u*)(Ss + (srow + 16 * i) * AP_STR + sc * 16) = sr[i];
            if (mt + 1 < 8) {
#pragma unroll
                for (int i = 0; i < 4; ++i) { const int rho = srow + 16 * i; sr[i] = *(const v4u*)(sg + ((size_t)(256 * (rho >> 5) + 32 * (mt + 1) + (rho & 31))) * 256 + sc * 8); }
            }
            __syncthreads();
#pragma unroll
            for (int ks = 0; ks < 16; ++ks) {
                const bf16x8 A = *(const LAS bf16x8*)(sa + 32 * ks);
                const bf16x8 B = *(const LAS bf16x8*)(qb + 32 * ks);
                acc[mt] = MFMA32(A, B, acc[mt]);
            }
        }
    }
    float ss = 0.f;
#pragma unroll
    for (int mt = 0; mt < 8; ++mt)
#pragma unroll
        for (int i = 0; i < 16; ++i) ss += acc[mt][i] * acc[mt][i];
    ss += __shfl_xor(ss, 32);
    __syncthreads();
    if (hl == 0) red[dh * 128 + 32 * ig + l31] = ss;
    LAS char* Tw = Qs + w * (32 * AP_STR);
#pragma unroll
    for (int mt = 0; mt < 8; ++mt)
#pragma unroll
        for (int g = 0; g < 4; ++g) { v2u w2; w2.x = pk2(acc[mt][4 * g], acc[mt][4 * g + 1]); w2.y = pk2(acc[mt][4 * g + 2], acc[mt][4 * g + 3]);
            *(LAS v2u*)(Tw + l31 * AP_STR + (32 * mt + 8 * g + 4 * hl) * 2) = w2; }
    __syncthreads();
    bf16* og = O + ((size_t)b * T + t0 + 32 * ig) * LDAB + h * 512 + 256 * dh;
#pragma unroll
    for (int i = 0; i < 16; ++i) { const int id = lane + 64 * i, row = id >> 5, c = id & 31;
        const v4u x = *(const LAS v4u*)(Tw + row * AP_STR + c * 16); *(v4u*)(og + (size_t)row * LDAB + c * 8) = x; }
    if (tid < 128) ssq[((size_t)b * T + t0 + tid) * 4 + h] = red[tid] + red[128 + tid];
}
#ifndef TS_PH
#define TS_PH -1
#endif
struct Args { const float* in[9]; float* out; unsigned char* ws; int ph_lo, ph_hi, li, pad; };
__global__ void __launch_bounds__(NWAVES * 64, 2) fwd_kernel(Args args) {
    extern __shared__ __attribute__((aligned(16))) unsigned char lds[];
    Frame F;
    F.lds = (LAS unsigned char*)lds; F.MISC = (volatile LAS unsigned*)(F.lds + MISC_OFF);
    F.tid = threadIdx.x; F.lane = F.tid & 63; F.wave = __builtin_amdgcn_readfirstlane(F.tid >> 6);
    F.G = gridDim.x; { const int bx = blockIdx.x; F.vcu = (F.G % 8 == 0) ? (bx % 8) * (F.G / 8) + bx / 8 : bx; }
    F.ws = args.ws; F.ctl = (gu32*)(args.ws + WS_CTL); F.out = args.out;
#pragma unroll
    for (int i = 0; i < 9; ++i) F.in[i] = args.in[i];
    for (int u = F.tid; u < (LDS_BYTES - LDSCTL_OFF) / 4; u += NWAVES * 64) ((LAS unsigned*)(F.lds + LDSCTL_OFF))[u] = 0u;
    __syncthreads();
    XcdBarrier bar; bar.bar = (unsigned*)(F.ctl + CW_BAR); bar.x = 0; bar.st = nullptr;
    if (N_LAUNCHES == 1) bar = xcd_barrier_post((unsigned*)(F.ctl + CW_BAR), F.MISC + 8);
    const int lo = args.ph_lo, hi = args.ph_hi;
    if (TS_PH >= 0 && blockIdx.x == 0 && F.tid == 0) F.MISC[16] = (unsigned)__builtin_amdgcn_s_memrealtime();
#define IN(k) (lo <= (k) && (k) < hi)
#define STAMP(i) do { if (TS_PH >= 0 && blockIdx.x == 0 && F.tid == 0) F.MISC[16 + (i)] = (unsigned)__builtin_amdgcn_s_memrealtime(); } while (0)
#define SEAM(k) do { if (IN(k) && IN((k) + 1)) xcd_barrier(bar); STAMP((k) + 1); } while (0)
#ifndef REP_PH
#define REP_PH -1
#endif
#define REPEAT(k) for (int rep = 0, nrep = (l == 0 && REP_PH == (k)) ? 2 : 1; rep < nrep; ++rep)
#define REPBAR() do { if (rep) xcd_barrier(bar); } while (0)
#define PHASE_PTRS() unsigned long long z0_ = 0ull; asm volatile("" : "+s"(z0_)); unsigned char* ws = args.ws + z0_; \
    Frame P = F; { int t_ = threadIdx.x; asm volatile("" : "+v"(t_)); P.tid = t_; P.lane = t_ & 63; P.wave = __builtin_amdgcn_readfirstlane(t_ >> 6); } \
    float* cosT = (float*)(ws + WS_COS); float* sinT = (float*)(ws + WS_SIN); float* rstd = (float*)(ws + WS_RSTD); float* ssq = (float*)(ws + WS_SSQ); \
    bf16* XB = (bf16*)(ws + WS_XB); bf16* U = (bf16*)(ws + WS_U); bf16* BZ = (bf16*)(ws + WS_AB); bf16* QT = (bf16*)(ws + WS_QT); bf16* KT = (bf16*)(ws + WS_KT); \
    bf16* V = (bf16*)(ws + WS_V); bf16* O = (bf16*)(ws + WS_AB) + 1024; bf16* SG = (bf16*)(ws + WS_SG); bf16* MG = (bf16*)(ws + WS_MG); \
    unsigned char* RW = ws + ((l & 1) ? WS_R2 : WS_R1); unsigned char* RS = ws + ((l & 1) ? WS_R1 : WS_R2); bf16* ST = (bf16*)RS; \
    (void)cosT; (void)sinT; (void)rstd; (void)ssq; (void)XB; (void)U; (void)BZ; (void)QT; (void)KT; (void)V; (void)O; (void)SG; (void)MG; (void)RW; (void)RS; (void)ST

    if (IN(0)) { const int l = 0; REPEAT(7) {
        REPBAR(); PHASE_PTRS();
        convert_layer(P, 0, ws + WS_R1);
        rotary_tables(P, cosT, sinT);
        rownorm(P, args.in[0], XB, rstd);
    } }
    SEAM(0);
#if REP_PH == 8
    for (int xb = 0; xb < 20; ++xb) xcd_barrier(bar);
#endif
#pragma unroll 1
    for (int l = 0; l < DEPTH; ++l) {
        const int pb = 1 + 7 * l;
        if (IN(pb + 0)) REPEAT(0) {
            REPBAR(); PHASE_PTRS();
            pg8::Gemm g{XB, (const bf16*)(RW + RW_IN), M, NA, D}; pg8::StaticOrder S; S.init(M, NA, F.G, (int)blockIdx.x);
            EpiA E{rstd, cosT, sinT, U, BZ, QT, KT, V};
            pg8::gemm_phase<EpiA, pg8::StaticOrder, true, true>(F.lds, g, S, E);
        }
        SEAM(pb + 0);
        if (IN(pb + 1)) REPEAT(1) {
            REPBAR(); PHASE_PTRS();
            const float* cw = args.in[3] + (size_t)l * 3 * D; const float* cb = args.in[4] + (size_t)l * D;
            if (F.G == 256 && nrep == 1) chain_item<true>(P, F.vcu >> 4, F.vcu & 15, KT, V, ST, U, BZ, cw, cb);
            else { for (int it = F.vcu; it < 256; it += F.G) chain_item<false>(P, it >> 4, it & 15, KT, V, ST, U, BZ, cw, cb);
                   if (rep == nrep - 1) conv_pass(P, U, BZ, cw, cb); }
        }
        SEAM(pb + 1);
        if (IN(pb + 2)) REPEAT(2) {
            REPBAR(); PHASE_PTRS();
            for (int pr = F.vcu; pr < 256; pr += F.G) {
                const int bh = pr >> 4, pi = pr & 15, s = pi >> 1;
                const int ra = (pi & 1) ? 4 * s + 1 : 4 * s + 0, rb = (pi & 1) ? 4 * s + 2 : 4 * s + 3;
#pragma unroll 1
                for (int k = 0; k < 2; ++k) apply_item(P, bh, k == 0 ? rb : ra, QT, KT, V, ST, O, ssq);
            }
        }
        SEAM(pb + 2);
        if (IN(pb + 3)) {
            PHASE_PTRS();
            if (l + 1 < DEPTH) { convert_layer(P, l + 1, RS); __syncthreads(); }
            pg8::Gemm g{XB, (const bf16*)(RW + RW_IN) + (size_t)NA * D, M, NB, D}; pg8::StaticOrder S; S.init(M, NB, F.G, (int)blockIdx.x);
            EpiB E{rstd, ssq, O, O, SG};
            pg8::gemm_phase<EpiB, pg8::StaticOrder, true, true>(F.lds, g, S, E);
        }
        SEAM(pb + 3);
        if (IN(pb + 4)) REPEAT(4) {
            REPBAR(); PHASE_PTRS();
            pg8::Gemm g{BZ, (const bf16*)(RW + RW_AB), M, D, LDAB}; pg8::StaticOrder S; S.init(M, D, F.G, (int)blockIdx.x);
            EpiMG E{SG, MG}; pg8::gemm_phase<EpiMG, pg8::StaticOrder, false, true>(F.lds, g, S, E);
        }
        SEAM(pb + 4);
        if (IN(pb + 5)) REPEAT(5) {
            REPBAR(); PHASE_PTRS();
            pg8::Gemm g{MG, (const bf16*)(RW + RW_O), M, D, D}; pg8::StaticOrder S; S.init(M, D, F.G, (int)blockIdx.x);
            EpiRes E{(l == 0) ? args.in[0] : (const float*)args.out, args.out}; pg8::gemm_phase<EpiRes, pg8::StaticOrder, false, true>(F.lds, g, S, E);
        }
        SEAM(pb + 5);
        if (IN(pb + 6)) REPEAT(6) {
            REPBAR(); PHASE_PTRS();
            if (l + 1 < DEPTH) rownorm(P, args.out, XB, rstd);
            else final_norm(P, args.out, args.in[8]);
        }
        if (l + 1 < DEPTH) SEAM(pb + 6);
    }
    STAMP(NPHASES);
    if (TS_PH >= 0 && blockIdx.x == 0 && F.tid == 0) { const unsigned d = F.MISC[17 + TS_PH] - F.MISC[16 + TS_PH]; const unsigned long long t0 = __builtin_amdgcn_s_memrealtime();
        while (__builtin_amdgcn_s_memrealtime() - t0 < 4ull * d) __builtin_amdgcn_s_sleep(8); }
#undef IN
#undef SEAM
}

extern "C" void kernel_launch(void* const* d_in, const int* in_sizes, int n_in, void* d_out, int out_size, void* d_ws, size_t ws_size, hipStream_t stream) {
    static int grid = 0;
    if (grid == 0) {
        if (n_in != 9 || in_sizes[0] != M * D || out_size != M * D || ws_size < WS_END) {
            fprintf(stderr, "kernel_launch: unexpected problem (n_in %d, in0 %d, out %d, ws %zu; need ws >= %zu); nothing launched\n", n_in, n_in > 0 ? in_sizes[0] : -1, out_size, ws_size, (size_t)WS_END); grid = -1; return; }
        int dev = 0, cus = 0, per_cu = 0;
        if (hipGetDevice(&dev) != hipSuccess || hipDeviceGetAttribute(&cus, hipDeviceAttributeMultiprocessorCount, dev) != hipSuccess) { grid = -1; return; }
        if (hipFuncSetAttribute((const void*)fwd_kernel, hipFuncAttributeMaxDynamicSharedMemorySize, LDS_BYTES) != hipSuccess) { fprintf(stderr, "kernel_launch: hipFuncSetAttribute failed\n"); grid = -1; return; }
        if (hipOccupancyMaxActiveBlocksPerMultiprocessor(&per_cu, (const void*)fwd_kernel, NWAVES * 64, LDS_BYTES) != hipSuccess || per_cu < 1) { fprintf(stderr, "kernel_launch: occupancy query says %d blocks per CU; nothing launched\n", per_cu); (void)hipGetLastError(); grid = -1; return; }
        grid = cus;
    }
    if (grid < 0) return;
    if (hipMemsetAsync((char*)d_ws + WS_CTL, 0, CTL_ZERO_BYTES, stream) != hipSuccess) return;
    Args a{};
    for (int i = 0; i < 9; ++i) a.in[i] = (const float*)d_in[i];
    a.out = (float*)d_out; a.ws = (unsigned char*)d_ws;
    if (N_LAUNCHES == 1) {
        a.ph_lo = 0; a.ph_hi = NPHASES; a.li = 0;
        hipLaunchKernelGGL(fwd_kernel, dim3(grid), dim3(NWAVES * 64), LDS_BYTES, stream, a);
    } else {
        for (int li = 0; li < NPHASES; ++li) { a.ph_lo = li; a.ph_hi = li + 1; a.li = li; hipLaunchKernelGGL(fwd_kernel, dim3(grid), dim3(NWAVES * 64), LDS_BYTES, stream, a); }
    }
}
```
